# Optimizing an MI355X kernel written in HIP

```python
import math
import jax, jax.numpy as jnp
from jax import lax
import numpy as np

D_MODEL = 1024
BATCH = 16
SEQ = 2048
DEPTH = 1
DEC_BATCH = 2
DEC_SEQ = 8192
PAST_LEN = 128

MIX_WIDTH = D_MODEL
MLA_WIDTH = MIX_WIDTH // 2
NA_WIDTH = MIX_WIDTH - MLA_WIDTH

MLA_HEADS = 8
MLA_V_DIM = MLA_WIDTH // MLA_HEADS
MLA_NOPE_DIM = 64
MLA_ROPE_DIM = 32
MLA_QK_DIM = MLA_NOPE_DIM + MLA_ROPE_DIM
Q_LORA_RANK = 384
KV_LORA_RANK = 256
ROPE_THETA = 10000.0
Q_BLOCK = 128

NA_HEADS = 8
NA_HEAD_DIM = NA_WIDTH // NA_HEADS
GRID_W = 64
NA_KH = 8
NA_KW = 16

IN_COLS = Q_LORA_RANK + KV_LORA_RANK + MLA_ROPE_DIM + 3 * NA_WIDTH
D_FF = int(math.ceil(8 * D_MODEL / 3 / 256)) * 256
EPS = 1e-6
NEG_INF = -1e30

kernel_name = "hymba_mla_natten_encoder"


def rmsnorm(x, g):
    xf = x.astype(jnp.float32)
    y = xf * lax.rsqrt(jnp.mean(xf * xf, axis=-1, keepdims=True) + EPS)
    return (y * g.astype(jnp.float32)).astype(x.dtype)


def rope_tables(seq_len):
    inv = ROPE_THETA ** (-jnp.arange(0, MLA_ROPE_DIM, 2, dtype=jnp.float32) / MLA_ROPE_DIM)
    ang = jnp.arange(seq_len, dtype=jnp.float32)[:, None] * inv[None, :]
    return jnp.cos(ang), jnp.sin(ang)


def apply_rope(x, cos, sin):
    shape = (cos.shape[0],) + (1,) * (x.ndim - 3) + (cos.shape[1],)
    c, s = cos.reshape(shape), sin.reshape(shape)
    xf = x.astype(jnp.float32)
    x1, x2 = jnp.split(xf, 2, axis=-1)
    return jnp.concatenate([x1 * c - x2 * s, x1 * s + x2 * c], axis=-1).astype(x.dtype)


def mla_group(c_q, c_kv, k_r, q_norm_g, kv_norm_g, w_uq, w_ukv):
    B, S, _ = c_q.shape
    q = (rmsnorm(c_q, q_norm_g) @ w_uq).reshape(B, S, MLA_HEADS, MLA_QK_DIM)
    kv = (rmsnorm(c_kv, kv_norm_g) @ w_ukv).reshape(B, S, MLA_HEADS, MLA_NOPE_DIM + MLA_V_DIM)
    k_nope, v = kv[..., :MLA_NOPE_DIM], kv[..., MLA_NOPE_DIM:]
    cos, sin = rope_tables(S)
    q = jnp.concatenate([q[..., :MLA_NOPE_DIM], apply_rope(q[..., MLA_NOPE_DIM:], cos, sin)], axis=-1)
    q = q * (MLA_QK_DIM ** -0.5)
    k_rope = apply_rope(k_r, cos, sin)
    n_blk = S // Q_BLOCK
    qb = q.reshape(B, n_blk, Q_BLOCK, MLA_HEADS, MLA_QK_DIM).transpose(1, 0, 2, 3, 4)

    def block(qi):
        s = (jnp.einsum('bqhd,bkhd->bhqk', qi[..., :MLA_NOPE_DIM], k_nope,
                        preferred_element_type=jnp.float32)
             + jnp.einsum('bqhr,bkr->bhqk', qi[..., MLA_NOPE_DIM:], k_rope,
                          preferred_element_type=jnp.float32))
        p = jax.nn.softmax(s, axis=-1).astype(v.dtype)
        return jnp.einsum('bhqk,bkhd->bqhd', p, v)

    o = lax.map(block, qb)
    return o.transpose(1, 0, 2, 3, 4).reshape(B, S, MLA_WIDTH)


def na_group(qkv, rpb):
    B, S, _ = qkv.shape
    rows = S // GRID_W
    kh = min(NA_KH, rows)
    qkv = qkv.reshape(B, rows, GRID_W, 3, NA_HEADS, NA_HEAD_DIM)
    q = qkv[:, :, :, 0] * (NA_HEAD_DIM ** -0.5)
    k = qkv[:, :, :, 1]
    v = qkv[:, :, :, 2]
    qc = np.arange(GRID_W)[:, None]
    kc = np.arange(GRID_W)[None, :]
    col_start = np.clip(qc - NA_KW // 2, 0, GRID_W - NA_KW)
    col_mask = (kc >= col_start) & (kc < col_start + NA_KW)
    dj_idx = (np.clip(kc - qc, -(NA_KW - 1), NA_KW - 1) + NA_KW - 1).astype(np.int32)

    def row_block(r):
        start = jnp.clip(r - kh // 2, 0, rows - kh)
        q_r = lax.dynamic_index_in_dim(q, r, axis=1, keepdims=False)
        k_b = lax.dynamic_slice_in_dim(k, start, kh, axis=1)
        v_b = lax.dynamic_slice_in_dim(v, start, kh, axis=1)
        s = jnp.einsum('bqhd,bkwhd->bhqkw', q_r, k_b, preferred_element_type=jnp.float32)
        di = start + jnp.arange(kh) - r
        bias = rpb[:, di + NA_KH - 1][:, :, dj_idx]
        bias = bias.transpose(0, 2, 1, 3).astype(jnp.float32)
        s = jnp.where(col_mask[None, None, :, None, :], s + bias[None], NEG_INF)
        p = jax.nn.softmax(s.reshape(B, NA_HEADS, GRID_W, kh * GRID_W), axis=-1)
        p = p.reshape(B, NA_HEADS, GRID_W, kh, GRID_W).astype(v.dtype)
        return jnp.einsum('bhqkw,bkwhd->bqhd', p, v_b)

    o = lax.map(row_block, jnp.arange(rows))
    return o.transpose(1, 0, 2, 3, 4).reshape(B, S, NA_WIDTH)


def encoder_layer(x, attn_norm_g, w_in, q_norm_g, kv_norm_g, w_uq, w_ukv, na_rpb,
                  mla_out_g, na_out_g, w_o, ffn_norm_g, w_gate, w_up, w_down):
    h = rmsnorm(x, attn_norm_g)
    proj = h @ w_in
    o1 = Q_LORA_RANK
    o2 = o1 + KV_LORA_RANK
    o3 = o2 + MLA_ROPE_DIM
    a = mla_group(proj[..., :o1], proj[..., o1:o2], proj[..., o2:o3],
                  q_norm_g, kv_norm_g, w_uq, w_ukv)
    b = na_group(proj[..., o3:], na_rpb)
    mix = jnp.concatenate([rmsnorm(a, mla_out_g), rmsnorm(b, na_out_g)], axis=-1)
    x = x + mix @ w_o
    h2 = rmsnorm(x, ffn_norm_g)
    x = x + (jax.nn.silu(h2 @ w_gate) * (h2 @ w_up)) @ w_down
    return x


def run_trunk(x, attn_norm_g, w_in, q_norm_g, kv_norm_g, w_uq, w_ukv, na_rpb,
              mla_out_g, na_out_g, w_o, ffn_norm_g, w_gate, w_up, w_down, final_norm_g):
    for l in range(DEPTH):
        x = encoder_layer(x, attn_norm_g[l], w_in[l], q_norm_g[l], kv_norm_g[l], w_uq[l],
                          w_ukv[l], na_rpb[l], mla_out_g[l], na_out_g[l], w_o[l],
                          ffn_norm_g[l], w_gate[l], w_up[l], w_down[l])
    return rmsnorm(x, final_norm_g)


def setup_inputs(seed: int = 0) -> dict:
    key = jax.random.key(seed)
    ks = jax.random.split(key, 20)
    f32 = jnp.float32

    def w(k, shape, fan_in):
        return jax.random.normal(k, shape, f32) * (fan_in ** -0.5)

    def gain(k, shape):
        return 1.0 + 0.05 * jax.random.normal(k, shape, f32)

    L = DEPTH
    return {
        "x_prompt": jax.random.normal(ks[0], (BATCH, SEQ, D_MODEL), f32),
        "x_sample": jax.random.normal(ks[1], (DEC_BATCH, DEC_SEQ, D_MODEL), f32),
        "attn_norm_g": gain(ks[2], (L, D_MODEL)),
        "w_in": w(ks[3], (L, D_MODEL, IN_COLS), D_MODEL),
        "q_norm_g": gain(ks[4], (L, Q_LORA_RANK)),
        "kv_norm_g": gain(ks[5], (L, KV_LORA_RANK)),
        "w_uq": w(ks[6], (L, Q_LORA_RANK, MLA_HEADS * MLA_QK_DIM), Q_LORA_RANK),
        "w_ukv": w(ks[7], (L, KV_LORA_RANK, MLA_HEADS * (MLA_NOPE_DIM + MLA_V_DIM)), KV_LORA_RANK),
        "na_rpb": 0.1 * jax.random.normal(ks[8], (L, NA_HEADS, 2 * NA_KH - 1, 2 * NA_KW - 1), f32),
        "mla_out_g": gain(ks[9], (L, MLA_WIDTH)),
        "na_out_g": gain(ks[10], (L, NA_WIDTH)),
        "w_o": w(ks[11], (L, MIX_WIDTH, D_MODEL), MIX_WIDTH),
        "ffn_norm_g": gain(ks[12], (L, D_MODEL)),
        "w_gate": w(ks[13], (L, D_MODEL, D_FF), D_MODEL),
        "w_up": w(ks[14], (L, D_MODEL, D_FF), D_MODEL),
        "w_down": w(ks[15], (L, D_FF, D_MODEL), D_FF),
        "final_norm_g": gain(ks[16], (D_MODEL,)),
    }


def reference(x_prompt, x_sample, attn_norm_g, w_in, q_norm_g, kv_norm_g, w_uq, w_ukv,
              na_rpb, mla_out_g, na_out_g, w_o, ffn_norm_g, w_gate, w_up, w_down,
              final_norm_g):
    y_prompt = run_trunk(x_prompt, attn_norm_g, w_in, q_norm_g, kv_norm_g, w_uq, w_ukv,
                         na_rpb, mla_out_g, na_out_g, w_o, ffn_norm_g, w_gate, w_up,
                         w_down, final_norm_g)
    y_sample = run_trunk(x_sample, attn_norm_g, w_in, q_norm_g, kv_norm_g, w_uq, w_ukv,
                         na_rpb, mla_out_g, na_out_g, w_o, ffn_norm_g, w_gate, w_up,
                         w_down, final_norm_g)
    return (y_prompt, y_sample)
```

```cpp
#include <hip/hip_runtime.h>
#include <hip/hip_cooperative_groups.h>
#include <cstdio>
#include <cstdint>
namespace cg = cooperative_groups;

#ifndef MK_ONE_LAUNCH
#define MK_ONE_LAUNCH 1
#endif
#ifndef MK_DEBUG
#define MK_DEBUG 0
#endif

#define GAS __attribute__((address_space(1)))
#define LAS __attribute__((address_space(3)))
typedef unsigned short bf16_t;
typedef short bf16x8 __attribute__((ext_vector_type(8)));
typedef short s16x4 __attribute__((ext_vector_type(4)));
typedef short v4i16_t __attribute__((ext_vector_type(4)));
typedef float f32x2 __attribute__((ext_vector_type(2)));
typedef float f32x4 __attribute__((ext_vector_type(4)));
typedef float f32x16 __attribute__((ext_vector_type(16)));
typedef unsigned u32x2 __attribute__((ext_vector_type(2)));
typedef unsigned u32x4 __attribute__((ext_vector_type(4)));
typedef __bf16 bf16x2_t __attribute__((ext_vector_type(2)));

__device__ __forceinline__ unsigned pk2(float lo, float hi) { f32x2 v = {lo, hi}; bf16x2_t b = __builtin_convertvector(v, bf16x2_t); return __builtin_bit_cast(unsigned, b); }
__device__ __forceinline__ float bf2f(unsigned b) { return __builtin_bit_cast(float, b << 16); }
__device__ __forceinline__ float bflo(unsigned w) { return __builtin_bit_cast(float, w << 16); }
__device__ __forceinline__ float bfhi(unsigned w) { return __builtin_bit_cast(float, w & 0xffff0000u); }
__device__ __forceinline__ u32x4 pack8(f32x4 a, f32x4 b) { u32x4 w; w.x = pk2(a[0], a[1]); w.y = pk2(a[2], a[3]); w.z = pk2(b[0], b[1]); w.w = pk2(b[2], b[3]); return w; }
__device__ __forceinline__ float sum4(f32x4 v) { return (v[0] + v[1]) + (v[2] + v[3]); }
__device__ __forceinline__ float dot4(f32x4 v) { return (v[0] * v[0] + v[1] * v[1]) + (v[2] * v[2] + v[3] * v[3]); }

constexpr int DM = 1024, TOK = 49152, TOKP = 32768, SEQP = 2048, SEQS = 8192;
constexpr int QL = 384, KVL = 256, NIN = 2208, N1P = 2304, DFF = 2816, NGU = 5632;
constexpr float EPS = 1e-6f, LOG2E = 1.4426950408889634f;
constexpr float QSC_MLA = 0.10206207261596575f * LOG2E;
constexpr float QSC_NA = 0.125f * LOG2E;
__device__ __forceinline__ int seq_pos(int row) { return row < TOKP ? (row & (SEQP - 1)) : (row & (SEQS - 1)); }

constexpr size_t KiB = 1024, MiB = 1u << 20;
constexpr size_t WS_CTL = 0, CTL_ZERO_BYTES = 64 * KiB;
constexpr size_t WS_COS = 1 * MiB, WS_SIN = WS_COS + 512 * KiB;
constexpr size_t WS_WIN = 2 * MiB;
constexpr size_t WS_WUQ = WS_WIN + (size_t)N1P * DM * 2;
constexpr size_t WS_WUKV = WS_WUQ + 768 * 384 * 2;
constexpr size_t WS_WO = WS_WUKV + 1024 * 256 * 2;
constexpr size_t WS_WGU = WS_WO + 1024 * 1024 * 2;
constexpr size_t WS_WD = WS_WGU + (size_t)NGU * DM * 2;
constexpr size_t WS_WEND = WS_WD + (size_t)DM * DFF * 2;
constexpr size_t WS_SSQ = 27 * MiB;
constexpr size_t WS_SSKV = WS_SSQ + (size_t)TOK * 12 * 4;
constexpr size_t WS_SSA = WS_SSKV + (size_t)TOK * 8 * 4;
constexpr size_t WS_SSB = WS_SSA + (size_t)TOK * 8 * 4;
constexpr size_t WS_SS1 = WS_SSB + (size_t)TOK * 8 * 4;
constexpr size_t WS_SS2 = WS_SS1 + (size_t)TOK * 16 * 4;
constexpr size_t WS_SSEND = WS_SS2 + (size_t)TOK * 16 * 4;
constexpr size_t WS_H = 40 * MiB;
constexpr size_t WS_AB = WS_H;
constexpr size_t WS_CQ = 136 * MiB;
constexpr size_t WS_CKV = WS_CQ + (size_t)TOK * QL * 2;
constexpr size_t WS_KR = WS_CKV + (size_t)TOK * KVL * 2;
constexpr size_t WS_NA = WS_KR + (size_t)TOK * 32 * 2;
constexpr size_t WS_Q = WS_NA + (size_t)TOK * 1536 * 2;
constexpr size_t WS_KN = WS_Q + (size_t)TOK * 768 * 2;
constexpr size_t WS_V = WS_KN + (size_t)TOK * 512 * 2;
constexpr size_t WS_END1 = WS_V + (size_t)TOK * 512 * 2;
constexpr size_t WS_X1 = 136 * MiB;
constexpr size_t WS_ACT = 232 * MiB;
constexpr size_t WS_NEED = 511 * MiB;
static_assert(WS_WEND <= WS_SSQ && WS_SSEND <= WS_H && WS_H + (size_t)TOK * DM * 2 <= WS_CQ && WS_END1 <= WS_NEED, "d_ws map");
static_assert(WS_X1 + (size_t)TOK * DM * 2 <= WS_ACT && WS_ACT + (size_t)TOK * DFF * 2 <= WS_NEED, "d_ws overlays");
constexpr int CW_FAIL = 16;

constexpr int RING_BYTES = 131072, LDS_BYTES = 147456;

namespace pg8 {
constexpr int BM = 256, BK = 64, HALF = 128, HTB = HALF * BK * 2, STAGE_BYTES = 8 * HTB, NXCD = 8, WGM = 8;
__host__ __device__ __forceinline__ int lds_byte(int r, int c) { const int st = (r >> 4) * 2 + (c >> 5), rr = r & 15, cc = c & 31, ob = rr * 64 + cc * 2; return st * 1024 + (ob ^ (((ob >> 9) & 1) << 5)); }
__host__ __device__ __forceinline__ void stage_rc(int b, int& R, int& C) { const int st = b / 1024, sb = b % 1024, swz = sb ^ (((sb >> 9) & 1) << 5); R = (st >> 1) * 16 + swz / 64; C = (st & 1) * 32 + (swz % 64) / 2; }
__host__ __device__ __forceinline__ int perm32(int rho) { const int n = rho >> 4, i = rho & 15; return 8 * (i >> 2) + 4 * n + (i & 3); }

struct Unit { int pm, pn; };
struct Gemm { const bf16_t* A; const bf16_t* Bt; int M, N, K; };

struct StaticOrder {
    int nM, nN, nwg, G, c;
    __device__ void init(int M, int N, int G_, int c_) { nM = M / BM; nN = N / BM; nwg = nM * nN; G = G_; c = c_; }
    __device__ bool next(int i, Unit& u) const {
        const long L = (long)i * G + c; if (L >= nwg) return false;
        int wgid = (int)L; { const int q = nwg / NXCD, r = nwg % NXCD, xcd = wgid % NXCD, off = wgid / NXCD; wgid = (xcd < r ? xcd * (q + 1) : r * (q + 1) + (xcd - r) * q) + off; }
        const int nig = WGM * nN, gid = wgid / nig, fm = gid * WGM, gsz = (nM - fm) < WGM ? (nM - fm) : WGM;
        u.pm = fm + ((wgid % nig) % gsz); u.pn = (wgid % nig) / gsz; return true;
    }
};

template <class Epi, bool ALIGN_EPI>
__device__ __forceinline__ void gemm_phase(LAS unsigned char* lds, const Gemm g, const StaticOrder& S, const Epi& E) {
    int tid = threadIdx.x; asm volatile("" : "+v"(tid));
    const int wid = __builtin_amdgcn_readfirstlane(tid >> 6), lane = tid & 63, wr = wid >> 2, wc = wid & 3, fr = lane & 15, fq = lane >> 4;
    const int K = g.K, nt = K / BK;
    unsigned voffA[2], voffB[2];
#pragma unroll
    for (int i = 0; i < 2; ++i) { int R, C; stage_rc(tid * 16 + i * 8192, R, C); const int Rb = Epi::PERM ? ((R & ~31) + perm32(R & 31)) : R;
        voffA[i] = (unsigned)(R * K + C) * 2u; voffB[i] = (unsigned)(Rb * K + C) * 2u; }
    const size_t kstep = (size_t)(BK * 2);
    const size_t hstep = (size_t)HALF * K * 2;
    const size_t tstep = 2 * hstep;
    const unsigned ldsw = (unsigned)wid * 1024u;
    const int aoff = lds_byte(wr * 64 + fr, fq * 8), boff = lds_byte(wc * 32 + fr, fq * 8);
#define PG8_SA(b, h) (((b) * 2 + (h)) * HTB)
#define PG8_SB(b, h) ((4 + (b) * 2 + (h)) * HTB)
#define PG8_STAGE(bufoff, gbase, voff) do { _Pragma("unroll") for (int _i = 0; _i < 2; ++_i) \
        __builtin_amdgcn_global_load_lds((const unsigned*)((const char*)(gbase) + (voff)[_i]), (LAS unsigned*)(lds + (bufoff) + ldsw + _i * 8192), 16, 0, 0); } while (0)
#define PG8_LDA(dst, b, h) do { _Pragma("unroll") for (int m = 0; m < 4; ++m) _Pragma("unroll") for (int k = 0; k < 2; ++k) dst[m][k] = *(const LAS bf16x8*)(lds + PG8_SA(b, h) + aoff + m * 2048 + k * 1024); } while (0)
#define PG8_LDB(dst, b, h) do { _Pragma("unroll") for (int n = 0; n < 2; ++n) _Pragma("unroll") for (int k = 0; k < 2; ++k) dst[n][k] = *(const LAS bf16x8*)(lds + PG8_SB(b, h) + boff + n * 2048 + k * 1024); } while (0)
#define PG8_MMA(ai, bj, At, Bt) do { __builtin_amdgcn_s_setprio(1); _Pragma("unroll") for (int m = 0; m < 4; ++m) _Pragma("unroll") for (int n = 0; n < 2; ++n) _Pragma("unroll") for (int k = 0; k < 2; ++k) \
        acc[ai][bj][m][n] = __builtin_amdgcn_mfma_f32_16x16x32_bf16(Bt[n][k], At[m][k], acc[ai][bj][m][n], 0, 0, 0); __builtin_amdgcn_s_setprio(0); } while (0)
#define PG8_WAIT_V(n) asm volatile("s_waitcnt vmcnt(" #n ")" ::: "memory")
#define PG8_WAIT_L(n) asm volatile("s_waitcnt lgkmcnt(" #n ")" ::: "memory")
#define PG8_BAR __builtin_amdgcn_s_barrier()
#define PG8_SCHED __builtin_amdgcn_sched_barrier(0)
    Unit cur, nxt; int ui = 0;
    if (!S.next(0, cur)) return;
    f32x4 acc[2][2][4][2];
#pragma unroll
    for (int a = 0; a < 2; ++a)
#pragma unroll
        for (int b = 0; b < 2; ++b)
#pragma unroll
            for (int m = 0; m < 4; ++m)
#pragma unroll
                for (int n = 0; n < 2; ++n) acc[a][b][m][n] = (f32x4){0.f, 0.f, 0.f, 0.f};
    bf16x8 At[4][2], B0[2][2], B1[2][2];
    const char* cA = (const char*)g.A + (size_t)cur.pm * tstep; const char* cB = (const char*)g.Bt + (size_t)cur.pn * tstep;
    PG8_STAGE(PG8_SB(0, 0), cB, voffB); PG8_STAGE(PG8_SB(0, 1), cB + hstep, voffB); PG8_STAGE(PG8_SA(0, 0), cA, voffA); PG8_STAGE(PG8_SA(0, 1), cA + hstep, voffA);
    if (wr == 1) PG8_BAR;
    PG8_WAIT_V(2); PG8_BAR;
    PG8_STAGE(PG8_SB(1, 0), cB + kstep, voffB); PG8_STAGE(PG8_SA(1, 0), cA + kstep, voffA); PG8_STAGE(PG8_SB(1, 1), cB + hstep + kstep, voffB);
    PG8_WAIT_V(6); PG8_BAR;
    for (;;) {
        const bool has_next = S.next(ui + 1, nxt);
        const char* nA = has_next ? (const char*)g.A + (size_t)nxt.pm * tstep : cA; const char* nB = has_next ? (const char*)g.Bt + (size_t)nxt.pn * tstep : cB;
#pragma unroll 1
        for (int t = 0; t < nt; t += 2) {
            if constexpr (Epi::MID_T >= 0) { if (t == Epi::MID_T) E.mid(acc, cur, wr, wc, fr, fq); }
            const bool last = (t == nt - 2);
            const char* a1 = cA + (size_t)(t + 1) * kstep;
            const char* a2 = last ? nA : cA + (size_t)(t + 2) * kstep; const char* b2 = last ? nB : cB + (size_t)(t + 2) * kstep;
            const char* a3 = a2 + kstep; const char* b3 = b2 + kstep;
            PG8_LDB(B0, 0, 0); PG8_LDB(B1, 0, 1); PG8_SCHED; PG8_LDA(At, 0, 0); PG8_STAGE(PG8_SA(1, 1), a1 + hstep, voffA);
            PG8_WAIT_V(8); PG8_WAIT_L(0); PG8_BAR; PG8_MMA(0, 0, At, B0); PG8_MMA(0, 1, At, B1); PG8_BAR; PG8_SCHED;
            PG8_LDA(At, 0, 1); PG8_STAGE(PG8_SB(0, 0), b2, voffB); PG8_STAGE(PG8_SB(0, 1), b2 + hstep, voffB); PG8_STAGE(PG8_SA(0, 0), a2, voffA);
            PG8_WAIT_V(8); PG8_WAIT_L(0); PG8_BAR; PG8_MMA(1, 0, At, B0); PG8_MMA(1, 1, At, B1); PG8_BAR; PG8_SCHED;
            PG8_LDB(B0, 1, 0); PG8_LDB(B1, 1, 1); PG8_SCHED; PG8_LDA(At, 1, 0); PG8_STAGE(PG8_SA(0, 1), a2 + hstep, voffA);
            PG8_WAIT_V(8); PG8_WAIT_L(0); PG8_BAR; PG8_MMA(0, 0, At, B0); PG8_MMA(0, 1, At, B1); PG8_BAR; PG8_SCHED;
            PG8_LDA(At, 1, 1); PG8_STAGE(PG8_SB(1, 0), b3, voffB); PG8_STAGE(PG8_SB(1, 1), b3 + hstep, voffB); PG8_STAGE(PG8_SA(1, 0), a3, voffA);
            PG8_WAIT_V(8); PG8_WAIT_L(0); PG8_BAR; PG8_MMA(1, 0, At, B0); PG8_MMA(1, 1, At, B1); PG8_BAR; PG8_SCHED;
        }
        if constexpr (ALIGN_EPI) { if (wr == 0) PG8_BAR; }
        E(acc, cur, wr, wc, fr, fq);
        if (!has_next) break;
#pragma unroll
        for (int a = 0; a < 2; ++a)
#pragma unroll
            for (int b = 0; b < 2; ++b)
#pragma unroll
                for (int m = 0; m < 4; ++m)
#pragma unroll
                    for (int n = 0; n < 2; ++n) acc[a][b][m][n] = (f32x4){0.f, 0.f, 0.f, 0.f};
        cur = nxt; cA = nA; cB = nB; ++ui;
        if constexpr (ALIGN_EPI) { if (wr == 1) PG8_BAR; }
    }
    PG8_WAIT_V(0);
    if constexpr (!ALIGN_EPI) { if (wr == 0) PG8_BAR; }
    PG8_BAR;
#undef PG8_SA
#undef PG8_SB
#undef PG8_STAGE
#undef PG8_LDA
#undef PG8_LDB
#undef PG8_MMA
#undef PG8_WAIT_V
#undef PG8_WAIT_L
#undef PG8_BAR
#undef PG8_SCHED
}
}
using pg8::Unit;

struct Epi1 {
    static constexpr bool PERM = true; static constexpr int MID_T = -1;
    bf16_t *CQ, *CKV, *KR, *NA; float *SSQ, *SSKV; const float *COS, *SIN;
    __device__ __forceinline__ void mid(f32x4 (&)[2][2][4][2], const Unit&, int, int, int, int) const {}
    __device__ __forceinline__ void operator()(const f32x4 (&acc)[2][2][4][2], const Unit& u, int wr, int wc, int fr, int fq_in) const {
        int row0 = u.pm * 256 + wr * 64 + fr, fq = fq_in; asm volatile("" : "+v"(row0), "+v"(fq));
#pragma unroll
        for (int bj = 0; bj < 2; ++bj) {
            const int gc = u.pn * 256 + bj * 128 + wc * 32;
            if (gc < 640) {
                const bool isq = gc < QL;
                bf16_t* base = isq ? CQ : CKV; const int ld = isq ? QL : KVL, col = isq ? gc : gc - QL; float* ss = isq ? SSQ : SSKV; const int nslot = isq ? 12 : 8, slot = col >> 5;
#pragma unroll
                for (int ai = 0; ai < 2; ++ai)
#pragma unroll
                    for (int m = 0; m < 4; ++m) { const int row = row0 + ai * 128 + m * 16; const f32x4 v0 = acc[ai][bj][m][0], v1 = acc[ai][bj][m][1];
                        float s = dot4(v0) + dot4(v1); s += __shfl_xor(s, 16); s += __shfl_xor(s, 32);
                        if (fq == 0) ss[(size_t)row * nslot + slot] = s;
                        *(u32x4*)(base + (size_t)row * ld + col + 8 * fq) = pack8(v0, v1); }
            } else if (gc < 672) {
#pragma unroll
                for (int ai = 0; ai < 2; ++ai)
#pragma unroll
                    for (int m = 0; m < 4; ++m) { const int row = row0 + ai * 128 + m * 16; const int pos = seq_pos(row);
                        const f32x4 c4 = *(const f32x4*)(COS + pos * 16 + 4 * fq), s4 = *(const f32x4*)(SIN + pos * 16 + 4 * fq);
                        const f32x4 x1 = acc[ai][bj][m][0], x2 = acc[ai][bj][m][1]; const f32x4 o1 = x1 * c4 - x2 * s4, o2 = x1 * s4 + x2 * c4;
                        u32x2 w1, w2; w1.x = pk2(o1[0], o1[1]); w1.y = pk2(o1[2], o1[3]); w2.x = pk2(o2[0], o2[1]); w2.y = pk2(o2[2], o2[3]);
                        *(u32x2*)(KR + (size_t)row * 32 + 4 * fq) = w1; *(u32x2*)(KR + (size_t)row * 32 + 16 + 4 * fq) = w2; }
            } else if (gc >= 768) {
                const int col = gc - 768; const float sc = col < 512 ? QSC_NA : 1.0f;
#pragma unroll
                for (int ai = 0; ai < 2; ++ai)
#pragma unroll
                    for (int m = 0; m < 4; ++m) { const int row = row0 + ai * 128 + m * 16;
                        *(u32x4*)(NA + (size_t)row * 1536 + col + 8 * fq) = pack8(acc[ai][bj][m][0] * sc, acc[ai][bj][m][1] * sc); }
            }
        }
    }
};
struct Epi2 {
    static constexpr bool PERM = true; static constexpr int MID_T = -1;
    bf16_t* Q; const float *SSQ, *COS, *SIN;
    __device__ __forceinline__ void mid(f32x4 (&)[2][2][4][2], const Unit&, int, int, int, int) const {}
    __device__ __forceinline__ void operator()(const f32x4 (&acc)[2][2][4][2], const Unit& u, int wr, int wc, int fr, int fq_in) const {
        int row0 = u.pm * 256 + wr * 64 + fr, fq = fq_in; asm volatile("" : "+v"(row0), "+v"(fq));
#pragma unroll
        for (int ai = 0; ai < 2; ++ai)
#pragma unroll
            for (int m = 0; m < 4; ++m) { const int row = row0 + ai * 128 + m * 16; const float* p = SSQ + (size_t)row * 12;
                const f32x4 a = *(const f32x4*)p, b = *(const f32x4*)(p + 4), c = *(const f32x4*)(p + 8);
                const float r = __builtin_amdgcn_rsqf((sum4(a) + sum4(b) + sum4(c)) * (1.0f / QL) + EPS) * QSC_MLA;
#pragma unroll
                for (int bj = 0; bj < 2; ++bj) {
                    const int gc = u.pn * 256 + bj * 128 + wc * 32, G = gc >> 5, h = G / 3, part = G - 3 * h;
                    if (part < 2) {
                        *(u32x4*)(Q + (size_t)row * 768 + h * 96 + part * 32 + 8 * fq) = pack8(acc[ai][bj][m][0] * r, acc[ai][bj][m][1] * r);
                    } else { const int pos = seq_pos(row);
                        const f32x4 c4 = *(const f32x4*)(COS + pos * 16 + 4 * fq), s4 = *(const f32x4*)(SIN + pos * 16 + 4 * fq);
                        const f32x4 x1 = acc[ai][bj][m][0] * r, x2 = acc[ai][bj][m][1] * r; const f32x4 o1 = x1 * c4 - x2 * s4, o2 = x1 * s4 + x2 * c4;
                        u32x2 w1, w2; w1.x = pk2(o1[0], o1[1]); w1.y = pk2(o1[2], o1[3]); w2.x = pk2(o2[0], o2[1]); w2.y = pk2(o2[2], o2[3]);
                        bf16_t* qp = Q + (size_t)row * 768 + h * 96 + 64 + 4 * fq; *(u32x2*)qp = w1; *(u32x2*)(qp + 16) = w2; }
                }
                asm volatile("" ::: "memory"); }
    }
};
struct Epi3 {
    static constexpr bool PERM = true; static constexpr int MID_T = -1;
    bf16_t *KN, *V; const float* SSKV;
    __device__ __forceinline__ void mid(f32x4 (&)[2][2][4][2], const Unit&, int, int, int, int) const {}
    __device__ __forceinline__ void operator()(const f32x4 (&acc)[2][2][4][2], const Unit& u, int wr, int wc, int fr, int fq_in) const {
        int row0 = u.pm * 256 + wr * 64 + fr, fq = fq_in; asm volatile("" : "+v"(row0), "+v"(fq));
        float rs[2][4];
#pragma unroll
        for (int ai = 0; ai < 2; ++ai)
#pragma unroll
            for (int m = 0; m < 4; ++m) { const float* p = SSKV + (size_t)(row0 + ai * 128 + m * 16) * 8;
                const f32x4 a = *(const f32x4*)p, b = *(const f32x4*)(p + 4);
                rs[ai][m] = __builtin_amdgcn_rsqf((sum4(a) + sum4(b)) * (1.0f / KVL) + EPS); }
#pragma unroll
        for (int bj = 0; bj < 2; ++bj) {
            const int gc = u.pn * 256 + bj * 128 + wc * 32, h = gc >> 7, w = gc & 127;
            bf16_t* base = (w < 64) ? KN + h * 64 + w : V + h * 64 + (w - 64);
#pragma unroll
            for (int ai = 0; ai < 2; ++ai)
#pragma unroll
                for (int m = 0; m < 4; ++m) { const int row = row0 + ai * 128 + m * 16; const float r = rs[ai][m];
                    *(u32x4*)(base + (size_t)row * 512 + 8 * fq) = pack8(acc[ai][bj][m][0] * r, acc[ai][bj][m][1] * r); }
        }
    }
};
struct Epi4 {
    static constexpr bool PERM = true; static constexpr int MID_T = 8;
    const float *xp, *xs; bf16_t* X1; const float *SSA, *SSB; float* SS1;
    __device__ __forceinline__ float rstd8(const float* p) const { const f32x4 a = *(const f32x4*)p, b = *(const f32x4*)(p + 4); return __builtin_amdgcn_rsqf((sum4(a) + sum4(b)) * (1.0f / 512.0f) + EPS); }
    __device__ __forceinline__ void mid(f32x4 (&acc)[2][2][4][2], const Unit& u, int wr, int wc, int fr, int fq_in) const {
        int row0 = u.pm * 256 + wr * 64 + fr, fq = fq_in; asm volatile("" : "+v"(row0), "+v"(fq));
#pragma unroll
        for (int ai = 0; ai < 2; ++ai)
#pragma unroll
            for (int m = 0; m < 4; ++m) { const size_t row = (size_t)(row0 + ai * 128 + m * 16);
                const float ra = rstd8(SSA + row * 8), rb = rstd8(SSB + row * 8); const float f = ra / rb;
#pragma unroll
                for (int bj = 0; bj < 2; ++bj)
#pragma unroll
                    for (int n = 0; n < 2; ++n) acc[ai][bj][m][n] = acc[ai][bj][m][n] * f;
                asm volatile("" ::: "memory"); }
    }
    __device__ __forceinline__ void operator()(const f32x4 (&acc)[2][2][4][2], const Unit& u, int wr, int wc, int fr, int fq_in) const {
        int row0 = u.pm * 256 + wr * 64 + fr, fq = fq_in; asm volatile("" : "+v"(row0), "+v"(fq)); const int colw = u.pn * 256 + wc * 32 + 8 * fq;
#pragma unroll
        for (int ai = 0; ai < 2; ++ai)
#pragma unroll
            for (int m = 0; m < 4; ++m) { const int row = row0 + ai * 128 + m * 16; const float rb = rstd8(SSB + (size_t)row * 8);
                const float* xr = (row < TOKP ? xp + (size_t)row * DM : xs + (size_t)(row - TOKP) * DM) + colw;
                float s = 0.f;
#pragma unroll
                for (int bj = 0; bj < 2; ++bj) { const f32x4 a0 = *(const f32x4*)(xr + bj * 128), a1 = *(const f32x4*)(xr + bj * 128 + 4);
                    const f32x4 v0 = a0 + acc[ai][bj][m][0] * rb, v1 = a1 + acc[ai][bj][m][1] * rb; s += dot4(v0) + dot4(v1);
                    *(u32x4*)(X1 + (size_t)row * DM + colw + bj * 128) = pack8(v0, v1); }
                s += __shfl_xor(s, 16); s += __shfl_xor(s, 32);
                if (fq == 0) SS1[(size_t)row * 16 + u.pn * 4 + wc] = s;
                asm volatile("" ::: "memory"); }
    }
};
__device__ __forceinline__ float rstd16(const float* p) { const f32x4 a = *(const f32x4*)p, b = *(const f32x4*)(p + 4), c = *(const f32x4*)(p + 8), d = *(const f32x4*)(p + 12);
    return __builtin_amdgcn_rsqf(((sum4(a) + sum4(b)) + (sum4(c) + sum4(d))) * (1.0f / DM) + EPS); }
struct Epi5 {
    static constexpr bool PERM = true; static constexpr int MID_T = -1;
    bf16_t* ACT; const float* SS1;
    __device__ __forceinline__ void mid(f32x4 (&)[2][2][4][2], const Unit&, int, int, int, int) const {}
    __device__ __forceinline__ void operator()(const f32x4 (&acc)[2][2][4][2], const Unit& u, int wr, int wc, int fr, int fq_in) const {
        int row0 = u.pm * 256 + wr * 64 + fr, fq = fq_in; asm volatile("" : "+v"(row0), "+v"(fq)); const int col = u.pn * 128 + wc * 32 + 8 * fq;
#pragma unroll
        for (int ai = 0; ai < 2; ++ai)
#pragma unroll
            for (int m = 0; m < 4; ++m) { const int row = row0 + ai * 128 + m * 16; const float r = rstd16(SS1 + (size_t)row * 16);
                f32x4 o[2];
#pragma unroll
                for (int n = 0; n < 2; ++n) { const f32x4 gt = acc[ai][0][m][n] * r, up = acc[ai][1][m][n] * r;
#pragma unroll
                    for (int i = 0; i < 4; ++i) o[n][i] = gt[i] * __builtin_amdgcn_rcpf(1.0f + __builtin_amdgcn_exp2f(-gt[i] * LOG2E)) * up[i]; }
                *(u32x4*)(ACT + (size_t)row * DFF + col) = pack8(o[0], o[1]); }
    }
};
struct Epi6 {
    static constexpr bool PERM = false; static constexpr int MID_T = -1;
    const bf16_t* X1; float* out; float* SS2;
    __device__ __forceinline__ void mid(f32x4 (&)[2][2][4][2], const Unit&, int, int, int, int) const {}
    __device__ __forceinline__ void operator()(const f32x4 (&acc)[2][2][4][2], const Unit& u, int wr, int wc, int fr, int fq_in) const {
        int row0 = u.pm * 256 + wr * 64 + fr, fq = fq_in; asm volatile("" : "+v"(row0), "+v"(fq)); const int colw = u.pn * 256 + wc * 32 + 4 * fq;
#pragma unroll
        for (int ai = 0; ai < 2; ++ai)
#pragma unroll
            for (int m = 0; m < 4; ++m) { const int row = row0 + ai * 128 + m * 16; float s = 0.f;
#pragma unroll
                for (int bj = 0; bj < 2; ++bj)
#pragma unroll
                    for (int n = 0; n < 2; ++n) { const size_t off = (size_t)row * DM + colw + bj * 128 + n * 16; const u32x2 w = *(const u32x2*)(X1 + off);
                        f32x4 v = acc[ai][bj][m][n]; v[0] += bflo(w.x); v[1] += bfhi(w.x); v[2] += bflo(w.y); v[3] += bfhi(w.y); s += dot4(v);
                        *(f32x4*)(out + off) = v; }
                s += __shfl_xor(s, 16); s += __shfl_xor(s, 32);
                if (fq == 0) SS2[(size_t)row * 16 + u.pn * 4 + wc] = s; }
    }
};

namespace att {
constexpr int KSLOT = 12288, VSLOT = 8192;
constexpr int L_K = 0, L_V = 2 * KSLOT, L_WS = L_V + 2 * VSLOT, L_OST = L_WS + 8 * 256, L_BIAS = L_OST + 8 * 4096, L_END = L_BIAS + 2560;
static_assert(L_END <= RING_BYTES, "attention LDS");
constexpr int THRL = 8;
#define MFMA32(a, b, c) __builtin_amdgcn_mfma_f32_32x32x16_bf16(a, b, c, 0, 0, 0)
__device__ __forceinline__ int crow(int r, int hi) { return (r & 3) + 8 * (r >> 2) + 4 * hi; }
__device__ __forceinline__ s16x4 vtr(const LAS unsigned char* p) { return __builtin_bit_cast(s16x4, __builtin_amdgcn_ds_read_tr16_b64_v4i16((LAS v4i16_t*)p)); }
__device__ __forceinline__ void glds(const void* g, LAS unsigned char* dst) { __builtin_amdgcn_global_load_lds((const unsigned*)g, (LAS unsigned*)dst, 16, 0, 0); }

struct SoftSt { float mhat, l; f32x16 o[2]; f32x16 negm; };

template <int ND, bool NA>
__device__ __forceinline__ void tile_step(SoftSt& st, const bf16x8 (&qr)[ND], const LAS unsigned char* kb, const LAS unsigned char* vp, LAS float* wsf, int r32, int hi, bool first,
                                          const LAS float* brow, int cs) {
    f32x16 C0, C1;
#pragma unroll
    for (int d0 = 0; d0 < ND; ++d0) {
        const bf16x8 b0 = *(const LAS bf16x8*)(kb + d0 * 2048), b1 = *(const LAS bf16x8*)(kb + d0 * 2048 + 512);
        if (d0 == 0) { C0 = MFMA32(b0, qr[0], st.negm); C1 = MFMA32(b1, qr[0], st.negm); } else { C0 = MFMA32(b0, qr[d0], C0); C1 = MFMA32(b1, qr[d0], C1); }
    }
    if (NA) {
#pragma unroll
        for (int r = 0; r < 16; ++r) { const int kc = (r & 3) + 8 * (r >> 2) + 4 * hi;
            C0[r] = ((unsigned)(kc - cs) < 16u) ? C0[r] + brow[kc] : -INFINITY;
            C1[r] = ((unsigned)(kc + 32 - cs) < 16u) ? C1[r] + brow[kc + 32] : -INFINITY; }
    }
#define MX3(a, b, c) __builtin_fmaxf(__builtin_fmaxf((a), (b)), (c))
    float a = MX3(C0[0], C0[1], C1[0]), b = MX3(C0[2], C0[3], C1[1]); a = MX3(a, C1[2], C1[3]);
#pragma unroll
    for (int r = 4; r < 16; r += 4) { a = MX3(a, C0[r], C0[r + 1]); b = MX3(b, C0[r + 2], C0[r + 3]); a = MX3(a, C1[r], C1[r + 1]); b = MX3(b, C1[r + 2], C1[r + 3]); }
#undef MX3
    float rm = __builtin_fmaxf(a, b);
    { auto rr = __builtin_amdgcn_permlane32_swap(__float_as_uint(rm), __float_as_uint(rm), false, false); rm = __builtin_fmaxf(__uint_as_float(rr[0]), __uint_as_float(rr[1])); }
    bool resc = false;
    if (first || __any(rm > (float)THRL)) {
        const float dl = first ? rm : __builtin_fmaxf(rm, 0.f); st.mhat += dl;
#pragma unroll
        for (int r = 0; r < 16; ++r) { C0[r] -= dl; C1[r] -= dl; st.negm[r] = -st.mhat; }
        const float f = first ? 0.f : __builtin_amdgcn_exp2f(-dl); st.l *= f; if (hi == 0) wsf[r32] = f; resc = true;
    }
    float sacc = 0.f;
#pragma unroll
    for (int r = 0; r < 16; ++r) { C0[r] = __builtin_amdgcn_exp2f(C0[r]); C1[r] = __builtin_amdgcn_exp2f(C1[r]); sacc += C0[r] + C1[r]; }
    st.l += sacc;
    u32x4 pw0, pw1, pw2, pw3;
    pw0 = (u32x4){pk2(C0[0], C0[1]), pk2(C0[2], C0[3]), pk2(C0[4], C0[5]), pk2(C0[6], C0[7])}; pw1 = (u32x4){pk2(C0[8], C0[9]), pk2(C0[10], C0[11]), pk2(C0[12], C0[13]), pk2(C0[14], C0[15])};
    pw2 = (u32x4){pk2(C1[0], C1[1]), pk2(C1[2], C1[3]), pk2(C1[4], C1[5]), pk2(C1[6], C1[7])}; pw3 = (u32x4){pk2(C1[8], C1[9]), pk2(C1[10], C1[11]), pk2(C1[12], C1[13]), pk2(C1[14], C1[15])};
    if (resc) {
#pragma unroll
        for (int r = 0; r < 16; ++r) { const float f = wsf[crow(r, hi)]; st.o[0][r] *= f; st.o[1][r] *= f; }
    }
#pragma unroll
    for (int d0 = 0; d0 < 2; ++d0) {
#pragma unroll
        for (int ks = 0; ks < 4; ++ks) { const s16x4 lo = vtr(vp + d0 * 4096 + ks * 1024), hh = vtr(vp + d0 * 4096 + ks * 1024 + 512);
            const bf16x8 vb = (bf16x8){lo[0], lo[1], lo[2], lo[3], hh[0], hh[1], hh[2], hh[3]};
            const bf16x8 pa = __builtin_bit_cast(bf16x8, ks == 0 ? pw0 : ks == 1 ? pw1 : ks == 2 ? pw2 : pw3);
            st.o[d0] = MFMA32(pa, vb, st.o[d0]); }
    }
}
__device__ __forceinline__ void attn_epilogue(SoftSt& st, LAS unsigned char* lds, int wid, int lane, int r32, int hi, bf16_t* Orow0  , float* SSrow0  ) {
    LAS float* wsf = (LAS float*)(lds + L_WS) + wid * 64;
    { auto rr = __builtin_amdgcn_permlane32_swap(__float_as_uint(st.l), __float_as_uint(st.l), false, false); st.l = __uint_as_float(rr[0]) + __uint_as_float(rr[1]); }
    if (hi == 0) wsf[32 + r32] = st.l;
    LAS bf16_t* stg = (LAS bf16_t*)(lds + L_OST) + wid * 2048;
#pragma unroll
    for (int r = 0; r < 16; ++r) { const int orow = crow(r, hi); const float rl = __builtin_amdgcn_rcpf(wsf[32 + orow]);
        const unsigned w0 = pk2(st.o[0][r] * rl, 0.f), w1 = pk2(st.o[1][r] * rl, 0.f);
        stg[orow * 64 + r32] = (bf16_t)(w0 & 0xffffu); stg[orow * 64 + 32 + r32] = (bf16_t)(w1 & 0xffffu); }
#pragma unroll
    for (int i = 0; i < 4; ++i) { const int row = i * 8 + (lane >> 3), ch = lane & 7; const u32x4 v = *(const LAS u32x4*)(stg + row * 64 + ch * 8);
        float s = 0.f;
#pragma unroll
        for (int j = 0; j < 4; ++j) { const float x = bflo(v[j]), y = bfhi(v[j]); s += x * x + y * y; }
        s += __shfl_xor(s, 1); s += __shfl_xor(s, 2); s += __shfl_xor(s, 4);
        if (ch == 0) SSrow0[(size_t)row * 8] = s;
        *(u32x4*)(Orow0 + (size_t)row * DM + ch * 8) = v; }
}

__device__ __forceinline__ void mla_unit(LAS unsigned char* lds, int rowbase, int S, int h, int q0, const bf16_t* Q, const bf16_t* KN, const bf16_t* KR, const bf16_t* V, bf16_t* AB, float* SSA) {
    const int tid = threadIdx.x, lane = tid & 63, r32 = lane & 31, hi = lane >> 5; const int wid = __builtin_amdgcn_readfirstlane(tid >> 6);
    const bf16_t* ksrc = KN + (size_t)(rowbase + lane) * 512 + h * 64 + wid * 8;
    const bf16_t* rsrc = KR + (size_t)(rowbase + lane) * 32 + (wid & 3) * 8;
    const bf16_t* vsrc = V + (size_t)(rowbase + 16 * (wid & 3) + (lane >> 2)) * 512 + h * 64 + (wid >> 2) * 32 + (lane & 3) * 8;
#define MLA_STAGE(t, s) do { glds(ksrc + (size_t)(t) * 64 * 512, lds + L_K + (s) * KSLOT + wid * 1024); \
        if (wid < 4) glds(rsrc + (size_t)(t) * 64 * 32, lds + L_K + (s) * KSLOT + (8 + wid) * 1024); \
        glds(vsrc + (size_t)(t) * 64 * 512, lds + L_V + (s) * VSLOT + wid * 1024); } while (0)
    const int NT = S / 64;
    MLA_STAGE(0, 0);
    const int qrow = rowbase + q0 + wid * 32;
    bf16x8 qr[6];
#pragma unroll
    for (int d0 = 0; d0 < 6; ++d0) qr[d0] = *(const bf16x8*)(Q + (size_t)(qrow + r32) * 768 + h * 96 + d0 * 16 + hi * 8);
    SoftSt st; st.mhat = 0.f; st.l = 0.f; st.o[0] = f32x16{}; st.o[1] = f32x16{}; st.negm = f32x16{};
    LAS float* wsf = (LAS float*)(lds + L_WS) + wid * 64;
    const int kboff = hi * 1024 + r32 * 16, vpoff = ((lane >> 4) & 1) * 32 + (lane & 3) * 8 + (4 * hi + ((lane & 15) >> 2)) * 64;
    asm volatile("s_waitcnt vmcnt(0)" ::: "memory"); __syncthreads();
    for (int t = 0; t < NT; ++t) {
        const int s = t & 1;
        if (t + 1 < NT) MLA_STAGE(t + 1, s ^ 1);
        tile_step<6, false>(st, qr, lds + L_K + s * KSLOT + kboff, lds + L_V + s * VSLOT + vpoff, wsf, r32, hi, t == 0, nullptr, 0);
        asm volatile("s_waitcnt vmcnt(0)" ::: "memory"); __syncthreads();
    }
#undef MLA_STAGE
    attn_epilogue(st, lds, wid, lane, r32, hi, AB + (size_t)qrow * DM + h * 64, SSA + (size_t)qrow * 8 + h);
}

__device__ __forceinline__ void na_unit(LAS unsigned char* lds, int rowbase, int rows, int h, int R0, const bf16_t* NAB, const float* rpb, bf16_t* AB, float* SSB) {
    const int tid = threadIdx.x, lane = tid & 63, r32 = lane & 31, hi = lane >> 5; const int wid = __builtin_amdgcn_readfirstlane(tid >> 6);
    LAS float* tab = (LAS float*)(lds + L_BIAS);
    for (int i = tid; i < 640; i += 512) { const int j = i - 48; tab[i] = (j >= 0 && j < 465) ? rpb[h * 465 + j] * LOG2E : 0.f; }
    const int r = R0 + (wid >> 1), qh = wid & 1;
    const int start_w = min(max(r - 4, 0), rows - 8);
    const int u_lo = min(max(R0 - 4, 0), rows - 8), u_hi = min(max(R0 - 1, 0), rows - 8) + 8;
    const bf16_t* ksrc = NAB + (size_t)(rowbase + lane) * 1536 + 512 + h * 64 + wid * 8;
    const bf16_t* vsrc = NAB + (size_t)(rowbase + 16 * (wid & 3) + (lane >> 2)) * 1536 + 1024 + h * 64 + (wid >> 2) * 32 + (lane & 3) * 8;
#define NA_STAGE(u, s) do { glds(ksrc + (size_t)(u) * 64 * 1536, lds + L_K + (s) * KSLOT + wid * 1024); glds(vsrc + (size_t)(u) * 64 * 1536, lds + L_V + (s) * VSLOT + wid * 1024); } while (0)
    NA_STAGE(u_lo, 0);
    const int qrow = rowbase + r * 64 + qh * 32;
    bf16x8 qr[4];
#pragma unroll
    for (int d0 = 0; d0 < 4; ++d0) qr[d0] = *(const bf16x8*)(NAB + (size_t)(qrow + r32) * 1536 + h * 64 + d0 * 16 + hi * 8);
    SoftSt st; st.mhat = 0.f; st.l = 0.f; st.o[0] = f32x16{}; st.o[1] = f32x16{}; st.negm = f32x16{};
    LAS float* wsf = (LAS float*)(lds + L_WS) + wid * 64;
    const int kboff = hi * 1024 + r32 * 16, vpoff = ((lane >> 4) & 1) * 32 + (lane & 3) * 8 + (4 * hi + ((lane & 15) >> 2)) * 64;
    const int qc = qh * 32 + r32, cs = min(max(qc - 8, 0), 48);
    asm volatile("s_waitcnt vmcnt(0)" ::: "memory"); __syncthreads();
    const int NT = u_hi - u_lo;
    for (int i = 0; i < NT; ++i) {
        const int s = i & 1, u = u_lo + i;
        if (i + 1 < NT) NA_STAGE(u + 1, s ^ 1);
        if (u >= start_w && u < start_w + 8)
            tile_step<4, true>(st, qr, lds + L_K + s * KSLOT + kboff, lds + L_V + s * VSLOT + vpoff, wsf, r32, hi, u == start_w, tab + 48 + (u - r + 7) * 31 + 15 - qc, cs);
        asm volatile("s_waitcnt vmcnt(0)" ::: "memory"); __syncthreads();
    }
#undef NA_STAGE
    attn_epilogue(st, lds, wid, lane, r32, hi, AB + (size_t)qrow * DM + 512 + h * 64, SSB + (size_t)qrow * 8 + h);
}
}

__device__ __forceinline__ float wave_sum(float v) {
#pragma unroll
    for (int o = 1; o < 64; o <<= 1) v += __shfl_xor(v, o);
    return v;
}
__device__ __forceinline__ int ropeperm(int p) { return 16 * ((p >> 2) & 1) + 4 * (p >> 3) + (p & 3); }
struct MapIn  { __device__ int operator()(int n) const { if (n < 640) return n; if (n < 672) return 640 + ropeperm(n - 640); if (n < 768) return -1; return n - 96; } };
struct MapUq  { __device__ int operator()(int n) const { const int h = n / 96, w = n - 96 * h; return w < 64 ? n : 96 * h + 64 + ropeperm(w - 64); } };
struct MapId  { __device__ int operator()(int n) const { return n; } };
struct MapGU  { __device__ int operator()(int n) const { const int pn = n >> 8, w = n & 255; return w < 128 ? 128 * pn + w : DFF + 128 * pn + (w - 128); } };
template <class Map>
__device__ __forceinline__ void wt_item(const float* W, const float* W2, int K, int N, bf16_t* WT, const float* g0, const float* g1, int ksplit, LAS float* scr, int item, int nblk, int lane, Map map) {
    const int kb = item / nblk, nb = item % nblk, k0 = 64 * kb, n0 = 32 * nb;
    int src = map(n0 + (lane & 31)); const float* Wsrc = W; if (W2 && src >= N) { Wsrc = W2; src -= N; }
#pragma unroll 8
    for (int i = 0; i < 32; ++i) { const int kk = 2 * i + (lane >> 5), k = k0 + kk; float v = src >= 0 ? Wsrc[(size_t)k * N + src] : 0.f;
        if (g0) v *= (k < ksplit ? g0[k] : g1[k - ksplit]);
        scr[kk * 33 + (lane & 31)] = v; }
    asm volatile("s_waitcnt lgkmcnt(0)" ::: "memory");
    const int c = lane & 7;
#pragma unroll
    for (int j = 0; j < 4; ++j) { const int n = (lane >> 3) + 8 * j; const LAS float* s = scr + (8 * c) * 33 + n;
        u32x4 o; o.x = pk2(s[0 * 33], s[1 * 33]); o.y = pk2(s[2 * 33], s[3 * 33]); o.z = pk2(s[4 * 33], s[5 * 33]); o.w = pk2(s[6 * 33], s[7 * 33]);
        *(u32x4*)(WT + (size_t)(n0 + n) * K + k0 + 8 * c) = o; }
    asm volatile("s_waitcnt lgkmcnt(0)" ::: "memory");
}
__device__ __forceinline__ void sincos_d(float ang, float& sn, float& cs) {
    const double a = (double)ang; const double k = __builtin_rint(a * 0.15915494309189535); const double r = a - k * 6.283185307179586 ; const double r2 = r * r;
    double ts = 1.0, tc = 1.0, s = 1.0, c = 1.0;
#pragma unroll
    for (int n = 1; n <= 13; ++n) { tc = -tc * r2 / (double)((2 * n - 1) * (2 * n)); ts = -ts * r2 / (double)((2 * n) * (2 * n + 1)); c += tc; s += ts; }
    sn = (float)(s * r); cs = (float)c;
}

struct Args { const float* in[17]; float* out; unsigned char* ws; int ph_lo, ph_hi; };
constexpr int NPHASE = 8;

__global__ void __launch_bounds__(512, 2) mega(Args args) {
    extern __shared__ __attribute__((aligned(16))) unsigned char lds_raw[];
    LAS unsigned char* lds = (LAS unsigned char*)lds_raw;
    const int tid = threadIdx.x, lane = tid & 63, wave = __builtin_amdgcn_readfirstlane(tid >> 6);
    const int G = gridDim.x, bx = blockIdx.x; const int vcu = (G % 8 == 0) ? (bx % 8) * (G / 8) + bx / 8 : bx;
    unsigned char* ws = args.ws;
    const float *xp = args.in[0], *xs = args.in[1];
    float* COS = (float*)(ws + WS_COS); float* SIN = (float*)(ws + WS_SIN);
    bf16_t *WIN = (bf16_t*)(ws + WS_WIN), *WUQ = (bf16_t*)(ws + WS_WUQ), *WUKV = (bf16_t*)(ws + WS_WUKV), *WO = (bf16_t*)(ws + WS_WO), *WGU = (bf16_t*)(ws + WS_WGU), *WD = (bf16_t*)(ws + WS_WD);
    float *SSQ = (float*)(ws + WS_SSQ), *SSKV = (float*)(ws + WS_SSKV), *SSA = (float*)(ws + WS_SSA), *SSB = (float*)(ws + WS_SSB), *SS1 = (float*)(ws + WS_SS1), *SS2 = (float*)(ws + WS_SS2);
    bf16_t *H = (bf16_t*)(ws + WS_H), *AB = (bf16_t*)(ws + WS_AB), *CQ = (bf16_t*)(ws + WS_CQ), *CKV = (bf16_t*)(ws + WS_CKV), *KR = (bf16_t*)(ws + WS_KR), *NAB = (bf16_t*)(ws + WS_NA);
    bf16_t *Qb = (bf16_t*)(ws + WS_Q), *KN = (bf16_t*)(ws + WS_KN), *Vb = (bf16_t*)(ws + WS_V), *X1 = (bf16_t*)(ws + WS_X1), *ACT = (bf16_t*)(ws + WS_ACT);
    const int lo = args.ph_lo, hi = args.ph_hi;
#ifndef PH_MASK
#define PH_MASK 0xff
#endif
#define IN(k) (((PH_MASK >> (k)) & 1) && lo <= (k) && (k) < hi)
#define SEAM(k) do { if (IN(k) && IN((k) + 1)) { cg::this_grid().sync(); } } while (0)

    if (IN(0)) {
        LAS float* scr = (LAS float*)(lds + wave * 16384);
        const int gw = vcu * 8 + wave, NGW = G * 8;
        constexpr int I_IN = (DM / 64) * (N1P / 32), I_UQ = (QL / 64) * (768 / 32), I_UKV = (KVL / 64) * (1024 / 32), I_O = (DM / 64) * (DM / 32), I_GU = (DM / 64) * (NGU / 32), I_D = (DFF / 64) * (DM / 32);
        constexpr int NITEMS = I_IN + I_UQ + I_UKV + I_O + I_GU + I_D;
        for (int it = gw; it < NITEMS; it += NGW) {
            int r = it;
            if (r < I_IN) { wt_item(args.in[3], nullptr, DM, NIN, WIN, nullptr, nullptr, 0, scr, r, N1P / 32, lane, MapIn()); continue; } r -= I_IN;
            if (r < I_UQ) { wt_item(args.in[6], nullptr, QL, 768, WUQ, args.in[4], args.in[4], QL, scr, r, 768 / 32, lane, MapUq()); continue; } r -= I_UQ;
            if (r < I_UKV) { wt_item(args.in[7], nullptr, KVL, 1024, WUKV, args.in[5], args.in[5], KVL, scr, r, 1024 / 32, lane, MapId()); continue; } r -= I_UKV;
            if (r < I_O) { wt_item(args.in[11], nullptr, DM, DM, WO, args.in[9], args.in[10], 512, scr, r, DM / 32, lane, MapId()); continue; } r -= I_O;
            if (r < I_GU) { wt_item(args.in[13], args.in[14], DM, DFF, WGU, args.in[12], args.in[12], DM, scr, r, NGU / 32, lane, MapGU()); continue; } r -= I_GU;
            wt_item(args.in[15], nullptr, DFF, DM, WD, nullptr, nullptr, 0, scr, r, DM / 32, lane, MapId());
        }
        for (int i = bx * 512 + tid; i < SEQS * 16; i += G * 512) { const int pos = i >> 4, j = i & 15;
            double inv = 1.0; for (int q = 0; q < j; ++q) inv *= 0.5623413251903491;
            const float ang = (float)pos * (float)inv; float sn, cs; sincos_d(ang, sn, cs); COS[i] = cs; SIN[i] = sn; }
        const float* g = args.in[2];
        f32x4 gv[4];
#pragma unroll
        for (int j = 0; j < 4; ++j) gv[j] = *(const f32x4*)(g + 4 * lane + 256 * j);
        for (int m = gw; m < TOK; m += NGW) {
            const float* xr = (m < TOKP ? xp + (size_t)m * DM : xs + (size_t)(m - TOKP) * DM) + 4 * lane;
            f32x4 v[4]; float s = 0.f;
#pragma unroll
            for (int j = 0; j < 4; ++j) { v[j] = *(const f32x4*)(xr + 256 * j); s += dot4(v[j]); }
            const float rstd = 1.0f / sqrtf(wave_sum(s) * (1.0f / DM) + EPS);
#pragma unroll
            for (int j = 0; j < 4; ++j) { const f32x4 o = v[j] * rstd * gv[j]; u32x2 w; w.x = pk2(o[0], o[1]); w.y = pk2(o[2], o[3]); *(u32x2*)(H + (size_t)m * DM + 4 * lane + 256 * j) = w; }
        }
    }
    SEAM(0);
    if (IN(1)) {
        pg8::Gemm g{H, WIN, TOK, N1P, DM}; pg8::StaticOrder S; S.init(TOK, N1P, G, bx);
        Epi1 E{CQ, CKV, KR, NAB, SSQ, SSKV, COS, SIN};
        pg8::gemm_phase<Epi1, true>(lds, g, S, E);
    }
    SEAM(1);
    if (IN(2)) {
        { pg8::Gemm g{CQ, WUQ, TOK, 768, QL}; pg8::StaticOrder S; S.init(TOK, 768, G, bx); Epi2 E{Qb, SSQ, COS, SIN}; pg8::gemm_phase<Epi2, true>(lds, g, S, E); }
        { pg8::Gemm g{CKV, WUKV, TOK, 1024, KVL}; pg8::StaticOrder S; S.init(TOK, 1024, G, bx); Epi3 E{KN, Vb, SSKV}; pg8::gemm_phase<Epi3, true>(lds, g, S, E); }
    }
    SEAM(2);
    if (IN(3)) {
        if (G == 256) {
            const int x = vcu >> 5, j = vcu & 31;
            for (int i = 0; i < 2; ++i) { const int pair = 2 * x + i; att::mla_unit(lds, TOKP + (pair >> 3) * SEQS, SEQS, pair & 7, j * 256, Qb, KN, KR, Vb, AB, SSA); }
            for (int i = 0; i < 4; ++i) { const int L = 4 * j + i, pair = 16 * x + (L >> 3); att::mla_unit(lds, (pair >> 3) * SEQP, SEQP, pair & 7, (L & 7) * 256, Qb, KN, KR, Vb, AB, SSA); }
        } else {
            for (int U = vcu; U < 512; U += G) { const int pair = U >> 5; att::mla_unit(lds, TOKP + (pair >> 3) * SEQS, SEQS, pair & 7, (U & 31) * 256, Qb, KN, KR, Vb, AB, SSA); }
            for (int U = vcu; U < 1024; U += G) { const int pair = U >> 3; att::mla_unit(lds, (pair >> 3) * SEQP, SEQP, pair & 7, (U & 7) * 256, Qb, KN, KR, Vb, AB, SSA); }
        }
        for (int U = vcu; U < 1536; U += G) {
            if (U < 1024) { const int h = U & 7, grp = U >> 3; att::na_unit(lds, (grp >> 3) * SEQP, 32, h, (grp & 7) * 4, NAB, args.in[8], AB, SSB); }
            else { const int U2 = U - 1024, h = U2 & 7, grp = U2 >> 3; att::na_unit(lds, TOKP + (grp >> 5) * SEQS, 128, h, (grp & 31) * 4, NAB, args.in[8], AB, SSB); }
        }
    }
    SEAM(3);
    if (IN(4)) {
        pg8::Gemm g{AB, WO, TOK, DM, DM}; pg8::StaticOrder S; S.init(TOK, DM, G, bx);
        Epi4 E{xp, xs, X1, SSA, SSB, SS1};
        pg8::gemm_phase<Epi4, true>(lds, g, S, E);
    }
    SEAM(4);
    if (IN(5)) {
        pg8::Gemm g{X1, WGU, TOK, NGU, DM}; pg8::StaticOrder S; S.init(TOK, NGU, G, bx);
        Epi5 E{ACT, SS1};
        pg8::gemm_phase<Epi5, true>(lds, g, S, E);
    }
    SEAM(5);
    if (IN(6)) {
        pg8::Gemm g{ACT, WD, TOK, DM, DFF}; pg8::StaticOrder S; S.init(TOK, DM, G, bx);
        Epi6 E{X1, args.out, SS2};
        pg8::gemm_phase<Epi6, true>(lds, g, S, E);
    }
    SEAM(6);
    if (IN(7)) {
        const int gw = vcu * 8 + wave, NGW = G * 8; const float* g = args.in[16];
        f32x4 gv[4];
#pragma unroll
        for (int j = 0; j < 4; ++j) gv[j] = *(const f32x4*)(g + 4 * lane + 256 * j);
        for (int m = gw; m < TOK; m += NGW) { float* o = args.out + (size_t)m * DM + 4 * lane; const float r = rstd16(SS2 + (size_t)m * 16);
#pragma unroll
            for (int j = 0; j < 4; ++j) { const f32x4 v = *(const f32x4*)(o + 256 * j); *(f32x4*)(o + 256 * j) = v * r * gv[j]; } }
    }
#undef IN
#undef SEAM
}

#if MK_DEBUG
__device__ __forceinline__ float block_sum(float v, LAS float* red) {
    v = wave_sum(v); __syncthreads(); if ((threadIdx.x & 63) == 0) red[threadIdx.x >> 6] = v; __syncthreads(); const float r = (red[0] + red[1]) + (red[2] + red[3]); __syncthreads(); return r;
}
__device__ __forceinline__ void report(unsigned* ctl, int phase, float rel2) {
    if (!(rel2 < 2e-4f)) { const int b = !(rel2 == rel2) ? 9 : rel2 < 1e-3f ? 1 : rel2 < 1e-2f ? 2 : rel2 < 1e-1f ? 3 : rel2 < 0.5f ? 4 : rel2 < 2.f ? 5 : 6; atomicMax(ctl + CW_FAIL, (unsigned)((8 - phase) * 16 + b)); }
}
__device__ __forceinline__ int chk_row(int b) { const int t = b >> 8; return (t == 0 ? 0 : t == 1 ? 77 : t == 2 ? 130 : 191) * 256 + (b & 255); }
__device__ __forceinline__ void rope_ref(int pos, int j, float& sn, float& cs) { const float inv = __powf(10000.0f, -(float)j / 16.0f); const float ang = (float)pos * inv; const double a = (double)ang; const double r = a - __builtin_rint(a * 0.15915494309189535) * 6.283185307179586; sn = __sinf((float)r); cs = __cosf((float)r); }

__global__ void __launch_bounds__(256) chk_phase(Args args, int phase) {
    __shared__ float buf[5632]; __shared__ float inb[2816]; __shared__ float red4[4];
    LAS float* red = (LAS float*)red4;
    unsigned char* ws = args.ws; unsigned* ctl = (unsigned*)(ws + WS_CTL);
    const int tid = threadIdx.x; const int row = chk_row(blockIdx.x);
    const float* xrow = row < TOKP ? args.in[0] + (size_t)row * DM : args.in[1] + (size_t)(row - TOKP) * DM;
    const bf16_t *H = (const bf16_t*)(ws + WS_H), *AB = (const bf16_t*)(ws + WS_AB), *CQ = (const bf16_t*)(ws + WS_CQ), *CKV = (const bf16_t*)(ws + WS_CKV), *KR = (const bf16_t*)(ws + WS_KR), *NAB = (const bf16_t*)(ws + WS_NA);
    const bf16_t *Qb = (const bf16_t*)(ws + WS_Q), *KN = (const bf16_t*)(ws + WS_KN), *Vb = (const bf16_t*)(ws + WS_V), *X1 = (const bf16_t*)(ws + WS_X1), *ACT = (const bf16_t*)(ws + WS_ACT);
    float d2 = 0.f, e2 = 0.f;
    if (phase == 0) {
        float s = 0.f; for (int k = tid; k < DM; k += 256) s += xrow[k] * xrow[k];
        const float rstd = rsqrtf(block_sum(s, red) / DM + EPS);
        for (int k = tid; k < DM; k += 256) { const float e = xrow[k] * rstd * args.in[2][k], f = bf2f(H[(size_t)row * DM + k]); d2 += (f - e) * (f - e); e2 += e * e; }
    } else if (phase == 1) {
        for (int k = tid; k < DM; k += 256) inb[k] = bf2f(H[(size_t)row * DM + k]);
        __syncthreads();
        for (int n = tid; n < NIN; n += 256) { float a = 0.f; for (int k = 0; k < DM; ++k) a += inb[k] * args.in[3][(size_t)k * NIN + n]; buf[n] = a; }
        __syncthreads();
        const int pos = seq_pos(row);
        for (int n = tid; n < NIN; n += 256) { float e, f;
            if (n < 384) { e = buf[n]; f = bf2f(CQ[(size_t)row * QL + n]); }
            else if (n < 640) { e = buf[n]; f = bf2f(CKV[(size_t)row * KVL + n - 384]); }
            else if (n < 672) { const int j = n - 640, jj = j & 15; float sn, cs; rope_ref(pos, jj, sn, cs); const float x1 = buf[640 + jj], x2 = buf[656 + jj]; e = j < 16 ? x1 * cs - x2 * sn : x1 * sn + x2 * cs; f = bf2f(KR[(size_t)row * 32 + j]); }
            else { const int c = n - 672; e = buf[n] * (c < 512 ? QSC_NA : 1.f); f = bf2f(NAB[(size_t)row * 1536 + c]); }
            d2 += (f - e) * (f - e); e2 += e * e; }
        float sq = 0.f, sk = 0.f; for (int n = tid; n < 640; n += 256) { if (n < 384) sq += buf[n] * buf[n]; else sk += buf[n] * buf[n]; }
        sq = block_sum(sq, red); sk = block_sum(sk, red);
        if (tid == 0) { float fq = 0.f, fk = 0.f; for (int i = 0; i < 12; ++i) fq += ((const float*)(ws + WS_SSQ))[(size_t)row * 12 + i]; for (int i = 0; i < 8; ++i) fk += ((const float*)(ws + WS_SSKV))[(size_t)row * 8 + i];
            const float rq = (fq - sq) / sq, rk = (fk - sk) / sk; report(ctl, 1, rq * rq + rk * rk); }
    } else if (phase == 2) {
        float s = 0.f; for (int k = tid; k < QL; k += 256) { const float v = bf2f(CQ[(size_t)row * QL + k]); inb[k] = v; s += v * v; }
        float s2 = 0.f; for (int k = tid; k < KVL; k += 256) { const float v = bf2f(CKV[(size_t)row * KVL + k]); inb[512 + k] = v; s2 += v * v; }
        const float rq = rsqrtf(block_sum(s, red) / QL + EPS), rk = rsqrtf(block_sum(s2, red) / KVL + EPS);
        for (int k = tid; k < QL; k += 256) inb[k] *= rq * args.in[4][k];
        for (int k = tid; k < KVL; k += 256) inb[512 + k] *= rk * args.in[5][k];
        __syncthreads();
        for (int n = tid; n < 768; n += 256) { float a = 0.f; for (int k = 0; k < QL; ++k) a += inb[k] * args.in[6][(size_t)k * 768 + n]; buf[n] = a; }
        for (int n = tid; n < 1024; n += 256) { float a = 0.f; for (int k = 0; k < KVL; ++k) a += inb[512 + k] * args.in[7][(size_t)k * 1024 + n]; buf[1024 + n] = a; }
        __syncthreads();
        const int pos = seq_pos(row);
        for (int n = tid; n < 768; n += 256) { const int h = n / 96, w = n - 96 * h; float e;
            if (w < 64) e = buf[n]; else { const int j = w - 64, jj = j & 15; float sn, cs; rope_ref(pos, jj, sn, cs); const float x1 = buf[h * 96 + 64 + jj], x2 = buf[h * 96 + 80 + jj]; e = j < 16 ? x1 * cs - x2 * sn : x1 * sn + x2 * cs; }
            e *= QSC_MLA; const float f = bf2f(Qb[(size_t)row * 768 + n]); d2 += (f - e) * (f - e); e2 += e * e; }
        for (int n = tid; n < 1024; n += 256) { const int h = n >> 7, w = n & 127; const float e = buf[1024 + n]; const float f = w < 64 ? bf2f(KN[(size_t)row * 512 + h * 64 + w]) : bf2f(Vb[(size_t)row * 512 + h * 64 + w - 64]); d2 += (f - e) * (f - e); e2 += e * e; }
    } else if (phase == 4) {
        float sa = 0.f, sb = 0.f; for (int k = tid; k < DM; k += 256) { const float v = bf2f(AB[(size_t)row * DM + k]); inb[k] = v; if (k < 512) sa += v * v; else sb += v * v; }
        const float ra = rsqrtf(block_sum(sa, red) / 512 + EPS), rb = rsqrtf(block_sum(sb, red) / 512 + EPS);
        for (int k = tid; k < DM; k += 256) inb[k] *= (k < 512 ? ra * args.in[9][k] : rb * args.in[10][k - 512]);
        __syncthreads();
        for (int n = tid; n < DM; n += 256) { float a = 0.f; for (int k = 0; k < DM; ++k) a += inb[k] * args.in[11][(size_t)k * DM + n]; const float e = xrow[n] + a, f = bf2f(X1[(size_t)row * DM + n]); d2 += (f - e) * (f - e); e2 += e * e; }
    } else if (phase == 5) {
        float s = 0.f; for (int k = tid; k < DM; k += 256) { const float v = bf2f(X1[(size_t)row * DM + k]); inb[k] = v; s += v * v; }
        const float r = rsqrtf(block_sum(s, red) / DM + EPS);
        for (int k = tid; k < DM; k += 256) inb[k] *= r * args.in[12][k];
        __syncthreads();
        for (int n = tid; n < DFF; n += 256) { float a = 0.f, b = 0.f; for (int k = 0; k < DM; ++k) { a += inb[k] * args.in[13][(size_t)k * DFF + n]; b += inb[k] * args.in[14][(size_t)k * DFF + n]; }
            const float e = a / (1.f + __expf(-a)) * b, f = bf2f(ACT[(size_t)row * DFF + n]); d2 += (f - e) * (f - e); e2 += e * e; }
    } else if (phase == 7) {
        for (int k = tid; k < DFF; k += 256) inb[k] = bf2f(ACT[(size_t)row * DFF + k]);
        __syncthreads();
        float s = 0.f;
        for (int n = tid; n < DM; n += 256) { float a = 0.f; for (int k = 0; k < DFF; ++k) a += inb[k] * args.in[15][(size_t)k * DM + n]; const float v = bf2f(X1[(size_t)row * DM + n]) + a; buf[n] = v; s += v * v; }
        const float r = rsqrtf(block_sum(s, red) / DM + EPS);
        for (int n = tid; n < DM; n += 256) { const float e = buf[n] * r * args.in[16][n], f = args.out[(size_t)row * DM + n]; d2 += (f - e) * (f - e); e2 += e * e; }
    }
    d2 = block_sum(d2, red); e2 = block_sum(e2, red);
    if (tid == 0) report(ctl, phase, d2 / e2);
}
__global__ void __launch_bounds__(64) chk_attn(Args args) {
    __shared__ float sc[8192]; __shared__ float qv[96];
    unsigned char* ws = args.ws; unsigned* ctl = (unsigned*)(ws + WS_CTL);
    const bf16_t *AB = (const bf16_t*)(ws + WS_AB), *KR = (const bf16_t*)(ws + WS_KR), *NAB = (const bf16_t*)(ws + WS_NA), *Qb = (const bf16_t*)(ws + WS_Q), *KN = (const bf16_t*)(ws + WS_KN), *Vb = (const bf16_t*)(ws + WS_V);
    const int sidx = blockIdx.x >> 1, kind = blockIdx.x & 1, lane = threadIdx.x;
    const int row = (int)(((long)sidx * 2731 + 17) % TOK), h = (sidx / 3) & 7;
    const int rowbase = row < TOKP ? (row / SEQP) * SEQP : TOKP + ((row - TOKP) / SEQS) * SEQS, S = row < TOKP ? SEQP : SEQS, t = row - rowbase;
    float o = 0.f, e2 = 0.f, d2 = 0.f;
    if (kind == 0) {
        for (int d = lane; d < 96; d += 64) qv[d] = bf2f(Qb[(size_t)row * 768 + h * 96 + d]);
        __syncthreads();
        float mx = -INFINITY;
        for (int j = lane; j < S; j += 64) { float s = 0.f; const bf16_t* kn = KN + (size_t)(rowbase + j) * 512 + h * 64; const bf16_t* kr = KR + (size_t)(rowbase + j) * 32;
            for (int d = 0; d < 64; ++d) s += qv[d] * bf2f(kn[d]); for (int d = 0; d < 32; ++d) s += qv[64 + d] * bf2f(kr[d]); sc[j] = s; mx = fmaxf(mx, s); }
        for (int of = 1; of < 64; of <<= 1) mx = fmaxf(mx, __shfl_xor(mx, of));
        float l = 0.f; for (int j = lane; j < S; j += 64) { const float p = exp2f(sc[j] - mx); sc[j] = p; l += p; }
        l = wave_sum(l); __syncthreads();
        for (int j = 0; j < S; ++j) o += sc[j] * bf2f(Vb[(size_t)(rowbase + j) * 512 + h * 64 + lane]);
        o /= l; const float f = bf2f(AB[(size_t)row * DM + h * 64 + lane]); d2 = (f - o) * (f - o); e2 = o * o;
        const float ssf = ((const float*)(ws + WS_SSA))[(size_t)row * 8 + h]; d2 = wave_sum(d2); e2 = wave_sum(e2);
        if (lane == 0) { const float rs = (ssf - e2) / e2; report(ctl, 3, d2 / e2 + (fabsf(rs) > 0.05f ? rs * rs : 0.f)); }
    } else {
        const int rows = S / 64, r = t >> 6, qc = t & 63; const int start = min(max(r - 4, 0), rows - 8), cs = min(max(qc - 8, 0), 48);
        for (int d = lane; d < 64; d += 64) qv[d] = bf2f(NAB[(size_t)row * 1536 + h * 64 + d]);
        __syncthreads();
        float mx = -INFINITY;
        for (int j = lane; j < 128; j += 64) { const int kr_ = start + (j >> 4), kc = cs + (j & 15); const bf16_t* kp = NAB + (size_t)(rowbase + kr_ * 64 + kc) * 1536 + 512 + h * 64;
            float s = 0.f; for (int d = 0; d < 64; ++d) s += qv[d] * bf2f(kp[d]);
            s += args.in[8][h * 465 + (kr_ - r + 7) * 31 + (kc - qc + 15)] * LOG2E; sc[j] = s; mx = fmaxf(mx, s); }
        for (int of = 1; of < 64; of <<= 1) mx = fmaxf(mx, __shfl_xor(mx, of));
        float l = 0.f; for (int j = lane; j < 128; j += 64) { const float p = exp2f(sc[j] - mx); sc[j] = p; l += p; }
        l = wave_sum(l); __syncthreads();
        for (int j = 0; j < 128; ++j) { const int kr_ = start + (j >> 4), kc = cs + (j & 15); o += sc[j] * bf2f(NAB[(size_t)(rowbase + kr_ * 64 + kc) * 1536 + 1024 + h * 64 + lane]); }
        o /= l; const float f = bf2f(AB[(size_t)row * DM + 512 + h * 64 + lane]); d2 = (f - o) * (f - o); e2 = o * o;
        const float ssf = ((const float*)(ws + WS_SSB))[(size_t)row * 8 + h]; d2 = wave_sum(d2); e2 = wave_sum(e2);
        if (lane == 0) { const float rs = (ssf - e2) / e2; report(ctl, 3, d2 / e2 + (fabsf(rs) > 0.05f ? rs * rs : 0.f)); }
    }
}
__global__ void __launch_bounds__(256) chk_final(Args args) {
    const unsigned code = ((const unsigned*)(args.ws + WS_CTL))[CW_FAIL];
    if (code == 0) return;
    const int k = 8 - (int)(code >> 4), b = (int)(code & 15); const float c = sqrtf(1.0f + (float)k + 0.1f * (float)b);
    for (size_t i = (size_t)blockIdx.x * 256 + threadIdx.x; i < (size_t)TOK * DM; i += (size_t)gridDim.x * 256) args.out[i] = c;
}
#endif

extern "C" void kernel_launch(void* const* d_in, const int* in_sizes, int n_in, void* d_out, int out_size, void* d_ws, size_t ws_size, hipStream_t stream) {
    static int grid = 0;
    if (grid == 0) {
        if (n_in != 17 || out_size != TOK * DM || ws_size < WS_NEED) { fprintf(stderr, "kernel_launch: unexpected problem (n_in %d, out %d, ws %zu; need %zu)\n", n_in, out_size, ws_size, (size_t)WS_NEED); grid = -1; return; }
        int dev = 0, cus = 0, per_cu = 0;
        hipGetDevice(&dev); hipDeviceGetAttribute(&cus, hipDeviceAttributeMultiprocessorCount, dev);
        if (hipFuncSetAttribute((const void*)mega, hipFuncAttributeMaxDynamicSharedMemorySize, LDS_BYTES) != hipSuccess) { fprintf(stderr, "kernel_launch: hipFuncSetAttribute failed\n"); grid = -1; return; }
        if (hipOccupancyMaxActiveBlocksPerMultiprocessor(&per_cu, (const void*)mega, 512, LDS_BYTES) != hipSuccess || per_cu < 1) { fprintf(stderr, "kernel_launch: occupancy query says %d\n", per_cu); per_cu = 1; }
        (void)hipGetLastError();
        grid = cus * 1;
    }
    if (grid < 0) return;
    hipMemsetAsync((char*)d_ws + WS_CTL, 0, CTL_ZERO_BYTES, stream);
    Args a{};
    for (int i = 0; i < 17; ++i) a.in[i] = (const float*)d_in[i];
    a.out = (float*)d_out; a.ws = (unsigned char*)d_ws;
#if MK_ONE_LAUNCH
    a.ph_lo = 0; a.ph_hi = NPHASE;
    void* kargs[] = {&a};
    hipError_t e = hipLaunchCooperativeKernel((const void*)mega, dim3(grid), dim3(512), kargs, LDS_BYTES, stream);
    if (e != hipSuccess) fprintf(stderr, "kernel_launch: cooperative launch failed: %s (grid %d)\n", hipGetErrorString(e), grid);
#else
    for (int ph = 0; ph < NPHASE; ++ph) {
        a.ph_lo = ph; a.ph_hi = ph + 1;
        hipLaunchKernelGGL(mega, dim3(grid), dim3(512), LDS_BYTES, stream, a);
#if MK_DEBUG
        if (ph == 3) hipLaunchKernelGGL(chk_attn, dim3(2 * 1536), dim3(64), 0, stream, a);
        else if (ph != 6) hipLaunchKernelGGL(chk_phase, dim3(1024), dim3(256), 0, stream, a, ph);
#endif
    }
#if MK_DEBUG
    hipLaunchKernelGGL(chk_final, dim3(2048), dim3(256), 0, stream, a);
#endif
#endif
}
```

```cpp
#include <hip/hip_runtime.h>
#include <hip/hip_cooperative_groups.h>
#include <cstdio>
#include <cstdint>
namespace cg = cooperative_groups;

#ifndef MK_ONE_LAUNCH
#define MK_ONE_LAUNCH 1
#endif
#ifndef MK_DEBUG
#define MK_DEBUG 0
#endif

#define GAS __attribute__((address_space(1)))
#define LAS __attribute__((address_space(3)))
typedef unsigned short bf16_t;
typedef short bf16x8 __attribute__((ext_vector_type(8)));
typedef short s16x4 __attribute__((ext_vector_type(4)));
typedef short v4i16_t __attribute__((ext_vector_type(4)));
typedef float f32x2 __attribute__((ext_vector_type(2)));
typedef float f32x4 __attribute__((ext_vector_type(4)));
typedef float f32x16 __attribute__((ext_vector_type(16)));
typedef unsigned u32x2 __attribute__((ext_vector_type(2)));
typedef unsigned u32x4 __attribute__((ext_vector_type(4)));
typedef __bf16 bf16x2_t __attribute__((ext_vector_type(2)));

__device__ __forceinline__ unsigned pk2(float lo, float hi) { f32x2 v = {lo, hi}; bf16x2_t b = __builtin_convertvector(v, bf16x2_t); return __builtin_bit_cast(unsigned, b); }
__device__ __forceinline__ float bf2f(unsigned b) { return __builtin_bit_cast(float, b << 16); }
__device__ __forceinline__ float bflo(unsigned w) { return __builtin_bit_cast(float, w << 16); }
__device__ __forceinline__ float bfhi(unsigned w) { return __builtin_bit_cast(float, w & 0xffff0000u); }
__device__ __forceinline__ u32x4 pack8(f32x4 a, f32x4 b) { u32x4 w; w.x = pk2(a[0], a[1]); w.y = pk2(a[2], a[3]); w.z = pk2(b[0], b[1]); w.w = pk2(b[2], b[3]); return w; }
__device__ __forceinline__ float sum4(f32x4 v) { return (v[0] + v[1]) + (v[2] + v[3]); }
__device__ __forceinline__ float dot4(f32x4 v) { return (v[0] * v[0] + v[1] * v[1]) + (v[2] * v[2] + v[3] * v[3]); }

constexpr int DM = 1024, TOK = 49152, TOKP = 32768, SEQP = 2048, SEQS = 8192;
constexpr int QL = 384, KVL = 256, NIN = 2208, N1P = 2304, DFF = 2816, NGU = 5632;
constexpr float EPS = 1e-6f, LOG2E = 1.4426950408889634f;
constexpr float QSC_MLA = 0.10206207261596575f * LOG2E;
constexpr float QSC_NA = 0.125f * LOG2E;
__device__ __forceinline__ int seq_pos(int row) { return row < TOKP ? (row & (SEQP - 1)) : (row & (SEQS - 1)); }

constexpr size_t KiB = 1024, MiB = 1u << 20;
constexpr size_t WS_CTL = 0, CTL_ZERO_BYTES = 64 * KiB;
constexpr size_t WS_COS = 1 * MiB, WS_SIN = WS_COS + 512 * KiB;
constexpr size_t WS_WIN = 2 * MiB;
constexpr size_t WS_WUQ = WS_WIN + (size_t)N1P * DM * 2;
constexpr size_t WS_WUKV = WS_WUQ + 768 * 384 * 2;
constexpr size_t WS_WO = WS_WUKV + 1024 * 256 * 2;
constexpr size_t WS_WGU = WS_WO + 1024 * 1024 * 2;
constexpr size_t WS_WD = WS_WGU + (size_t)NGU * DM * 2;
constexpr size_t WS_WEND = WS_WD + (size_t)DM * DFF * 2;
constexpr size_t WS_SSQ = 27 * MiB;
constexpr size_t WS_SSKV = WS_SSQ + (size_t)TOK * 12 * 4;
constexpr size_t WS_SSA = WS_SSKV + (size_t)TOK * 8 * 4;
constexpr size_t WS_SSB = WS_SSA + (size_t)TOK * 8 * 4;
constexpr size_t WS_SS1 = WS_SSB + (size_t)TOK * 8 * 4;
constexpr size_t WS_SS2 = WS_SS1 + (size_t)TOK * 16 * 4;
constexpr size_t WS_SSEND = WS_SS2 + (size_t)TOK * 16 * 4;
constexpr size_t WS_H = 40 * MiB;
constexpr size_t WS_AB = WS_H;
constexpr size_t WS_CQ = 136 * MiB;
constexpr size_t WS_CKV = WS_CQ + (size_t)TOK * QL * 2;
constexpr size_t WS_KR = WS_CKV + (size_t)TOK * KVL * 2;
constexpr size_t WS_NA = WS_KR + (size_t)TOK * 32 * 2;
constexpr size_t WS_Q = WS_NA + (size_t)TOK * 1536 * 2;
constexpr size_t WS_KN = WS_Q + (size_t)TOK * 768 * 2;
constexpr size_t WS_V = WS_KN + (size_t)TOK * 512 * 2;
constexpr size_t WS_END1 = WS_V + (size_t)TOK * 512 * 2;
constexpr size_t WS_X1 = 136 * MiB;
constexpr size_t WS_ACT = 232 * MiB;
constexpr size_t WS_NEED = 511 * MiB;
static_assert(WS_WEND <= WS_SSQ && WS_SSEND <= WS_H && WS_H + (size_t)TOK * DM * 2 <= WS_CQ && WS_END1 <= WS_NEED, "d_ws map");
static_assert(WS_X1 + (size_t)TOK * DM * 2 <= WS_ACT && WS_ACT + (size_t)TOK * DFF * 2 <= WS_NEED, "d_ws overlays");
constexpr int CW_FAIL = 16, CW_BAR = 1024;

constexpr int RING_BYTES = 131072, LDS_BYTES = 147456;

namespace pg8 {
constexpr int BM = 256, BK = 64, HALF = 128, HTB = HALF * BK * 2, STAGE_BYTES = 8 * HTB, NXCD = 8, WGM = 8;
__host__ __device__ __forceinline__ int lds_byte(int r, int c) { const int st = (r >> 4) * 2 + (c >> 5), rr = r & 15, cc = c & 31, ob = rr * 64 + cc * 2; return st * 1024 + (ob ^ (((ob >> 9) & 1) << 5)); }
__host__ __device__ __forceinline__ void stage_rc(int b, int& R, int& C) { const int st = b / 1024, sb = b % 1024, swz = sb ^ (((sb >> 9) & 1) << 5); R = (st >> 1) * 16 + swz / 64; C = (st & 1) * 32 + (swz % 64) / 2; }
__host__ __device__ __forceinline__ int perm32(int rho) { const int n = rho >> 4, i = rho & 15; return 8 * (i >> 2) + 4 * n + (i & 3); }

struct Unit { int pm, pn; };
struct Gemm { const bf16_t* A; const bf16_t* Bt; int M, N, K; };

struct StaticOrder {
    int nM, nN, nwg, G, c;
    __device__ void init(int M, int N, int G_, int c_) { nM = M / BM; nN = N / BM; nwg = nM * nN; G = G_; c = c_; }
    __device__ bool next(int i, Unit& u) const {
        const long L = (long)i * G + c; if (L >= nwg) return false;
        int wgid = (int)L; { const int q = nwg / NXCD, r = nwg % NXCD, xcd = wgid % NXCD, off = wgid / NXCD; wgid = (xcd < r ? xcd * (q + 1) : r * (q + 1) + (xcd - r) * q) + off; }
        const int nig = WGM * nN, gid = wgid / nig, fm = gid * WGM, gsz = (nM - fm) < WGM ? (nM - fm) : WGM;
        u.pm = fm + ((wgid % nig) % gsz); u.pn = (wgid % nig) / gsz; return true;
    }
};

template <class Epi, bool ALIGN_EPI>
__device__ __forceinline__ void gemm_phase(LAS unsigned char* lds, const Gemm g, const StaticOrder& S, const Epi& E) {
    int tid = threadIdx.x; asm volatile("" : "+v"(tid));
    const int wid = __builtin_amdgcn_readfirstlane(tid >> 6), lane = tid & 63, wr = wid >> 2, wc = wid & 3, fr = lane & 15, fq = lane >> 4;
    const int K = g.K, nt = K / BK;
    unsigned voffA[2], voffB[2];
#pragma unroll
    for (int i = 0; i < 2; ++i) { int R, C; stage_rc(tid * 16 + i * 8192, R, C); const int Rb = Epi::PERM ? ((R & ~31) + perm32(R & 31)) : R;
        voffA[i] = (unsigned)(R * K + C) * 2u; voffB[i] = (unsigned)(Rb * K + C) * 2u; }
    const size_t kstep = (size_t)(BK * 2);
    const size_t hstep = (size_t)HALF * K * 2;
    const size_t tstep = 2 * hstep;
    const unsigned ldsw = (unsigned)wid * 1024u;
    const int aoff = lds_byte(wr * 64 + fr, fq * 8), boff = lds_byte(wc * 32 + fr, fq * 8);
#define PG8_SA(b, h) (((b) * 2 + (h)) * HTB)
#define PG8_SB(b, h) ((4 + (b) * 2 + (h)) * HTB)
#define PG8_STAGE(bufoff, gbase, voff) do { _Pragma("unroll") for (int _i = 0; _i < 2; ++_i) \
        __builtin_amdgcn_global_load_lds((const unsigned*)((const char*)(gbase) + (voff)[_i]), (LAS unsigned*)(lds + (bufoff) + ldsw + _i * 8192), 16, 0, 0); } while (0)
#define PG8_LDA(dst, b, h) do { _Pragma("unroll") for (int m = 0; m < 4; ++m) _Pragma("unroll") for (int k = 0; k < 2; ++k) dst[m][k] = *(const LAS bf16x8*)(lds + PG8_SA(b, h) + aoff + m * 2048 + k * 1024); } while (0)
#define PG8_LDB(dst, b, h) do { _Pragma("unroll") for (int n = 0; n < 2; ++n) _Pragma("unroll") for (int k = 0; k < 2; ++k) dst[n][k] = *(const LAS bf16x8*)(lds + PG8_SB(b, h) + boff + n * 2048 + k * 1024); } while (0)
#define PG8_MMA(ai, bj, At, Bt) do { __builtin_amdgcn_s_setprio(1); _Pragma("unroll") for (int m = 0; m < 4; ++m) _Pragma("unroll") for (int n = 0; n < 2; ++n) _Pragma("unroll") for (int k = 0; k < 2; ++k) \
        acc[ai][bj][m][n] = __builtin_amdgcn_mfma_f32_16x16x32_bf16(Bt[n][k], At[m][k], acc[ai][bj][m][n], 0, 0, 0); __builtin_amdgcn_s_setprio(0); } while (0)
#define PG8_WAIT_V(n) asm volatile("s_waitcnt vmcnt(" #n ")" ::: "memory")
#define PG8_WAIT_L(n) asm volatile("s_waitcnt lgkmcnt(" #n ")" ::: "memory")
#define PG8_BAR __builtin_amdgcn_s_barrier()
#define PG8_SCHED __builtin_amdgcn_sched_barrier(0)
    Unit cur, nxt; int ui = 0;
    if (!S.next(0, cur)) return;
    f32x4 acc[2][2][4][2];
#pragma unroll
    for (int a = 0; a < 2; ++a)
#pragma unroll
        for (int b = 0; b < 2; ++b)
#pragma unroll
            for (int m = 0; m < 4; ++m)
#pragma unroll
                for (int n = 0; n < 2; ++n) acc[a][b][m][n] = (f32x4){0.f, 0.f, 0.f, 0.f};
    bf16x8 At[4][2], B0[2][2], B1[2][2];
    const char* cA = (const char*)g.A + (size_t)cur.pm * tstep; const char* cB = (const char*)g.Bt + (size_t)cur.pn * tstep;
    PG8_STAGE(PG8_SB(0, 0), cB, voffB); PG8_STAGE(PG8_SB(0, 1), cB + hstep, voffB); PG8_STAGE(PG8_SA(0, 0), cA, voffA); PG8_STAGE(PG8_SA(0, 1), cA + hstep, voffA);
    if (wr == 1) PG8_BAR;
    PG8_WAIT_V(2); PG8_BAR;
    PG8_STAGE(PG8_SB(1, 0), cB + kstep, voffB); PG8_STAGE(PG8_SA(1, 0), cA + kstep, voffA); PG8_STAGE(PG8_SB(1, 1), cB + hstep + kstep, voffB);
    PG8_WAIT_V(6); PG8_BAR;
    for (;;) {
        const bool has_next = S.next(ui + 1, nxt);
        const char* nA = has_next ? (const char*)g.A + (size_t)nxt.pm * tstep : cA; const char* nB = has_next ? (const char*)g.Bt + (size_t)nxt.pn * tstep : cB;
#pragma unroll 1
        for (int t = 0; t < nt; t += 2) {
            if constexpr (Epi::MID_T >= 0) { if (t == Epi::MID_T) E.mid(acc, cur, wr, wc, fr, fq); }
            const bool last = (t == nt - 2);
            const char* a1 = cA + (size_t)(t + 1) * kstep;
            const char* a2 = last ? nA : cA + (size_t)(t + 2) * kstep; const char* b2 = last ? nB : cB + (size_t)(t + 2) * kstep;
            const char* a3 = a2 + kstep; const char* b3 = b2 + kstep;
            PG8_LDB(B0, 0, 0); PG8_LDB(B1, 0, 1); PG8_SCHED; PG8_LDA(At, 0, 0); PG8_STAGE(PG8_SA(1, 1), a1 + hstep, voffA);
            PG8_WAIT_V(8); PG8_WAIT_L(0); PG8_BAR; PG8_MMA(0, 0, At, B0); PG8_MMA(0, 1, At, B1); PG8_BAR; PG8_SCHED;
            PG8_LDA(At, 0, 1); PG8_STAGE(PG8_SB(0, 0), b2, voffB); PG8_STAGE(PG8_SB(0, 1), b2 + hstep, voffB); PG8_STAGE(PG8_SA(0, 0), a2, voffA);
            PG8_WAIT_V(8); PG8_WAIT_L(0); PG8_BAR; PG8_MMA(1, 0, At, B0); PG8_MMA(1, 1, At, B1); PG8_BAR; PG8_SCHED;
            PG8_LDB(B0, 1, 0); PG8_LDB(B1, 1, 1); PG8_SCHED; PG8_LDA(At, 1, 0); PG8_STAGE(PG8_SA(0, 1), a2 + hstep, voffA);
            PG8_WAIT_V(8); PG8_WAIT_L(0); PG8_BAR; PG8_MMA(0, 0, At, B0); PG8_MMA(0, 1, At, B1); PG8_BAR; PG8_SCHED;
            PG8_LDA(At, 1, 1); PG8_STAGE(PG8_SB(1, 0), b3, voffB); PG8_STAGE(PG8_SB(1, 1), b3 + hstep, voffB); PG8_STAGE(PG8_SA(1, 0), a3, voffA);
            PG8_WAIT_V(8); PG8_WAIT_L(0); PG8_BAR; PG8_MMA(1, 0, At, B0); PG8_MMA(1, 1, At, B1); PG8_BAR; PG8_SCHED;
        }
        if constexpr (ALIGN_EPI) { if (wr == 0) PG8_BAR; }
        E(acc, cur, wr, wc, fr, fq);
        if (!has_next) break;
#pragma unroll
        for (int a = 0; a < 2; ++a)
#pragma unroll
            for (int b = 0; b < 2; ++b)
#pragma unroll
                for (int m = 0; m < 4; ++m)
#pragma unroll
                    for (int n = 0; n < 2; ++n) acc[a][b][m][n] = (f32x4){0.f, 0.f, 0.f, 0.f};
        cur = nxt; cA = nA; cB = nB; ++ui;
        if constexpr (ALIGN_EPI) { if (wr == 1) PG8_BAR; }
    }
    PG8_WAIT_V(0);
    if constexpr (!ALIGN_EPI) { if (wr == 0) PG8_BAR; }
    PG8_BAR;
#undef PG8_SA
#undef PG8_SB
#undef PG8_STAGE
#undef PG8_LDA
#undef PG8_LDB
#undef PG8_MMA
#undef PG8_WAIT_V
#undef PG8_WAIT_L
#undef PG8_BAR
#undef PG8_SCHED
}
}
using pg8::Unit;

struct Epi1 {
    static constexpr bool PERM = true; static constexpr int MID_T = -1;
    bf16_t *CQ, *CKV, *KR, *NA; float *SSQ, *SSKV; const float *COS, *SIN;
    __device__ __forceinline__ void mid(f32x4 (&)[2][2][4][2], const Unit&, int, int, int, int) const {}
    __device__ __forceinline__ void operator()(const f32x4 (&acc)[2][2][4][2], const Unit& u, int wr, int wc, int fr, int fq_in) const {
        int row0 = u.pm * 256 + wr * 64 + fr, fq = fq_in; asm volatile("" : "+v"(row0), "+v"(fq));
#pragma unroll
        for (int bj = 0; bj < 2; ++bj) {
            const int gc = u.pn * 256 + bj * 128 + wc * 32;
            if (gc < 640) {
                const bool isq = gc < QL;
                bf16_t* base = isq ? CQ : CKV; const int ld = isq ? QL : KVL, col = isq ? gc : gc - QL; float* ss = isq ? SSQ : SSKV; const int nslot = isq ? 12 : 8, slot = col >> 5;
#pragma unroll
                for (int ai = 0; ai < 2; ++ai)
#pragma unroll
                    for (int m = 0; m < 4; ++m) { const int row = row0 + ai * 128 + m * 16; const f32x4 v0 = acc[ai][bj][m][0], v1 = acc[ai][bj][m][1];
                        float s = dot4(v0) + dot4(v1); s += __shfl_xor(s, 16); s += __shfl_xor(s, 32);
                        if (fq == 0) ss[(size_t)row * nslot + slot] = s;
                        *(u32x4*)(base + (size_t)row * ld + col + 8 * fq) = pack8(v0, v1); }
            } else if (gc < 672) {
#pragma unroll
                for (int ai = 0; ai < 2; ++ai)
#pragma unroll
                    for (int m = 0; m < 4; ++m) { const int row = row0 + ai * 128 + m * 16; const int pos = seq_pos(row);
                        const f32x4 c4 = *(const f32x4*)(COS + pos * 16 + 4 * fq), s4 = *(const f32x4*)(SIN + pos * 16 + 4 * fq);
                        const f32x4 x1 = acc[ai][bj][m][0], x2 = acc[ai][bj][m][1]; const f32x4 o1 = x1 * c4 - x2 * s4, o2 = x1 * s4 + x2 * c4;
                        u32x2 w1, w2; w1.x = pk2(o1[0], o1[1]); w1.y = pk2(o1[2], o1[3]); w2.x = pk2(o2[0], o2[1]); w2.y = pk2(o2[2], o2[3]);
                        *(u32x2*)(KR + (size_t)row * 32 + 4 * fq) = w1; *(u32x2*)(KR + (size_t)row * 32 + 16 + 4 * fq) = w2; }
            } else if (gc >= 768) {
                const int col = gc - 768; const float sc = col < 512 ? QSC_NA : 1.0f;
#pragma unroll
                for (int ai = 0; ai < 2; ++ai)
#pragma unroll
                    for (int m = 0; m < 4; ++m) { const int row = row0 + ai * 128 + m * 16;
                        *(u32x4*)(NA + (size_t)row * 1536 + col + 8 * fq) = pack8(acc[ai][bj][m][0] * sc, acc[ai][bj][m][1] * sc); }
            }
        }
    }
};
struct Epi2 {
    static constexpr bool PERM = true; static constexpr int MID_T = -1;
    bf16_t* Q; const float *SSQ, *COS, *SIN;
    __device__ __forceinline__ void mid(f32x4 (&)[2][2][4][2], const Unit&, int, int, int, int) const {}
    __device__ __forceinline__ void operator()(const f32x4 (&acc)[2][2][4][2], const Unit& u, int wr, int wc, int fr, int fq_in) const {
        int row0 = u.pm * 256 + wr * 64 + fr, fq = fq_in; asm volatile("" : "+v"(row0), "+v"(fq));
#pragma unroll
        for (int ai = 0; ai < 2; ++ai)
#pragma unroll
            for (int m = 0; m < 4; ++m) { const int row = row0 + ai * 128 + m * 16; const float* p = SSQ + (size_t)row * 12;
                const f32x4 a = *(const f32x4*)p, b = *(const f32x4*)(p + 4), c = *(const f32x4*)(p + 8);
                const float r = __builtin_amdgcn_rsqf((sum4(a) + sum4(b) + sum4(c)) * (1.0f / QL) + EPS) * QSC_MLA;
#pragma unroll
                for (int bj = 0; bj < 2; ++bj) {
                    const int gc = u.pn * 256 + bj * 128 + wc * 32, G = gc >> 5, h = G / 3, part = G - 3 * h;
                    if (part < 2) {
                        *(u32x4*)(Q + (size_t)row * 768 + h * 96 + part * 32 + 8 * fq) = pack8(acc[ai][bj][m][0] * r, acc[ai][bj][m][1] * r);
                    } else { const int pos = seq_pos(row);
                        const f32x4 c4 = *(const f32x4*)(COS + pos * 16 + 4 * fq), s4 = *(const f32x4*)(SIN + pos * 16 + 4 * fq);
                        const f32x4 x1 = acc[ai][bj][m][0] * r, x2 = acc[ai][bj][m][1] * r; const f32x4 o1 = x1 * c4 - x2 * s4, o2 = x1 * s4 + x2 * c4;
                        u32x2 w1, w2; w1.x = pk2(o1[0], o1[1]); w1.y = pk2(o1[2], o1[3]); w2.x = pk2(o2[0], o2[1]); w2.y = pk2(o2[2], o2[3]);
                        bf16_t* qp = Q + (size_t)row * 768 + h * 96 + 64 + 4 * fq; *(u32x2*)qp = w1; *(u32x2*)(qp + 16) = w2; }
                }
                asm volatile("" ::: "memory"); }
    }
};
struct Epi3 {
    static constexpr bool PERM = true; static constexpr int MID_T = -1;
    bf16_t *KN, *V; const float* SSKV;
    __device__ __forceinline__ void mid(f32x4 (&)[2][2][4][2], const Unit&, int, int, int, int) const {}
    __device__ __forceinline__ void operator()(const f32x4 (&acc)[2][2][4][2], const Unit& u, int wr, int wc, int fr, int fq_in) const {
        int row0 = u.pm * 256 + wr * 64 + fr, fq = fq_in; asm volatile("" : "+v"(row0), "+v"(fq));
        float rs[2][4];
#pragma unroll
        for (int ai = 0; ai < 2; ++ai)
#pragma unroll
            for (int m = 0; m < 4; ++m) { const float* p = SSKV + (size_t)(row0 + ai * 128 + m * 16) * 8;
                const f32x4 a = *(const f32x4*)p, b = *(const f32x4*)(p + 4);
                rs[ai][m] = __builtin_amdgcn_rsqf((sum4(a) + sum4(b)) * (1.0f / KVL) + EPS); }
#pragma unroll
        for (int bj = 0; bj < 2; ++bj) {
            const int gc = u.pn * 256 + bj * 128 + wc * 32, h = gc >> 7, w = gc & 127;
            bf16_t* base = (w < 64) ? KN + h * 64 + w : V + h * 64 + (w - 64);
#pragma unroll
            for (int ai = 0; ai < 2; ++ai)
#pragma unroll
                for (int m = 0; m < 4; ++m) { const int row = row0 + ai * 128 + m * 16; const float r = rs[ai][m];
                    *(u32x4*)(base + (size_t)row * 512 + 8 * fq) = pack8(acc[ai][bj][m][0] * r, acc[ai][bj][m][1] * r); }
        }
    }
};
struct Epi4 {
    static constexpr bool PERM = true; static constexpr int MID_T = 8;
    const float *xp, *xs; bf16_t* X1; const float *SSA, *SSB; float* SS1;
    __device__ __forceinline__ float rstd8(const float* p) const { const f32x4 a = *(const f32x4*)p, b = *(const f32x4*)(p + 4); return __builtin_amdgcn_rsqf((sum4(a) + sum4(b)) * (1.0f / 512.0f) + EPS); }
    __device__ __forceinline__ void mid(f32x4 (&acc)[2][2][4][2], const Unit& u, int wr, int wc, int fr, int fq_in) const {
        int row0 = u.pm * 256 + wr * 64 + fr, fq = fq_in; asm volatile("" : "+v"(row0), "+v"(fq));
#pragma unroll
        for (int ai = 0; ai < 2; ++ai)
#pragma unroll
            for (int m = 0; m < 4; ++m) { const size_t row = (size_t)(row0 + ai * 128 + m * 16);
                const float ra = rstd8(SSA + row * 8), rb = rstd8(SSB + row * 8); const float f = ra / rb;
#pragma unroll
                for (int bj = 0; bj < 2; ++bj)
#pragma unroll
                    for (int n = 0; n < 2; ++n) acc[ai][bj][m][n] = acc[ai][bj][m][n] * f;
                asm volatile("" ::: "memory"); }
    }
    __device__ __forceinline__ void operator()(const f32x4 (&acc)[2][2][4][2], const Unit& u, int wr, int wc, int fr, int fq_in) const {
        int row0 = u.pm * 256 + wr * 64 + fr, fq = fq_in; asm volatile("" : "+v"(row0), "+v"(fq)); const int colw = u.pn * 256 + wc * 32 + 8 * fq;
#pragma unroll
        for (int ai = 0; ai < 2; ++ai)
#pragma unroll
            for (int m = 0; m < 4; ++m) { const int row = row0 + ai * 128 + m * 16; const float rb = rstd8(SSB + (size_t)row * 8);
                const float* xr = (row < TOKP ? xp + (size_t)row * DM : xs + (size_t)(row - TOKP) * DM) + colw;
                float s = 0.f;
#pragma unroll
                for (int bj = 0; bj < 2; ++bj) { const f32x4 a0 = *(const f32x4*)(xr + bj * 128), a1 = *(const f32x4*)(xr + bj * 128 + 4);
                    const f32x4 v0 = a0 + acc[ai][bj][m][0] * rb, v1 = a1 + acc[ai][bj][m][1] * rb; s += dot4(v0) + dot4(v1);
                    *(u32x4*)(X1 + (size_t)row * DM + colw + bj * 128) = pack8(v0, v1); }
                s += __shfl_xor(s, 16); s += __shfl_xor(s, 32);
                if (fq == 0) SS1[(size_t)row * 16 + u.pn * 4 + wc] = s;
                asm volatile("" ::: "memory"); }
    }
};
__device__ __forceinline__ float rstd16(const float* p) { const f32x4 a = *(const f32x4*)p, b = *(const f32x4*)(p + 4), c = *(const f32x4*)(p + 8), d = *(const f32x4*)(p + 12);
    return __builtin_amdgcn_rsqf(((sum4(a) + sum4(b)) + (sum4(c) + sum4(d))) * (1.0f / DM) + EPS); }
struct Epi5 {
    static constexpr bool PERM = true; static constexpr int MID_T = -1;
    bf16_t* ACT; const float* SS1;
    __device__ __forceinline__ void mid(f32x4 (&)[2][2][4][2], const Unit&, int, int, int, int) const {}
    __device__ __forceinline__ void operator()(const f32x4 (&acc)[2][2][4][2], const Unit& u, int wr, int wc, int fr, int fq_in) const {
        int row0 = u.pm * 256 + wr * 64 + fr, fq = fq_in; asm volatile("" : "+v"(row0), "+v"(fq)); const int col = u.pn * 128 + wc * 32 + 8 * fq;
#pragma unroll
        for (int ai = 0; ai < 2; ++ai)
#pragma unroll
            for (int m = 0; m < 4; ++m) { const int row = row0 + ai * 128 + m * 16; const float r = rstd16(SS1 + (size_t)row * 16);
                f32x4 o[2];
#pragma unroll
                for (int n = 0; n < 2; ++n) { const f32x4 gt = acc[ai][0][m][n] * r, up = acc[ai][1][m][n] * r;
#pragma unroll
                    for (int i = 0; i < 4; ++i) o[n][i] = gt[i] * __builtin_amdgcn_rcpf(1.0f + __builtin_amdgcn_exp2f(-gt[i] * LOG2E)) * up[i]; }
                *(u32x4*)(ACT + (size_t)row * DFF + col) = pack8(o[0], o[1]); }
    }
};
struct Epi6 {
    static constexpr bool PERM = false; static constexpr int MID_T = -1;
    const bf16_t* X1; float* out; float* SS2;
    __device__ __forceinline__ void mid(f32x4 (&)[2][2][4][2], const Unit&, int, int, int, int) const {}
    __device__ __forceinline__ void operator()(const f32x4 (&acc)[2][2][4][2], const Unit& u, int wr, int wc, int fr, int fq_in) const {
        int row0 = u.pm * 256 + wr * 64 + fr, fq = fq_in; asm volatile("" : "+v"(row0), "+v"(fq)); const int colw = u.pn * 256 + wc * 32 + 4 * fq;
#pragma unroll
        for (int ai = 0; ai < 2; ++ai)
#pragma unroll
            for (int m = 0; m < 4; ++m) { const int row = row0 + ai * 128 + m * 16; float s = 0.f;
#pragma unroll
                for (int bj = 0; bj < 2; ++bj)
#pragma unroll
                    for (int n = 0; n < 2; ++n) { const size_t off = (size_t)row * DM + colw + bj * 128 + n * 16; const u32x2 w = *(const u32x2*)(X1 + off);
                        f32x4 v = acc[ai][bj][m][n]; v[0] += bflo(w.x); v[1] += bfhi(w.x); v[2] += bflo(w.y); v[3] += bfhi(w.y); s += dot4(v);
                        *(f32x4*)(out + off) = v; }
                s += __shfl_xor(s, 16); s += __shfl_xor(s, 32);
                if (fq == 0) SS2[(size_t)row * 16 + u.pn * 4 + wc] = s; }
    }
};

namespace att {
constexpr int KSLOT = 12288, VSLOT = 8192;
constexpr int L_K = 0, L_V = 2 * KSLOT, L_WS = L_V + 2 * VSLOT, L_OST = L_WS + 8 * 256, L_BIAS = L_OST + 8 * 4096, L_END = L_BIAS + 2560;
static_assert(L_END <= RING_BYTES, "attention LDS");
constexpr int THRL = 8;
#define MFMA32(a, b, c) __builtin_amdgcn_mfma_f32_32x32x16_bf16(a, b, c, 0, 0, 0)
__device__ __forceinline__ int crow(int r, int hi) { return (r & 3) + 8 * (r >> 2) + 4 * hi; }
__device__ __forceinline__ s16x4 vtr(const LAS unsigned char* p) { return __builtin_bit_cast(s16x4, __builtin_amdgcn_ds_read_tr16_b64_v4i16((LAS v4i16_t*)p)); }
__device__ __forceinline__ void glds(const void* g, LAS unsigned char* dst) { __builtin_amdgcn_global_load_lds((const unsigned*)g, (LAS unsigned*)dst, 16, 0, 0); }

struct SoftSt { float mhat, l; f32x16 o[2]; f32x16 negm; };

template <int ND, bool NA>
__device__ __forceinline__ void tile_step(SoftSt& st, const bf16x8 (&qr)[ND], const LAS unsigned char* kb, const LAS unsigned char* vp, LAS float* wsf, int r32, int hi, bool first,
                                          const LAS float* brow, int cs) {
    f32x16 C0, C1;
#pragma unroll
    for (int d0 = 0; d0 < ND; ++d0) {
        const bf16x8 b0 = *(const LAS bf16x8*)(kb + d0 * 2048), b1 = *(const LAS bf16x8*)(kb + d0 * 2048 + 512);
        if (d0 == 0) { C0 = MFMA32(b0, qr[0], st.negm); C1 = MFMA32(b1, qr[0], st.negm); } else { C0 = MFMA32(b0, qr[d0], C0); C1 = MFMA32(b1, qr[d0], C1); }
    }
    if (NA) {
#pragma unroll
        for (int r = 0; r < 16; ++r) { const int kc = (r & 3) + 8 * (r >> 2) + 4 * hi;
            C0[r] = ((unsigned)(kc - cs) < 16u) ? C0[r] + brow[kc] : -INFINITY;
            C1[r] = ((unsigned)(kc + 32 - cs) < 16u) ? C1[r] + brow[kc + 32] : -INFINITY; }
    }
#define MX3(a, b, c) __builtin_fmaxf(__builtin_fmaxf((a), (b)), (c))
    float a = MX3(C0[0], C0[1], C1[0]), b = MX3(C0[2], C0[3], C1[1]); a = MX3(a, C1[2], C1[3]);
#pragma unroll
    for (int r = 4; r < 16; r += 4) { a = MX3(a, C0[r], C0[r + 1]); b = MX3(b, C0[r + 2], C0[r + 3]); a = MX3(a, C1[r], C1[r + 1]); b = MX3(b, C1[r + 2], C1[r + 3]); }
#undef MX3
    float rm = __builtin_fmaxf(a, b);
    { auto rr = __builtin_amdgcn_permlane32_swap(__float_as_uint(rm), __float_as_uint(rm), false, false); rm = __builtin_fmaxf(__uint_as_float(rr[0]), __uint_as_float(rr[1])); }
    bool resc = false;
    if (first || __any(rm > (float)THRL)) {
        const float dl = first ? rm : __builtin_fmaxf(rm, 0.f); st.mhat += dl;
#pragma unroll
        for (int r = 0; r < 16; ++r) { C0[r] -= dl; C1[r] -= dl; st.negm[r] = -st.mhat; }
        const float f = first ? 0.f : __builtin_amdgcn_exp2f(-dl); st.l *= f; if (hi == 0) wsf[r32] = f; resc = true;
    }
    float sacc = 0.f;
#pragma unroll
    for (int r = 0; r < 16; ++r) { C0[r] = __builtin_amdgcn_exp2f(C0[r]); C1[r] = __builtin_amdgcn_exp2f(C1[r]); sacc += C0[r] + C1[r]; }
    st.l += sacc;
    u32x4 pw0, pw1, pw2, pw3;
    pw0 = (u32x4){pk2(C0[0], C0[1]), pk2(C0[2], C0[3]), pk2(C0[4], C0[5]), pk2(C0[6], C0[7])}; pw1 = (u32x4){pk2(C0[8], C0[9]), pk2(C0[10], C0[11]), pk2(C0[12], C0[13]), pk2(C0[14], C0[15])};
    pw2 = (u32x4){pk2(C1[0], C1[1]), pk2(C1[2], C1[3]), pk2(C1[4], C1[5]), pk2(C1[6], C1[7])}; pw3 = (u32x4){pk2(C1[8], C1[9]), pk2(C1[10], C1[11]), pk2(C1[12], C1[13]), pk2(C1[14], C1[15])};
    if (resc) {
#pragma unroll
        for (int r = 0; r < 16; ++r) { const float f = wsf[crow(r, hi)]; st.o[0][r] *= f; st.o[1][r] *= f; }
    }
#pragma unroll
    for (int d0 = 0; d0 < 2; ++d0) {
#pragma unroll
        for (int ks = 0; ks < 4; ++ks) { const s16x4 lo = vtr(vp + d0 * 4096 + ks * 1024), hh = vtr(vp + d0 * 4096 + ks * 1024 + 512);
            const bf16x8 vb = (bf16x8){lo[0], lo[1], lo[2], lo[3], hh[0], hh[1], hh[2], hh[3]};
            const bf16x8 pa = __builtin_bit_cast(bf16x8, ks == 0 ? pw0 : ks == 1 ? pw1 : ks == 2 ? pw2 : pw3);
            st.o[d0] = MFMA32(pa, vb, st.o[d0]); }
    }
}
__device__ __forceinline__ void attn_epilogue(SoftSt& st, LAS unsigned char* lds, int wid, int lane, int r32, int hi, bf16_t* Orow0  , float* SSrow0  ) {
    LAS float* wsf = (LAS float*)(lds + L_WS) + wid * 64;
    { auto rr = __builtin_amdgcn_permlane32_swap(__float_as_uint(st.l), __float_as_uint(st.l), false, false); st.l = __uint_as_float(rr[0]) + __uint_as_float(rr[1]); }
    if (hi == 0) wsf[32 + r32] = st.l;
    LAS bf16_t* stg = (LAS bf16_t*)(lds + L_OST) + wid * 2048;
#pragma unroll
    for (int r = 0; r < 16; ++r) { const int orow = crow(r, hi); const float rl = __builtin_amdgcn_rcpf(wsf[32 + orow]);
        const unsigned w0 = pk2(st.o[0][r] * rl, 0.f), w1 = pk2(st.o[1][r] * rl, 0.f);
        stg[orow * 64 + r32] = (bf16_t)(w0 & 0xffffu); stg[orow * 64 + 32 + r32] = (bf16_t)(w1 & 0xffffu); }
#pragma unroll
    for (int i = 0; i < 4; ++i) { const int row = i * 8 + (lane >> 3), ch = lane & 7; const u32x4 v = *(const LAS u32x4*)(stg + row * 64 + ch * 8);
        float s = 0.f;
#pragma unroll
        for (int j = 0; j < 4; ++j) { const float x = bflo(v[j]), y = bfhi(v[j]); s += x * x + y * y; }
        s += __shfl_xor(s, 1); s += __shfl_xor(s, 2); s += __shfl_xor(s, 4);
        if (ch == 0) SSrow0[(size_t)row * 8] = s;
        *(u32x4*)(Orow0 + (size_t)row * DM + ch * 8) = v; }
}

__device__ __forceinline__ void mla_unit(LAS unsigned char* lds, int rowbase, int S, int h, int q0, const bf16_t* Q, const bf16_t* KN, const bf16_t* KR, const bf16_t* V, bf16_t* AB, float* SSA) {
    const int tid = threadIdx.x, lane = tid & 63, r32 = lane & 31, hi = lane >> 5; const int wid = __builtin_amdgcn_readfirstlane(tid >> 6);
    const bf16_t* ksrc = KN + (size_t)(rowbase + lane) * 512 + h * 64 + wid * 8;
    const bf16_t* rsrc = KR + (size_t)(rowbase + lane) * 32 + (wid & 3) * 8;
    const bf16_t* vsrc = V + (size_t)(rowbase + 16 * (wid & 3) + (lane >> 2)) * 512 + h * 64 + (wid >> 2) * 32 + (lane & 3) * 8;
#define MLA_STAGE(t, s) do { glds(ksrc + (size_t)(t) * 64 * 512, lds + L_K + (s) * KSLOT + wid * 1024); \
        if (wid < 4) glds(rsrc + (size_t)(t) * 64 * 32, lds + L_K + (s) * KSLOT + (8 + wid) * 1024); \
        glds(vsrc + (size_t)(t) * 64 * 512, lds + L_V + (s) * VSLOT + wid * 1024); } while (0)
    const int NT = S / 64;
    MLA_STAGE(0, 0);
    const int qrow = rowbase + q0 + wid * 32;
    bf16x8 qr[6];
#pragma unroll
    for (int d0 = 0; d0 < 6; ++d0) qr[d0] = *(const bf16x8*)(Q + (size_t)(qrow + r32) * 768 + h * 96 + d0 * 16 + hi * 8);
    SoftSt st; st.mhat = 0.f; st.l = 0.f; st.o[0] = f32x16{}; st.o[1] = f32x16{}; st.negm = f32x16{};
    LAS float* wsf = (LAS float*)(lds + L_WS) + wid * 64;
    const int kboff = hi * 1024 + r32 * 16, vpoff = ((lane >> 4) & 1) * 32 + (lane & 3) * 8 + (4 * hi + ((lane & 15) >> 2)) * 64;
    asm volatile("s_waitcnt vmcnt(0)" ::: "memory"); __syncthreads();
    for (int t = 0; t < NT; ++t) {
        const int s = t & 1;
        if (t + 1 < NT) MLA_STAGE(t + 1, s ^ 1);
        tile_step<6, false>(st, qr, lds + L_K + s * KSLOT + kboff, lds + L_V + s * VSLOT + vpoff, wsf, r32, hi, t == 0, nullptr, 0);
        asm volatile("s_waitcnt vmcnt(0)" ::: "memory"); __syncthreads();
    }
#undef MLA_STAGE
    attn_epilogue(st, lds, wid, lane, r32, hi, AB + (size_t)qrow * DM + h * 64, SSA + (size_t)qrow * 8 + h);
}

__device__ __forceinline__ void na_unit(LAS unsigned char* lds, int rowbase, int rows, int h, int R0, const bf16_t* NAB, const float* rpb, bf16_t* AB, float* SSB) {
    const int tid = threadIdx.x, lane = tid & 63, r32 = lane & 31, hi = lane >> 5; const int wid = __builtin_amdgcn_readfirstlane(tid >> 6);
    LAS float* tab = (LAS float*)(lds + L_BIAS);
    for (int i = tid; i < 640; i += 512) { const int j = i - 48; tab[i] = (j >= 0 && j < 465) ? rpb[h * 465 + j] * LOG2E : 0.f; }
    const int r = R0 + (wid >> 1), qh = wid & 1;
    const int start_w = min(max(r - 4, 0), rows - 8);
    const int u_lo = min(max(R0 - 4, 0), rows - 8), u_hi = min(max(R0 - 1, 0), rows - 8) + 8;
    const bf16_t* ksrc = NAB + (size_t)(rowbase + lane) * 1536 + 512 + h * 64 + wid * 8;
    const bf16_t* vsrc = NAB + (size_t)(rowbase + 16 * (wid & 3) + (lane >> 2)) * 1536 + 1024 + h * 64 + (wid >> 2) * 32 + (lane & 3) * 8;
#define NA_STAGE(u, s) do { glds(ksrc + (size_t)(u) * 64 * 1536, lds + L_K + (s) * KSLOT + wid * 1024); glds(vsrc + (size_t)(u) * 64 * 1536, lds + L_V + (s) * VSLOT + wid * 1024); } while (0)
    NA_STAGE(u_lo, 0);
    const int qrow = rowbase + r * 64 + qh * 32;
    bf16x8 qr[4];
#pragma unroll
    for (int d0 = 0; d0 < 4; ++d0) qr[d0] = *(const bf16x8*)(NAB + (size_t)(qrow + r32) * 1536 + h * 64 + d0 * 16 + hi * 8);
    SoftSt st; st.mhat = 0.f; st.l = 0.f; st.o[0] = f32x16{}; st.o[1] = f32x16{}; st.negm = f32x16{};
    LAS float* wsf = (LAS float*)(lds + L_WS) + wid * 64;
    const int kboff = hi * 1024 + r32 * 16, vpoff = ((lane >> 4) & 1) * 32 + (lane & 3) * 8 + (4 * hi + ((lane & 15) >> 2)) * 64;
    const int qc = qh * 32 + r32, cs = min(max(qc - 8, 0), 48);
    asm volatile("s_waitcnt vmcnt(0)" ::: "memory"); __syncthreads();
    const int NT = u_hi - u_lo;
    for (int i = 0; i < NT; ++i) {
        const int s = i & 1, u = u_lo + i;
        if (i + 1 < NT) NA_STAGE(u + 1, s ^ 1);
        if (u >= start_w && u < start_w + 8)
            tile_step<4, true>(st, qr, lds + L_K + s * KSLOT + kboff, lds + L_V + s * VSLOT + vpoff, wsf, r32, hi, u == start_w, tab + 48 + (u - r + 7) * 31 + 15 - qc, cs);
        asm volatile("s_waitcnt vmcnt(0)" ::: "memory"); __syncthreads();
    }
#undef NA_STAGE
    attn_epilogue(st, lds, wid, lane, r32, hi, AB + (size_t)qrow * DM + 512 + h * 64, SSB + (size_t)qrow * 8 + h);
}
}

__device__ __forceinline__ float wave_sum(float v) {
#pragma unroll
    for (int o = 1; o < 64; o <<= 1) v += __shfl_xor(v, o);
    return v;
}
__device__ __forceinline__ int ropeperm(int p) { return 16 * ((p >> 2) & 1) + 4 * (p >> 3) + (p & 3); }
struct MapIn  { __device__ int operator()(int n) const { if (n < 640) return n; if (n < 672) return 640 + ropeperm(n - 640); if (n < 768) return -1; return n - 96; } };
struct MapUq  { __device__ int operator()(int n) const { const int h = n / 96, w = n - 96 * h; return w < 64 ? n : 96 * h + 64 + ropeperm(w - 64); } };
struct MapId  { __device__ int operator()(int n) const { return n; } };
struct MapGU  { __device__ int operator()(int n) const { const int pn = n >> 8, w = n & 255; return w < 128 ? 128 * pn + w : DFF + 128 * pn + (w - 128); } };
template <class Map>
__device__ __forceinline__ void wt_item(const float* W, const float* W2, int K, int N, bf16_t* WT, const float* g0, const float* g1, int ksplit, LAS float* scr, int item, int nblk, int lane, Map map) {
    const int kb = item / nblk, nb = item % nblk, k0 = 64 * kb, n0 = 32 * nb;
    int src = map(n0 + (lane & 31)); const float* Wsrc = W; if (W2 && src >= N) { Wsrc = W2; src -= N; }
#pragma unroll 8
    for (int i = 0; i < 32; ++i) { const int kk = 2 * i + (lane >> 5), k = k0 + kk; float v = src >= 0 ? Wsrc[(size_t)k * N + src] : 0.f;
        if (g0) v *= (k < ksplit ? g0[k] : g1[k - ksplit]);
        scr[kk * 33 + (lane & 31)] = v; }
    asm volatile("s_waitcnt lgkmcnt(0)" ::: "memory");
    const int c = lane & 7;
#pragma unroll
    for (int j = 0; j < 4; ++j) { const int n = (lane >> 3) + 8 * j; const LAS float* s = scr + (8 * c) * 33 + n;
        u32x4 o; o.x = pk2(s[0 * 33], s[1 * 33]); o.y = pk2(s[2 * 33], s[3 * 33]); o.z = pk2(s[4 * 33], s[5 * 33]); o.w = pk2(s[6 * 33], s[7 * 33]);
        *(u32x4*)(WT + (size_t)(n0 + n) * K + k0 + 8 * c) = o; }
    asm volatile("s_waitcnt lgkmcnt(0)" ::: "memory");
}
__device__ __forceinline__ void sincos_d(float ang, float& sn, float& cs) {
    const double a = (double)ang; const double k = __builtin_rint(a * 0.15915494309189535); const double r = a - k * 6.283185307179586 ; const double r2 = r * r;
    double ts = 1.0, tc = 1.0, s = 1.0, c = 1.0;
#pragma unroll
    for (int n = 1; n <= 13; ++n) { tc = -tc * r2 / (double)((2 * n - 1) * (2 * n)); ts = -ts * r2 / (double)((2 * n) * (2 * n + 1)); c += tc; s += ts; }
    sn = (float)(s * r); cs = (float)c;
}

#define XB_TMO      128
#define XB_XCNT(j)  (256  + 64 * (j))
#define XB_XSUB(j)  (1280 + 64 * (j))
#define XB_XGEN(j)  (2304 + 64 * (j))
#define XB_TOP      3328
#define XB_TOPGEN   3392
#define XCD_BAR_WORDS 3456
#define XB_SPIN_CAP (1u << 18)
__device__ __forceinline__ unsigned xb_ld(unsigned* p)              { return __hip_atomic_load(p, __ATOMIC_RELAXED, __HIP_MEMORY_SCOPE_AGENT); }
__device__ __forceinline__ unsigned xb_add(unsigned* p, unsigned v) { return __hip_atomic_fetch_add(p, v, __ATOMIC_RELAXED, __HIP_MEMORY_SCOPE_AGENT); }
__device__ __forceinline__ unsigned xb_xcc_id() { return (unsigned)__builtin_amdgcn_s_getreg((3 << 11) | 20) & 0xFu; }
#define XB_SPIN(cond, bar) do { unsigned _sp = 0; while (cond) { __builtin_amdgcn_s_sleep(1); \
    if ((++_sp & 255u) == 0u) { if (xb_ld(&(bar)[XB_TMO])) break; if (_sp > XB_SPIN_CAP) { atomicAdd(&(bar)[XB_TMO], 1u); break; } } } } while (0)
struct XcdBarrier { unsigned* bar; unsigned x; volatile LAS unsigned* st; };
__device__ __forceinline__ XcdBarrier xcd_barrier_post(unsigned* bar, volatile LAS unsigned* st) {
    XcdBarrier b; b.bar = bar; b.x = xb_xcc_id(); b.st = st;
    if (threadIdx.x == 0) (void)xb_add(&bar[XB_XCNT(b.x)], 1u);
    return b;
}
__device__ __forceinline__ void xcd_barrier_complete(unsigned* bar, unsigned x, unsigned& nloc, unsigned& nx) {
    const unsigned G = gridDim.x * gridDim.y * gridDim.z;
    unsigned sum, cnt, mine, sp = 0u;
    for (;;) {
        sum = 0u; cnt = 0u; mine = 0u;
#pragma unroll
        for (unsigned j = 0; j < 16; ++j) { const unsigned c = xb_ld(&bar[XB_XCNT(j)]); sum += c; cnt += (c > 0u) ? 1u : 0u; mine = (j == x) ? c : mine; }
        if (sum == G) break;
        __builtin_amdgcn_s_sleep(1);
        if ((++sp & 255u) == 0u) { if (xb_ld(&bar[XB_TMO])) break; if (sp > XB_SPIN_CAP) { atomicAdd(&bar[XB_TMO], 1u); break; } }
    }
    nloc = mine > 0u ? mine : 1u; nx = cnt > 0u ? cnt : 1u;
}
__device__ __forceinline__ void xcd_barrier(const XcdBarrier& b) {
    asm volatile("s_waitcnt vmcnt(0)" ::: "memory");
    __syncthreads();
    if (threadIdx.x == 0) {
        unsigned* bar = b.bar;
        __builtin_amdgcn_s_waitcnt(0);
        unsigned nloc = b.st[0], nx = b.st[1];
        if (nloc == 0u) { xcd_barrier_complete(bar, b.x, nloc, nx); b.st[0] = nloc; b.st[1] = nx; }
        const unsigned old = xb_add(&bar[XB_XSUB(b.x)], 1u);
        const unsigned gen = old / nloc;
        if (old + 1u == (gen + 1u) * nloc) {
            __builtin_amdgcn_fence(__ATOMIC_RELEASE, "agent");
            asm volatile("s_waitcnt vmcnt(0)" ::: "memory");
            const unsigned og = xb_add(&bar[XB_TOP], 1u);
            const unsigned tg = og / nx;
            if (og + 1u == (tg + 1u) * nx) xb_add(&bar[XB_TOPGEN], 1u);
            else XB_SPIN(xb_ld(&bar[XB_TOPGEN]) == tg, bar);
            __builtin_amdgcn_fence(__ATOMIC_ACQUIRE, "agent");
            xb_add(&bar[XB_XGEN(b.x)], 1u);
            asm volatile("s_waitcnt vmcnt(0)" ::: "memory");
        } else {
            XB_SPIN(xb_ld(&bar[XB_XGEN(b.x)]) == gen, bar);
            __builtin_amdgcn_fence(__ATOMIC_ACQUIRE, "agent");
            asm volatile("s_waitcnt vmcnt(0)" ::: "memory");
        }
    }
    __syncthreads();
}

struct Args { const float* in[17]; float* out; unsigned char* ws; int ph_lo, ph_hi; };
constexpr int NPHASE = 8;

__global__ void __launch_bounds__(512, 2) mega(Args args) {
    extern __shared__ __attribute__((aligned(16))) unsigned char lds_raw[];
    LAS unsigned char* lds = (LAS unsigned char*)lds_raw;
    const int tid = threadIdx.x, lane = tid & 63, wave = __builtin_amdgcn_readfirstlane(tid >> 6);
    const int G = gridDim.x, bx = blockIdx.x; const int vcu = (G % 8 == 0) ? (bx % 8) * (G / 8) + bx / 8 : bx;
    unsigned char* ws = args.ws;
    const float *xp = args.in[0], *xs = args.in[1];
    float* COS = (float*)(ws + WS_COS); float* SIN = (float*)(ws + WS_SIN);
    bf16_t *WIN = (bf16_t*)(ws + WS_WIN), *WUQ = (bf16_t*)(ws + WS_WUQ), *WUKV = (bf16_t*)(ws + WS_WUKV), *WO = (bf16_t*)(ws + WS_WO), *WGU = (bf16_t*)(ws + WS_WGU), *WD = (bf16_t*)(ws + WS_WD);
    float *SSQ = (float*)(ws + WS_SSQ), *SSKV = (float*)(ws + WS_SSKV), *SSA = (float*)(ws + WS_SSA), *SSB = (float*)(ws + WS_SSB), *SS1 = (float*)(ws + WS_SS1), *SS2 = (float*)(ws + WS_SS2);
    bf16_t *H = (bf16_t*)(ws + WS_H), *AB = (bf16_t*)(ws + WS_AB), *CQ = (bf16_t*)(ws + WS_CQ), *CKV = (bf16_t*)(ws + WS_CKV), *KR = (bf16_t*)(ws + WS_KR), *NAB = (bf16_t*)(ws + WS_NA);
    bf16_t *Qb = (bf16_t*)(ws + WS_Q), *KN = (bf16_t*)(ws + WS_KN), *Vb = (bf16_t*)(ws + WS_V), *X1 = (bf16_t*)(ws + WS_X1), *ACT = (bf16_t*)(ws + WS_ACT);
    const int lo = args.ph_lo, hi = args.ph_hi;
    volatile LAS unsigned* MISC = (volatile LAS unsigned*)(lds + RING_BYTES + 320);
    XcdBarrier bar; bar.bar = (unsigned*)(ws + WS_CTL) + CW_BAR; bar.x = 0; bar.st = MISC;
    if (hi - lo > 1) { if (tid < 2) MISC[tid] = 0u; __syncthreads(); bar = xcd_barrier_post((unsigned*)(ws + WS_CTL) + CW_BAR, MISC); }
#ifndef PH_MASK
#define PH_MASK 0xff
#endif
#define IN(k) (((PH_MASK >> (k)) & 1) && lo <= (k) && (k) < hi)
#ifndef PH_TWICE
#define PH_TWICE -1
#endif
#ifndef EXTRA_SYNCS
#define EXTRA_SYNCS 0
#endif
#define REP(k) for (int rep_ = 0; rep_ < ((k) == PH_TWICE ? 2 : 1); ++rep_)
#ifndef CG_SEAM
#define CG_SEAM -1
#endif
#define SEAM(k) do { if (IN(k) && IN((k) + 1)) { if ((k) == CG_SEAM) cg::this_grid().sync(); else xcd_barrier(bar); } } while (0)

    REP(0) if (IN(0)) {
        LAS float* scr = (LAS float*)(lds + wave * 16384);
        const int gw = vcu * 8 + wave, NGW = G * 8;
        constexpr int I_IN = (DM / 64) * (N1P / 32), I_UQ = (QL / 64) * (768 / 32), I_UKV = (KVL / 64) * (1024 / 32), I_O = (DM / 64) * (DM / 32), I_GU = (DM / 64) * (NGU / 32), I_D = (DFF / 64) * (DM / 32);
        constexpr int NITEMS = I_IN + I_UQ + I_UKV + I_O + I_GU + I_D;
        for (int it = gw; it < NITEMS; it += NGW) {
            int r = it;
            if (r < I_IN) { wt_item(args.in[3], nullptr, DM, NIN, WIN, nullptr, nullptr, 0, scr, r, N1P / 32, lane, MapIn()); continue; } r -= I_IN;
            if (r < I_UQ) { wt_item(args.in[6], nullptr, QL, 768, WUQ, args.in[4], args.in[4], QL, scr, r, 768 / 32, lane, MapUq()); continue; } r -= I_UQ;
            if (r < I_UKV) { wt_item(args.in[7], nullptr, KVL, 1024, WUKV, args.in[5], args.in[5], KVL, scr, r, 1024 / 32, lane, MapId()); continue; } r -= I_UKV;
            if (r < I_O) { wt_item(args.in[11], nullptr, DM, DM, WO, args.in[9], args.in[10], 512, scr, r, DM / 32, lane, MapId()); continue; } r -= I_O;
            if (r < I_GU) { wt_item(args.in[13], args.in[14], DM, DFF, WGU, args.in[12], args.in[12], DM, scr, r, NGU / 32, lane, MapGU()); continue; } r -= I_GU;
            wt_item(args.in[15], nullptr, DFF, DM, WD, nullptr, nullptr, 0, scr, r, DM / 32, lane, MapId());
        }
        for (int i = bx * 512 + tid; i < SEQS * 16; i += G * 512) { const int pos = i >> 4, j = i & 15;
            double inv = 1.0; for (int q = 0; q < j; ++q) inv *= 0.5623413251903491;
            const float ang = (float)pos * (float)inv; float sn, cs; sincos_d(ang, sn, cs); COS[i] = cs; SIN[i] = sn; }
        const float* g = args.in[2];
        f32x4 gv[4];
#pragma unroll
        for (int j = 0; j < 4; ++j) gv[j] = *(const f32x4*)(g + 4 * lane + 256 * j);
        for (int m = gw; m < TOK; m += NGW) {
            const float* xr = (m < TOKP ? xp + (size_t)m * DM : xs + (size_t)(m - TOKP) * DM) + 4 * lane;
            f32x4 v[4]; float s = 0.f;
#pragma unroll
            for (int j = 0; j < 4; ++j) { v[j] = *(const f32x4*)(xr + 256 * j); s += dot4(v[j]); }
            const float rstd = 1.0f / sqrtf(wave_sum(s) * (1.0f / DM) + EPS);
#pragma unroll
            for (int j = 0; j < 4; ++j) { const f32x4 o = v[j] * rstd * gv[j]; u32x2 w; w.x = pk2(o[0], o[1]); w.y = pk2(o[2], o[3]); *(u32x2*)(H + (size_t)m * DM + 4 * lane + 256 * j) = w; }
        }
    }
    SEAM(0);
    REP(1) if (IN(1)) {
        pg8::Gemm g{H, WIN, TOK, N1P, DM}; pg8::StaticOrder S; S.init(TOK, N1P, G, bx);
        Epi1 E{CQ, CKV, KR, NAB, SSQ, SSKV, COS, SIN};
        pg8::gemm_phase<Epi1, true>(lds, g, S, E);
    }
    SEAM(1);
    REP(2) if (IN(2)) {
        { pg8::Gemm g{CQ, WUQ, TOK, 768, QL}; pg8::StaticOrder S; S.init(TOK, 768, G, bx); Epi2 E{Qb, SSQ, COS, SIN}; pg8::gemm_phase<Epi2, true>(lds, g, S, E); }
        { pg8::Gemm g{CKV, WUKV, TOK, 1024, KVL}; pg8::StaticOrder S; S.init(TOK, 1024, G, bx); Epi3 E{KN, Vb, SSKV}; pg8::gemm_phase<Epi3, true>(lds, g, S, E); }
    }
    SEAM(2);
    REP(3) if (IN(3)) {
        if (G == 256) {
            const int x = vcu >> 5, j = vcu & 31;
            for (int i = 0; i < 2; ++i) { const int pair = 2 * x + i; att::mla_unit(lds, TOKP + (pair >> 3) * SEQS, SEQS, pair & 7, j * 256, Qb, KN, KR, Vb, AB, SSA); }
            for (int i = 0; i < 4; ++i) { const int L = 4 * j + i, pair = 16 * x + (L >> 3); att::mla_unit(lds, (pair >> 3) * SEQP, SEQP, pair & 7, (L & 7) * 256, Qb, KN, KR, Vb, AB, SSA); }
        } else {
            for (int U = vcu; U < 512; U += G) { const int pair = U >> 5; att::mla_unit(lds, TOKP + (pair >> 3) * SEQS, SEQS, pair & 7, (U & 31) * 256, Qb, KN, KR, Vb, AB, SSA); }
            for (int U = vcu; U < 1024; U += G) { const int pair = U >> 3; att::mla_unit(lds, (pair >> 3) * SEQP, SEQP, pair & 7, (U & 7) * 256, Qb, KN, KR, Vb, AB, SSA); }
        }
        for (int U = vcu; U < 1536; U += G) {
            if (U < 1024) { const int h = U & 7, grp = U >> 3; att::na_unit(lds, (grp >> 3) * SEQP, 32, h, (grp & 7) * 4, NAB, args.in[8], AB, SSB); }
            else { const int U2 = U - 1024, h = U2 & 7, grp = U2 >> 3; att::na_unit(lds, TOKP + (grp >> 5) * SEQS, 128, h, (grp & 31) * 4, NAB, args.in[8], AB, SSB); }
        }
    }
    SEAM(3);
    REP(4) if (IN(4)) {
        pg8::Gemm g{AB, WO, TOK, DM, DM}; pg8::StaticOrder S; S.init(TOK, DM, G, bx);
        Epi4 E{xp, xs, X1, SSA, SSB, SS1};
        pg8::gemm_phase<Epi4, true>(lds, g, S, E);
    }
    SEAM(4);
    REP(5) if (IN(5)) {
        pg8::Gemm g{X1, WGU, TOK, NGU, DM}; pg8::StaticOrder S; S.init(TOK, NGU, G, bx);
        Epi5 E{ACT, SS1};
        pg8::gemm_phase<Epi5, true>(lds, g, S, E);
    }
    SEAM(5);
    REP(6) if (IN(6)) {
        pg8::Gemm g{ACT, WD, TOK, DM, DFF}; pg8::StaticOrder S; S.init(TOK, DM, G, bx);
        Epi6 E{X1, args.out, SS2};
        pg8::gemm_phase<Epi6, true>(lds, g, S, E);
    }
    SEAM(6);
    for (int es_ = 0; es_ < EXTRA_SYNCS; ++es_) xcd_barrier(bar);
    REP(7) if (IN(7)) {
        const int gw = vcu * 8 + wave, NGW = G * 8; const float* g = args.in[16];
        f32x4 gv[4];
#pragma unroll
        for (int j = 0; j < 4; ++j) gv[j] = *(const f32x4*)(g + 4 * lane + 256 * j);
        for (int m = gw; m < TOK; m += NGW) { float* o = args.out + (size_t)m * DM + 4 * lane; const float r = rstd16(SS2 + (size_t)m * 16);
#pragma unroll
            for (int j = 0; j < 4; ++j) { const f32x4 v = *(const f32x4*)(o + 256 * j); *(f32x4*)(o + 256 * j) = v * r * gv[j]; } }
    }
#undef IN
#undef SEAM
}

#if MK_DEBUG
__device__ __forceinline__ float block_sum(float v, LAS float* red) {
    v = wave_sum(v); __syncthreads(); if ((threadIdx.x & 63) == 0) red[threadIdx.x >> 6] = v; __syncthreads(); const float r = (red[0] + red[1]) + (red[2] + red[3]); __syncthreads(); return r;
}
__device__ __forceinline__ void report(unsigned* ctl, int phase, float rel2) {
    if (!(rel2 < 2e-4f)) { const int b = !(rel2 == rel2) ? 9 : rel2 < 1e-3f ? 1 : rel2 < 1e-2f ? 2 : rel2 < 1e-1f ? 3 : rel2 < 0.5f ? 4 : rel2 < 2.f ? 5 : 6; atomicMax(ctl + CW_FAIL, (unsigned)((8 - phase) * 16 + b)); }
}
__device__ __forceinline__ int chk_row(int b) { const int t = b >> 8; return (t == 0 ? 0 : t == 1 ? 77 : t == 2 ? 130 : 191) * 256 + (b & 255); }
__device__ __forceinline__ void rope_ref(int pos, int j, float& sn, float& cs) { const float inv = __powf(10000.0f, -(float)j / 16.0f); const float ang = (float)pos * inv; const double a = (double)ang; const double r = a - __builtin_rint(a * 0.15915494309189535) * 6.283185307179586; sn = __sinf((float)r); cs = __cosf((float)r); }

__global__ void __launch_bounds__(256) chk_phase(Args args, int phase) {
    __shared__ float buf[5632]; __shared__ float inb[2816]; __shared__ float red4[4];
    LAS float* red = (LAS float*)red4;
    unsigned char* ws = args.ws; unsigned* ctl = (unsigned*)(ws + WS_CTL);
    const int tid = threadIdx.x; const int row = chk_row(blockIdx.x);
    const float* xrow = row < TOKP ? args.in[0] + (size_t)row * DM : args.in[1] + (size_t)(row - TOKP) * DM;
    const bf16_t *H = (const bf16_t*)(ws + WS_H), *AB = (const bf16_t*)(ws + WS_AB), *CQ = (const bf16_t*)(ws + WS_CQ), *CKV = (const bf16_t*)(ws + WS_CKV), *KR = (const bf16_t*)(ws + WS_KR), *NAB = (const bf16_t*)(ws + WS_NA);
    const bf16_t *Qb = (const bf16_t*)(ws + WS_Q), *KN = (const bf16_t*)(ws + WS_KN), *Vb = (const bf16_t*)(ws + WS_V), *X1 = (const bf16_t*)(ws + WS_X1), *ACT = (const bf16_t*)(ws + WS_ACT);
    float d2 = 0.f, e2 = 0.f;
    if (phase == 0) {
        float s = 0.f; for (int k = tid; k < DM; k += 256) s += xrow[k] * xrow[k];
        const float rstd = rsqrtf(block_sum(s, red) / DM + EPS);
        for (int k = tid; k < DM; k += 256) { const float e = xrow[k] * rstd * args.in[2][k], f = bf2f(H[(size_t)row * DM + k]); d2 += (f - e) * (f - e); e2 += e * e; }
    } else if (phase == 1) {
        for (int k = tid; k < DM; k += 256) inb[k] = bf2f(H[(size_t)row * DM + k]);
        __syncthreads();
        for (int n = tid; n < NIN; n += 256) { float a = 0.f; for (int k = 0; k < DM; ++k) a += inb[k] * args.in[3][(size_t)k * NIN + n]; buf[n] = a; }
        __syncthreads();
        const int pos = seq_pos(row);
        for (int n = tid; n < NIN; n += 256) { float e, f;
            if (n < 384) { e = buf[n]; f = bf2f(CQ[(size_t)row * QL + n]); }
            else if (n < 640) { e = buf[n]; f = bf2f(CKV[(size_t)row * KVL + n - 384]); }
            else if (n < 672) { const int j = n - 640, jj = j & 15; float sn, cs; rope_ref(pos, jj, sn, cs); const float x1 = buf[640 + jj], x2 = buf[656 + jj]; e = j < 16 ? x1 * cs - x2 * sn : x1 * sn + x2 * cs; f = bf2f(KR[(size_t)row * 32 + j]); }
            else { const int c = n - 672; e = buf[n] * (c < 512 ? QSC_NA : 1.f); f = bf2f(NAB[(size_t)row * 1536 + c]); }
            d2 += (f - e) * (f - e); e2 += e * e; }
        float sq = 0.f, sk = 0.f; for (int n = tid; n < 640; n += 256) { if (n < 384) sq += buf[n] * buf[n]; else sk += buf[n] * buf[n]; }
        sq = block_sum(sq, red); sk = block_sum(sk, red);
        if (tid == 0) { float fq = 0.f, fk = 0.f; for (int i = 0; i < 12; ++i) fq += ((const float*)(ws + WS_SSQ))[(size_t)row * 12 + i]; for (int i = 0; i < 8; ++i) fk += ((const float*)(ws + WS_SSKV))[(size_t)row * 8 + i];
            const float rq = (fq - sq) / sq, rk = (fk - sk) / sk; report(ctl, 1, rq * rq + rk * rk); }
    } else if (phase == 2) {
        float s = 0.f; for (int k = tid; k < QL; k += 256) { const float v = bf2f(CQ[(size_t)row * QL + k]); inb[k] = v; s += v * v; }
        float s2 = 0.f; for (int k = tid; k < KVL; k += 256) { const float v = bf2f(CKV[(size_t)row * KVL + k]); inb[512 + k] = v; s2 += v * v; }
        const float rq = rsqrtf(block_sum(s, red) / QL + EPS), rk = rsqrtf(block_sum(s2, red) / KVL + EPS);
        for (int k = tid; k < QL; k += 256) inb[k] *= rq * args.in[4][k];
        for (int k = tid; k < KVL; k += 256) inb[512 + k] *= rk * args.in[5][k];
        __syncthreads();
        for (int n = tid; n < 768; n += 256) { float a = 0.f; for (int k = 0; k < QL; ++k) a += inb[k] * args.in[6][(size_t)k * 768 + n]; buf[n] = a; }
        for (int n = tid; n < 1024; n += 256) { float a = 0.f; for (int k = 0; k < KVL; ++k) a += inb[512 + k] * args.in[7][(size_t)k * 1024 + n]; buf[1024 + n] = a; }
        __syncthreads();
        const int pos = seq_pos(row);
        for (int n = tid; n < 768; n += 256) { const int h = n / 96, w = n - 96 * h; float e;
            if (w < 64) e = buf[n]; else { const int j = w - 64, jj = j & 15; float sn, cs; rope_ref(pos, jj, sn, cs); const float x1 = buf[h * 96 + 64 + jj], x2 = buf[h * 96 + 80 + jj]; e = j < 16 ? x1 * cs - x2 * sn : x1 * sn + x2 * cs; }
            e *= QSC_MLA; const float f = bf2f(Qb[(size_t)row * 768 + n]); d2 += (f - e) * (f - e); e2 += e * e; }
        for (int n = tid; n < 1024; n += 256) { const int h = n >> 7, w = n & 127; const float e = buf[1024 + n]; const float f = w < 64 ? bf2f(KN[(size_t)row * 512 + h * 64 + w]) : bf2f(Vb[(size_t)row * 512 + h * 64 + w - 64]); d2 += (f - e) * (f - e); e2 += e * e; }
    } else if (phase == 4) {
        float sa = 0.f, sb = 0.f; for (int k = tid; k < DM; k += 256) { const float v = bf2f(AB[(size_t)row * DM + k]); inb[k] = v; if (k < 512) sa += v * v; else sb += v * v; }
        const float ra = rsqrtf(block_sum(sa, red) / 512 + EPS), rb = rsqrtf(block_sum(sb, red) / 512 + EPS);
        for (int k = tid; k < DM; k += 256) inb[k] *= (k < 512 ? ra * args.in[9][k] : rb * args.in[10][k - 512]);
        __syncthreads();
        for (int n = tid; n < DM; n += 256) { float a = 0.f; for (int k = 0; k < DM; ++k) a += inb[k] * args.in[11][(size_t)k * DM + n]; const float e = xrow[n] + a, f = bf2f(X1[(size_t)row * DM + n]); d2 += (f - e) * (f - e); e2 += e * e; }
    } else if (phase == 5) {
        float s = 0.f; for (int k = tid; k < DM; k += 256) { const float v = bf2f(X1[(size_t)row * DM + k]); inb[k] = v; s += v * v; }
        const float r = rsqrtf(block_sum(s, red) / DM + EPS);
        for (int k = tid; k < DM; k += 256) inb[k] *= r * args.in[12][k];
        __syncthreads();
        for (int n = tid; n < DFF; n += 256) { float a = 0.f, b = 0.f; for (int k = 0; k < DM; ++k) { a += inb[k] * args.in[13][(size_t)k * DFF + n]; b += inb[k] * args.in[14][(size_t)k * DFF + n]; }
            const float e = a / (1.f + __expf(-a)) * b, f = bf2f(ACT[(size_t)row * DFF + n]); d2 += (f - e) * (f - e); e2 += e * e; }
    } else if (phase == 7) {
        for (int k = tid; k < DFF; k += 256) inb[k] = bf2f(ACT[(size_t)row * DFF + k]);
        __syncthreads();
        float s = 0.f;
        for (int n = tid; n < DM; n += 256) { float a = 0.f; for (int k = 0; k < DFF; ++k) a += inb[k] * args.in[15][(size_t)k * DM + n]; const float v = bf2f(X1[(size_t)row * DM + n]) + a; buf[n] = v; s += v * v; }
        const float r = rsqrtf(block_sum(s, red) / DM + EPS);
        for (int n = tid; n < DM; n += 256) { const float e = buf[n] * r * args.in[16][n], f = args.out[(size_t)row * DM + n]; d2 += (f - e) * (f - e); e2 += e * e; }
    }
    d2 = block_sum(d2, red); e2 = block_sum(e2, red);
    if (tid == 0) report(ctl, phase, d2 / e2);
}
__global__ void __launch_bounds__(64) chk_attn(Args args) {
    __shared__ float sc[8192]; __shared__ float qv[96];
    unsigned char* ws = args.ws; unsigned* ctl = (unsigned*)(ws + WS_CTL);
    const bf16_t *AB = (const bf16_t*)(ws + WS_AB), *KR = (const bf16_t*)(ws + WS_KR), *NAB = (const bf16_t*)(ws + WS_NA), *Qb = (const bf16_t*)(ws + WS_Q), *KN = (const bf16_t*)(ws + WS_KN), *Vb = (const bf16_t*)(ws + WS_V);
    const int sidx = blockIdx.x >> 1, kind = blockIdx.x & 1, lane = threadIdx.x;
    const int row = (int)(((long)sidx * 2731 + 17) % TOK), h = (sidx / 3) & 7;
    const int rowbase = row < TOKP ? (row / SEQP) * SEQP : TOKP + ((row - TOKP) / SEQS) * SEQS, S = row < TOKP ? SEQP : SEQS, t = row - rowbase;
    float o = 0.f, e2 = 0.f, d2 = 0.f;
    if (kind == 0) {
        for (int d = lane; d < 96; d += 64) qv[d] = bf2f(Qb[(size_t)row * 768 + h * 96 + d]);
        __syncthreads();
        float mx = -INFINITY;
        for (int j = lane; j < S; j += 64) { float s = 0.f; const bf16_t* kn = KN + (size_t)(rowbase + j) * 512 + h * 64; const bf16_t* kr = KR + (size_t)(rowbase + j) * 32;
            for (int d = 0; d < 64; ++d) s += qv[d] * bf2f(kn[d]); for (int d = 0; d < 32; ++d) s += qv[64 + d] * bf2f(kr[d]); sc[j] = s; mx = fmaxf(mx, s); }
        for (int of = 1; of < 64; of <<= 1) mx = fmaxf(mx, __shfl_xor(mx, of));
        float l = 0.f; for (int j = lane; j < S; j += 64) { const float p = exp2f(sc[j] - mx); sc[j] = p; l += p; }
        l = wave_sum(l); __syncthreads();
        for (int j = 0; j < S; ++j) o += sc[j] * bf2f(Vb[(size_t)(rowbase + j) * 512 + h * 64 + lane]);
        o /= l; const float f = bf2f(AB[(size_t)row * DM + h * 64 + lane]); d2 = (f - o) * (f - o); e2 = o * o;
        const float ssf = ((const float*)(ws + WS_SSA))[(size_t)row * 8 + h]; d2 = wave_sum(d2); e2 = wave_sum(e2);
        if (lane == 0) { const float rs = (ssf - e2) / e2; report(ctl, 3, d2 / e2 + (fabsf(rs) > 0.05f ? rs * rs : 0.f)); }
    } else {
        const int rows = S / 64, r = t >> 6, qc = t & 63; const int start = min(max(r - 4, 0), rows - 8), cs = min(max(qc - 8, 0), 48);
        for (int d = lane; d < 64; d += 64) qv[d] = bf2f(NAB[(size_t)row * 1536 + h * 64 + d]);
        __syncthreads();
        float mx = -INFINITY;
        for (int j = lane; j < 128; j += 64) { const int kr_ = start + (j >> 4), kc = cs + (j & 15); const bf16_t* kp = NAB + (size_t)(rowbase + kr_ * 64 + kc) * 1536 + 512 + h * 64;
            float s = 0.f; for (int d = 0; d < 64; ++d) s += qv[d] * bf2f(kp[d]);
            s += args.in[8][h * 465 + (kr_ - r + 7) * 31 + (kc - qc + 15)] * LOG2E; sc[j] = s; mx = fmaxf(mx, s); }
        for (int of = 1; of < 64; of <<= 1) mx = fmaxf(mx, __shfl_xor(mx, of));
        float l = 0.f; for (int j = lane; j < 128; j += 64) { const float p = exp2f(sc[j] - mx); sc[j] = p; l += p; }
        l = wave_sum(l); __syncthreads();
        for (int j = 0; j < 128; ++j) { const int kr_ = start + (j >> 4), kc = cs + (j & 15); o += sc[j] * bf2f(NAB[(size_t)(rowbase + kr_ * 64 + kc) * 1536 + 1024 + h * 64 + lane]); }
        o /= l; const float f = bf2f(AB[(size_t)row * DM + 512 + h * 64 + lane]); d2 = (f - o) * (f - o); e2 = o * o;
        const float ssf = ((const float*)(ws + WS_SSB))[(size_t)row * 8 + h]; d2 = wave_sum(d2); e2 = wave_sum(e2);
        if (lane == 0) { const float rs = (ssf - e2) / e2; report(ctl, 3, d2 / e2 + (fabsf(rs) > 0.05f ? rs * rs : 0.f)); }
    }
}
__global__ void __launch_bounds__(256) chk_final(Args args) {
    const unsigned code = ((const unsigned*)(args.ws + WS_CTL))[CW_FAIL];
    if (code == 0) return;
    const int k = 8 - (int)(code >> 4), b = (int)(code & 15); const float c = sqrtf(1.0f + (float)k + 0.1f * (float)b);
    for (size_t i = (size_t)blockIdx.x * 256 + threadIdx.x; i < (size_t)TOK * DM; i += (size_t)gridDim.x * 256) args.out[i] = c;
}
#endif

extern "C" void kernel_launch(void* const* d_in, const int* in_sizes, int n_in, void* d_out, int out_size, void* d_ws, size_t ws_size, hipStream_t stream) {
    static int grid = 0;
    if (grid == 0) {
        if (n_in != 17 || out_size != TOK * DM || ws_size < WS_NEED) { fprintf(stderr, "kernel_launch: unexpected problem (n_in %d, out %d, ws %zu; need %zu)\n", n_in, out_size, ws_size, (size_t)WS_NEED); grid = -1; return; }
        int dev = 0, cus = 0, per_cu = 0;
        hipGetDevice(&dev); hipDeviceGetAttribute(&cus, hipDeviceAttributeMultiprocessorCount, dev);
        if (hipFuncSetAttribute((const void*)mega, hipFuncAttributeMaxDynamicSharedMemorySize, LDS_BYTES) != hipSuccess) { fprintf(stderr, "kernel_launch: hipFuncSetAttribute failed\n"); grid = -1; return; }
        if (hipOccupancyMaxActiveBlocksPerMultiprocessor(&per_cu, (const void*)mega, 512, LDS_BYTES) != hipSuccess || per_cu < 1) { fprintf(stderr, "kernel_launch: occupancy query says %d\n", per_cu); per_cu = 1; }
        (void)hipGetLastError();
        grid = cus * 1;
    }
    if (grid < 0) return;
    hipMemsetAsync((char*)d_ws + WS_CTL, 0, CTL_ZERO_BYTES, stream);
    Args a{};
    for (int i = 0; i < 17; ++i) a.in[i] = (const float*)d_in[i];
    a.out = (float*)d_out; a.ws = (unsigned char*)d_ws;
#if MK_ONE_LAUNCH
    a.ph_lo = 0; a.ph_hi = NPHASE;
    void* kargs[] = {&a};
    hipError_t e = hipLaunchCooperativeKernel((const void*)mega, dim3(grid), dim3(512), kargs, LDS_BYTES, stream);
    if (e != hipSuccess) fprintf(stderr, "kernel_launch: cooperative launch failed: %s (grid %d)\n", hipGetErrorString(e), grid);
#else
    for (int ph = 0; ph < NPHASE; ++ph) {
        a.ph_lo = ph; a.ph_hi = ph + 1;
        hipLaunchKernelGGL(mega, dim3(grid), dim3(512), LDS_BYTES, stream, a);
#if MK_DEBUG
        if (ph == 3) hipLaunchKernelGGL(chk_attn, dim3(2 * 1536), dim3(64), 0, stream, a);
        else if (ph != 6) hipLaunchKernelGGL(chk_phase, dim3(1024), dim3(256), 0, stream, a, ph);
#endif
    }
#if MK_DEBUG
    hipLaunchKernelGGL(chk_final, dim3(2048), dim3(256), 0, stream, a);
#endif
#endif
}
```

```cpp
#include <hip/hip_runtime.h>
#include <hip/hip_cooperative_groups.h>
#include <cstdio>
#include <cstdint>
namespace cg = cooperative_groups;

#ifndef MK_ONE_LAUNCH
#define MK_ONE_LAUNCH 1
#endif
#ifndef MK_DEBUG
#define MK_DEBUG 0
#endif

#define GAS __attribute__((address_space(1)))
#define LAS __attribute__((address_space(3)))
typedef unsigned short bf16_t;
typedef short bf16x8 __attribute__((ext_vector_type(8)));
typedef short s16x4 __attribute__((ext_vector_type(4)));
typedef short v4i16_t __attribute__((ext_vector_type(4)));
typedef float f32x2 __attribute__((ext_vector_type(2)));
typedef float f32x4 __attribute__((ext_vector_type(4)));
typedef float f32x16 __attribute__((ext_vector_type(16)));
typedef unsigned u32x2 __attribute__((ext_vector_type(2)));
typedef unsigned u32x4 __attribute__((ext_vector_type(4)));
typedef __bf16 bf16x2_t __attribute__((ext_vector_type(2)));

__device__ __forceinline__ unsigned pk2(float lo, float hi) { f32x2 v = {lo, hi}; bf16x2_t b = __builtin_convertvector(v, bf16x2_t); return __builtin_bit_cast(unsigned, b); }
__device__ __forceinline__ float bf2f(unsigned b) { return __builtin_bit_cast(float, b << 16); }
__device__ __forceinline__ float bflo(unsigned w) { return __builtin_bit_cast(float, w << 16); }
__device__ __forceinline__ float bfhi(unsigned w) { return __builtin_bit_cast(float, w & 0xffff0000u); }
__device__ __forceinline__ u32x4 pack8(f32x4 a, f32x4 b) { u32x4 w; w.x = pk2(a[0], a[1]); w.y = pk2(a[2], a[3]); w.z = pk2(b[0], b[1]); w.w = pk2(b[2], b[3]); return w; }
__device__ __forceinline__ float sum4(f32x4 v) { return (v[0] + v[1]) + (v[2] + v[3]); }
__device__ __forceinline__ float dot4(f32x4 v) { return (v[0] * v[0] + v[1] * v[1]) + (v[2] * v[2] + v[3] * v[3]); }

constexpr int DM = 1024, TOK = 49152, TOKP = 32768, SEQP = 2048, SEQS = 8192;
constexpr int QL = 384, KVL = 256, NIN = 2208, N1P = 2304, DFF = 2816, NGU = 5632;
constexpr float EPS = 1e-6f, LOG2E = 1.4426950408889634f;
constexpr float QSC_MLA = 0.10206207261596575f * LOG2E;
constexpr float QSC_NA = 0.125f * LOG2E;
__device__ __forceinline__ int seq_pos(int row) { return row < TOKP ? (row & (SEQP - 1)) : (row & (SEQS - 1)); }

constexpr size_t KiB = 1024, MiB = 1u << 20;
constexpr size_t WS_CTL = 0, CTL_ZERO_BYTES = 64 * KiB;
constexpr size_t WS_COS = 1 * MiB, WS_SIN = WS_COS + 512 * KiB;
constexpr size_t WS_WIN = 2 * MiB;
constexpr size_t WS_WUQ = WS_WIN + (size_t)N1P * DM * 2;
constexpr size_t WS_WUKV = WS_WUQ + 768 * 384 * 2;
constexpr size_t WS_WO = WS_WUKV + 1024 * 256 * 2;
constexpr size_t WS_WGU = WS_WO + 1024 * 1024 * 2;
constexpr size_t WS_WD = WS_WGU + (size_t)NGU * DM * 2;
constexpr size_t WS_WEND = WS_WD + (size_t)DM * DFF * 2;
constexpr size_t WS_SSQ = 27 * MiB;
constexpr size_t WS_SSKV = WS_SSQ + (size_t)TOK * 12 * 4;
constexpr size_t WS_SSA = WS_SSKV + (size_t)TOK * 8 * 4;
constexpr size_t WS_SSB = WS_SSA + (size_t)TOK * 8 * 4;
constexpr size_t WS_SS1 = WS_SSB + (size_t)TOK * 8 * 4;
constexpr size_t WS_SS2 = WS_SS1 + (size_t)TOK * 16 * 4;
constexpr size_t WS_SSEND = WS_SS2 + (size_t)TOK * 16 * 4;
constexpr size_t WS_H = 40 * MiB;
constexpr size_t WS_AB = WS_H;
constexpr size_t WS_CQ = 136 * MiB;
constexpr size_t WS_CKV = WS_CQ + (size_t)TOK * QL * 2;
constexpr size_t WS_KR = WS_CKV + (size_t)TOK * KVL * 2;
constexpr size_t WS_NA = WS_KR + (size_t)TOK * 32 * 2;
constexpr size_t WS_Q = WS_NA + (size_t)TOK * 1536 * 2;
constexpr size_t WS_KN = WS_Q + (size_t)TOK * 768 * 2;
constexpr size_t WS_V = WS_KN + (size_t)TOK * 512 * 2;
constexpr size_t WS_END1 = WS_V + (size_t)TOK * 512 * 2;
constexpr size_t WS_X1 = 136 * MiB;
constexpr size_t WS_ACT = 232 * MiB;
constexpr size_t WS_NEED = 511 * MiB;
static_assert(WS_WEND <= WS_SSQ && WS_SSEND <= WS_H && WS_H + (size_t)TOK * DM * 2 <= WS_CQ && WS_END1 <= WS_NEED, "d_ws map");
static_assert(WS_X1 + (size_t)TOK * DM * 2 <= WS_ACT && WS_ACT + (size_t)TOK * DFF * 2 <= WS_NEED, "d_ws overlays");
constexpr int CW_FAIL = 16, CW_BAR = 1024;

constexpr int RING_BYTES = 131072, LDS_BYTES = 147456;

namespace pg8 {
constexpr int BM = 256, BK = 64, HALF = 128, HTB = HALF * BK * 2, STAGE_BYTES = 8 * HTB, NXCD = 8, WGM = 8;
__host__ __device__ __forceinline__ int lds_byte(int r, int c) { const int st = (r >> 4) * 2 + (c >> 5), rr = r & 15, cc = c & 31, ob = rr * 64 + cc * 2; return st * 1024 + (ob ^ (((ob >> 9) & 1) << 5)); }
__host__ __device__ __forceinline__ void stage_rc(int b, int& R, int& C) { const int st = b / 1024, sb = b % 1024, swz = sb ^ (((sb >> 9) & 1) << 5); R = (st >> 1) * 16 + swz / 64; C = (st & 1) * 32 + (swz % 64) / 2; }
__host__ __device__ __forceinline__ int perm32(int rho) { const int n = rho >> 4, i = rho & 15; return 8 * (i >> 2) + 4 * n + (i & 3); }

struct Unit { int pm, pn; };
struct Gemm { const bf16_t* A; const bf16_t* Bt; int M, N, K; };

struct StaticOrder {
    int nM, nN, nwg, G, c;
    __device__ void init(int M, int N, int G_, int c_) { nM = M / BM; nN = N / BM; nwg = nM * nN; G = G_; c = c_; }
    __device__ bool next(int i, Unit& u) const {
        const long L = (long)i * G + c; if (L >= nwg) return false;
        int wgid = (int)L; { const int q = nwg / NXCD, r = nwg % NXCD, xcd = wgid % NXCD, off = wgid / NXCD; wgid = (xcd < r ? xcd * (q + 1) : r * (q + 1) + (xcd - r) * q) + off; }
        const int nig = WGM * nN, gid = wgid / nig, fm = gid * WGM, gsz = (nM - fm) < WGM ? (nM - fm) : WGM;
        u.pm = fm + ((wgid % nig) % gsz); u.pn = (wgid % nig) / gsz; return true;
    }
};

template <class Epi, bool ALIGN_EPI>
__device__ __forceinline__ void gemm_phase(LAS unsigned char* lds, const Gemm g, const StaticOrder& S, const Epi& E) {
    int tid = threadIdx.x; asm volatile("" : "+v"(tid));
    const int wid = __builtin_amdgcn_readfirstlane(tid >> 6), lane = tid & 63, wr = wid >> 2, wc = wid & 3, fr = lane & 15, fq = lane >> 4;
    const int K = g.K, nt = K / BK;
    unsigned voffA[2], voffB[2];
#pragma unroll
    for (int i = 0; i < 2; ++i) { int R, C; stage_rc(tid * 16 + i * 8192, R, C); const int Rb = Epi::PERM ? ((R & ~31) + perm32(R & 31)) : R;
        voffA[i] = (unsigned)(R * K + C) * 2u; voffB[i] = (unsigned)(Rb * K + C) * 2u; }
    const size_t kstep = (size_t)(BK * 2);
    const size_t hstep = (size_t)HALF * K * 2;
    const size_t tstep = 2 * hstep;
    const unsigned ldsw = (unsigned)wid * 1024u;
    const int aoff = lds_byte(wr * 64 + fr, fq * 8), boff = lds_byte(wc * 32 + fr, fq * 8);
#define PG8_SA(b, h) (((b) * 2 + (h)) * HTB)
#define PG8_SB(b, h) ((4 + (b) * 2 + (h)) * HTB)
#define PG8_STAGE(bufoff, gbase, voff) do { _Pragma("unroll") for (int _i = 0; _i < 2; ++_i) \
        __builtin_amdgcn_global_load_lds((const unsigned*)((const char*)(gbase) + (voff)[_i]), (LAS unsigned*)(lds + (bufoff) + ldsw + _i * 8192), 16, 0, 0); } while (0)
#define PG8_LDA(dst, b, h) do { _Pragma("unroll") for (int m = 0; m < 4; ++m) _Pragma("unroll") for (int k = 0; k < 2; ++k) dst[m][k] = *(const LAS bf16x8*)(lds + PG8_SA(b, h) + aoff + m * 2048 + k * 1024); } while (0)
#define PG8_LDB(dst, b, h) do { _Pragma("unroll") for (int n = 0; n < 2; ++n) _Pragma("unroll") for (int k = 0; k < 2; ++k) dst[n][k] = *(const LAS bf16x8*)(lds + PG8_SB(b, h) + boff + n * 2048 + k * 1024); } while (0)
#define PG8_MMA(ai, bj, At, Bt) do { __builtin_amdgcn_s_setprio(1); _Pragma("unroll") for (int m = 0; m < 4; ++m) _Pragma("unroll") for (int n = 0; n < 2; ++n) _Pragma("unroll") for (int k = 0; k < 2; ++k) \
        acc[ai][bj][m][n] = __builtin_amdgcn_mfma_f32_16x16x32_bf16(Bt[n][k], At[m][k], acc[ai][bj][m][n], 0, 0, 0); __builtin_amdgcn_s_setprio(0); } while (0)
#define PG8_WAIT_V(n) asm volatile("s_waitcnt vmcnt(" #n ")" ::: "memory")
#define PG8_WAIT_L(n) asm volatile("s_waitcnt lgkmcnt(" #n ")" ::: "memory")
#define PG8_BAR __builtin_amdgcn_s_barrier()
#define PG8_SCHED __builtin_amdgcn_sched_barrier(0)
    Unit cur, nxt; int ui = 0;
    if (!S.next(0, cur)) return;
    f32x4 acc[2][2][4][2];
#pragma unroll
    for (int a = 0; a < 2; ++a)
#pragma unroll
        for (int b = 0; b < 2; ++b)
#pragma unroll
            for (int m = 0; m < 4; ++m)
#pragma unroll
                for (int n = 0; n < 2; ++n) acc[a][b][m][n] = (f32x4){0.f, 0.f, 0.f, 0.f};
    bf16x8 At[4][2], B0[2][2], B1[2][2];
    const char* cA = (const char*)g.A + (size_t)cur.pm * tstep; const char* cB = (const char*)g.Bt + (size_t)cur.pn * tstep;
    PG8_STAGE(PG8_SB(0, 0), cB, voffB); PG8_STAGE(PG8_SB(0, 1), cB + hstep, voffB); PG8_STAGE(PG8_SA(0, 0), cA, voffA); PG8_STAGE(PG8_SA(0, 1), cA + hstep, voffA);
    if (wr == 1) PG8_BAR;
    PG8_WAIT_V(2); PG8_BAR;
    PG8_STAGE(PG8_SB(1, 0), cB + kstep, voffB); PG8_STAGE(PG8_SA(1, 0), cA + kstep, voffA); PG8_STAGE(PG8_SB(1, 1), cB + hstep + kstep, voffB);
    PG8_WAIT_V(6); PG8_BAR;
    for (;;) {
        const bool has_next = S.next(ui + 1, nxt);
        const char* nA = has_next ? (const char*)g.A + (size_t)nxt.pm * tstep : cA; const char* nB = has_next ? (const char*)g.Bt + (size_t)nxt.pn * tstep : cB;
#pragma unroll 1
        for (int t = 0; t < nt; t += 2) {
            if constexpr (Epi::MID_T >= 0) { if (t == Epi::MID_T) E.mid(acc, cur, wr, wc, fr, fq); }
            const bool last = (t == nt - 2);
            const char* a1 = cA + (size_t)(t + 1) * kstep;
            const char* a2 = last ? nA : cA + (size_t)(t + 2) * kstep; const char* b2 = last ? nB : cB + (size_t)(t + 2) * kstep;
            const char* a3 = a2 + kstep; const char* b3 = b2 + kstep;
            PG8_LDB(B0, 0, 0); PG8_LDB(B1, 0, 1); PG8_SCHED; PG8_LDA(At, 0, 0); PG8_STAGE(PG8_SA(1, 1), a1 + hstep, voffA);
            PG8_WAIT_V(8); PG8_WAIT_L(0); PG8_BAR; PG8_MMA(0, 0, At, B0); PG8_MMA(0, 1, At, B1); PG8_BAR; PG8_SCHED;
            PG8_LDA(At, 0, 1); PG8_STAGE(PG8_SB(0, 0), b2, voffB); PG8_STAGE(PG8_SB(0, 1), b2 + hstep, voffB); PG8_STAGE(PG8_SA(0, 0), a2, voffA);
            PG8_WAIT_V(8); PG8_WAIT_L(0); PG8_BAR; PG8_MMA(1, 0, At, B0); PG8_MMA(1, 1, At, B1); PG8_BAR; PG8_SCHED;
            PG8_LDB(B0, 1, 0); PG8_LDB(B1, 1, 1); PG8_SCHED; PG8_LDA(At, 1, 0); PG8_STAGE(PG8_SA(0, 1), a2 + hstep, voffA);
            PG8_WAIT_V(8); PG8_WAIT_L(0); PG8_BAR; PG8_MMA(0, 0, At, B0); PG8_MMA(0, 1, At, B1); PG8_BAR; PG8_SCHED;
            PG8_LDA(At, 1, 1); PG8_STAGE(PG8_SB(1, 0), b3, voffB); PG8_STAGE(PG8_SB(1, 1), b3 + hstep, voffB); PG8_STAGE(PG8_SA(1, 0), a3, voffA);
            PG8_WAIT_V(8); PG8_WAIT_L(0); PG8_BAR; PG8_MMA(1, 0, At, B0); PG8_MMA(1, 1, At, B1); PG8_BAR; PG8_SCHED;
        }
        if constexpr (ALIGN_EPI) { if (wr == 0) PG8_BAR; }
        E(acc, cur, wr, wc, fr, fq);
        if (!has_next) break;
#pragma unroll
        for (int a = 0; a < 2; ++a)
#pragma unroll
            for (int b = 0; b < 2; ++b)
#pragma unroll
                for (int m = 0; m < 4; ++m)
#pragma unroll
                    for (int n = 0; n < 2; ++n) acc[a][b][m][n] = (f32x4){0.f, 0.f, 0.f, 0.f};
        cur = nxt; cA = nA; cB = nB; ++ui;
        if constexpr (ALIGN_EPI) { if (wr == 1) PG8_BAR; }
    }
    PG8_WAIT_V(0);
    if constexpr (!ALIGN_EPI) { if (wr == 0) PG8_BAR; }
    PG8_BAR;
#undef PG8_SA
#undef PG8_SB
#undef PG8_STAGE
#undef PG8_LDA
#undef PG8_LDB
#undef PG8_MMA
#undef PG8_WAIT_V
#undef PG8_WAIT_L
#undef PG8_BAR
#undef PG8_SCHED
}
}
using pg8::Unit;

struct Epi1 {
    static constexpr bool PERM = true; static constexpr int MID_T = -1;
    bf16_t *CQ, *CKV, *KR, *NA; float *SSQ, *SSKV; const float *COS, *SIN;
    __device__ __forceinline__ void mid(f32x4 (&)[2][2][4][2], const Unit&, int, int, int, int) const {}
    __device__ __forceinline__ void operator()(const f32x4 (&acc)[2][2][4][2], const Unit& u, int wr, int wc, int fr, int fq_in) const {
        int row0 = u.pm * 256 + wr * 64 + fr, fq = fq_in; asm volatile("" : "+v"(row0), "+v"(fq));
#pragma unroll
        for (int bj = 0; bj < 2; ++bj) {
            const int gc = u.pn * 256 + bj * 128 + wc * 32;
            if (gc < 640) {
                const bool isq = gc < QL;
                bf16_t* base = isq ? CQ : CKV; const int ld = isq ? QL : KVL, col = isq ? gc : gc - QL; float* ss = isq ? SSQ : SSKV; const int nslot = isq ? 12 : 8, slot = col >> 5;
#pragma unroll
                for (int ai = 0; ai < 2; ++ai)
#pragma unroll
                    for (int m = 0; m < 4; ++m) { const int row = row0 + ai * 128 + m * 16; const f32x4 v0 = acc[ai][bj][m][0], v1 = acc[ai][bj][m][1];
                        float s = dot4(v0) + dot4(v1); s += __shfl_xor(s, 16); s += __shfl_xor(s, 32);
                        if (fq == 0) ss[(size_t)row * nslot + slot] = s;
                        *(u32x4*)(base + (size_t)row * ld + col + 8 * fq) = pack8(v0, v1); }
            } else if (gc < 672) {
#pragma unroll
                for (int ai = 0; ai < 2; ++ai)
#pragma unroll
                    for (int m = 0; m < 4; ++m) { const int row = row0 + ai * 128 + m * 16; const int pos = seq_pos(row);
                        const f32x4 c4 = *(const f32x4*)(COS + pos * 16 + 4 * fq), s4 = *(const f32x4*)(SIN + pos * 16 + 4 * fq);
                        const f32x4 x1 = acc[ai][bj][m][0], x2 = acc[ai][bj][m][1]; const f32x4 o1 = x1 * c4 - x2 * s4, o2 = x1 * s4 + x2 * c4;
                        u32x2 w1, w2; w1.x = pk2(o1[0], o1[1]); w1.y = pk2(o1[2], o1[3]); w2.x = pk2(o2[0], o2[1]); w2.y = pk2(o2[2], o2[3]);
                        *(u32x2*)(KR + (size_t)row * 32 + 4 * fq) = w1; *(u32x2*)(KR + (size_t)row * 32 + 16 + 4 * fq) = w2; }
            } else if (gc >= 768) {
                const int col = gc - 768; const float sc = col < 512 ? QSC_NA : 1.0f;
#pragma unroll
                for (int ai = 0; ai < 2; ++ai)
#pragma unroll
                    for (int m = 0; m < 4; ++m) { const int row = row0 + ai * 128 + m * 16;
                        *(u32x4*)(NA + (size_t)row * 1536 + col + 8 * fq) = pack8(acc[ai][bj][m][0] * sc, acc[ai][bj][m][1] * sc); }
            }
        }
    }
};
struct Epi2 {
    static constexpr bool PERM = true; static constexpr int MID_T = -1;
    bf16_t* Q; const float *SSQ, *COS, *SIN;
    __device__ __forceinline__ void mid(f32x4 (&)[2][2][4][2], const Unit&, int, int, int, int) const {}
    __device__ __forceinline__ void operator()(const f32x4 (&acc)[2][2][4][2], const Unit& u, int wr, int wc, int fr, int fq_in) const {
        int row0 = u.pm * 256 + wr * 64 + fr, fq = fq_in; asm volatile("" : "+v"(row0), "+v"(fq));
#pragma unroll
        for (int ai = 0; ai < 2; ++ai)
#pragma unroll
            for (int m = 0; m < 4; ++m) { const int row = row0 + ai * 128 + m * 16; const float* p = SSQ + (size_t)row * 12;
                const f32x4 a = *(const f32x4*)p, b = *(const f32x4*)(p + 4), c = *(const f32x4*)(p + 8);
                const float r = __builtin_amdgcn_rsqf((sum4(a) + sum4(b) + sum4(c)) * (1.0f / QL) + EPS) * QSC_MLA;
#pragma unroll
                for (int bj = 0; bj < 2; ++bj) {
                    const int gc = u.pn * 256 + bj * 128 + wc * 32, G = gc >> 5, h = G / 3, part = G - 3 * h;
                    if (part < 2) {
                        *(u32x4*)(Q + (size_t)row * 768 + h * 96 + part * 32 + 8 * fq) = pack8(acc[ai][bj][m][0] * r, acc[ai][bj][m][1] * r);
                    } else { const int pos = seq_pos(row);
                        const f32x4 c4 = *(const f32x4*)(COS + pos * 16 + 4 * fq), s4 = *(const f32x4*)(SIN + pos * 16 + 4 * fq);
                        const f32x4 x1 = acc[ai][bj][m][0] * r, x2 = acc[ai][bj][m][1] * r; const f32x4 o1 = x1 * c4 - x2 * s4, o2 = x1 * s4 + x2 * c4;
                        u32x2 w1, w2; w1.x = pk2(o1[0], o1[1]); w1.y = pk2(o1[2], o1[3]); w2.x = pk2(o2[0], o2[1]); w2.y = pk2(o2[2], o2[3]);
                        bf16_t* qp = Q + (size_t)row * 768 + h * 96 + 64 + 4 * fq; *(u32x2*)qp = w1; *(u32x2*)(qp + 16) = w2; }
                }
                asm volatile("" ::: "memory"); }
    }
};
struct Epi3 {
    static constexpr bool PERM = true; static constexpr int MID_T = -1;
    bf16_t *KN, *V; const float* SSKV;
    __device__ __forceinline__ void mid(f32x4 (&)[2][2][4][2], const Unit&, int, int, int, int) const {}
    __device__ __forceinline__ void operator()(const f32x4 (&acc)[2][2][4][2], const Unit& u, int wr, int wc, int fr, int fq_in) const {
        int row0 = u.pm * 256 + wr * 64 + fr, fq = fq_in; asm volatile("" : "+v"(row0), "+v"(fq));
        float rs[2][4];
#pragma unroll
        for (int ai = 0; ai < 2; ++ai)
#pragma unroll
            for (int m = 0; m < 4; ++m) { const float* p = SSKV + (size_t)(row0 + ai * 128 + m * 16) * 8;
                const f32x4 a = *(const f32x4*)p, b = *(const f32x4*)(p + 4);
                rs[ai][m] = __builtin_amdgcn_rsqf((sum4(a) + sum4(b)) * (1.0f / KVL) + EPS); }
#pragma unroll
        for (int bj = 0; bj < 2; ++bj) {
            const int gc = u.pn * 256 + bj * 128 + wc * 32, h = gc >> 7, w = gc & 127;
            bf16_t* base = (w < 64) ? KN + h * 64 + w : V + h * 64 + (w - 64);
#pragma unroll
            for (int ai = 0; ai < 2; ++ai)
#pragma unroll
                for (int m = 0; m < 4; ++m) { const int row = row0 + ai * 128 + m * 16; const float r = rs[ai][m];
                    *(u32x4*)(base + (size_t)row * 512 + 8 * fq) = pack8(acc[ai][bj][m][0] * r, acc[ai][bj][m][1] * r); }
        }
    }
};
struct Epi4 {
    static constexpr bool PERM = true; static constexpr int MID_T = 8;
    const float *xp, *xs; bf16_t* X1; const float *SSA, *SSB; float* SS1;
    __device__ __forceinline__ float rstd8(const float* p) const { const f32x4 a = *(const f32x4*)p, b = *(const f32x4*)(p + 4); return __builtin_amdgcn_rsqf((sum4(a) + sum4(b)) * (1.0f / 512.0f) + EPS); }
    __device__ __forceinline__ void mid(f32x4 (&acc)[2][2][4][2], const Unit& u, int wr, int wc, int fr, int fq_in) const {
        int row0 = u.pm * 256 + wr * 64 + fr, fq = fq_in; asm volatile("" : "+v"(row0), "+v"(fq));
#pragma unroll
        for (int ai = 0; ai < 2; ++ai)
#pragma unroll
            for (int m = 0; m < 4; ++m) { const size_t row = (size_t)(row0 + ai * 128 + m * 16);
                const float ra = rstd8(SSA + row * 8), rb = rstd8(SSB + row * 8); const float f = ra / rb;
#pragma unroll
                for (int bj = 0; bj < 2; ++bj)
#pragma unroll
                    for (int n = 0; n < 2; ++n) acc[ai][bj][m][n] = acc[ai][bj][m][n] * f;
                asm volatile("" ::: "memory"); }
    }
    __device__ __forceinline__ void operator()(const f32x4 (&acc)[2][2][4][2], const Unit& u, int wr, int wc, int fr, int fq_in) const {
        int row0 = u.pm * 256 + wr * 64 + fr, fq = fq_in; asm volatile("" : "+v"(row0), "+v"(fq)); const int colw = u.pn * 256 + wc * 32 + 8 * fq;
#pragma unroll
        for (int ai = 0; ai < 2; ++ai)
#pragma unroll
            for (int m = 0; m < 4; ++m) { const int row = row0 + ai * 128 + m * 16; const float rb = rstd8(SSB + (size_t)row * 8);
                const float* xr = (row < TOKP ? xp + (size_t)row * DM : xs + (size_t)(row - TOKP) * DM) + colw;
                float s = 0.f;
#pragma unroll
                for (int bj = 0; bj < 2; ++bj) { const f32x4 a0 = *(const f32x4*)(xr + bj * 128), a1 = *(const f32x4*)(xr + bj * 128 + 4);
                    const f32x4 v0 = a0 + acc[ai][bj][m][0] * rb, v1 = a1 + acc[ai][bj][m][1] * rb; s += dot4(v0) + dot4(v1);
                    *(u32x4*)(X1 + (size_t)row * DM + colw + bj * 128) = pack8(v0, v1); }
                s += __shfl_xor(s, 16); s += __shfl_xor(s, 32);
                if (fq == 0) SS1[(size_t)row * 16 + u.pn * 4 + wc] = s;
                asm volatile("" ::: "memory"); }
    }
};
__device__ __forceinline__ float rstd16(const float* p) { const f32x4 a = *(const f32x4*)p, b = *(const f32x4*)(p + 4), c = *(const f32x4*)(p + 8), d = *(const f32x4*)(p + 12);
    return __builtin_amdgcn_rsqf(((sum4(a) + sum4(b)) + (sum4(c) + sum4(d))) * (1.0f / DM) + EPS); }
struct Epi5 {
    static constexpr bool PERM = true; static constexpr int MID_T = -1;
    bf16_t* ACT; const float* SS1;
    __device__ __forceinline__ void mid(f32x4 (&)[2][2][4][2], const Unit&, int, int, int, int) const {}
    __device__ __forceinline__ void operator()(const f32x4 (&acc)[2][2][4][2], const Unit& u, int wr, int wc, int fr, int fq_in) const {
        int row0 = u.pm * 256 + wr * 64 + fr, fq = fq_in; asm volatile("" : "+v"(row0), "+v"(fq)); const int col = u.pn * 128 + wc * 32 + 8 * fq;
#pragma unroll
        for (int ai = 0; ai < 2; ++ai)
#pragma unroll
            for (int m = 0; m < 4; ++m) { const int row = row0 + ai * 128 + m * 16; const float r = rstd16(SS1 + (size_t)row * 16);
                f32x4 o[2];
#pragma unroll
                for (int n = 0; n < 2; ++n) { const f32x4 gt = acc[ai][0][m][n] * r, up = acc[ai][1][m][n] * r;
#pragma unroll
                    for (int i = 0; i < 4; ++i) o[n][i] = gt[i] * __builtin_amdgcn_rcpf(1.0f + __builtin_amdgcn_exp2f(-gt[i] * LOG2E)) * up[i]; }
                *(u32x4*)(ACT + (size_t)row * DFF + col) = pack8(o[0], o[1]); }
    }
};
struct Epi6 {
    static constexpr bool PERM = false; static constexpr int MID_T = -1;
    const bf16_t* X1; float* out; float* SS2;
    __device__ __forceinline__ void mid(f32x4 (&)[2][2][4][2], const Unit&, int, int, int, int) const {}
    __device__ __forceinline__ void operator()(const f32x4 (&acc)[2][2][4][2], const Unit& u, int wr, int wc, int fr, int fq_in) const {
        int row0 = u.pm * 256 + wr * 64 + fr, fq = fq_in; asm volatile("" : "+v"(row0), "+v"(fq)); const int colw = u.pn * 256 + wc * 32 + 4 * fq;
#pragma unroll
        for (int ai = 0; ai < 2; ++ai)
#pragma unroll
            for (int m = 0; m < 4; ++m) { const int row = row0 + ai * 128 + m * 16; float s = 0.f;
#pragma unroll
                for (int bj = 0; bj < 2; ++bj)
#pragma unroll
                    for (int n = 0; n < 2; ++n) { const size_t off = (size_t)row * DM + colw + bj * 128 + n * 16; const u32x2 w = *(const u32x2*)(X1 + off);
                        f32x4 v = acc[ai][bj][m][n]; v[0] += bflo(w.x); v[1] += bfhi(w.x); v[2] += bflo(w.y); v[3] += bfhi(w.y); s += dot4(v);
                        *(f32x4*)(out + off) = v; }
                s += __shfl_xor(s, 16); s += __shfl_xor(s, 32);
                if (fq == 0) SS2[(size_t)row * 16 + u.pn * 4 + wc] = s; }
    }
};

namespace att {
constexpr int KSLOT = 12288, VSLOT = 8192;
constexpr int L_K = 0, L_V = 2 * KSLOT, L_WS = L_V + 2 * VSLOT, L_OST = L_WS + 8 * 256, L_BIAS = L_OST + 8 * 4096, L_END = L_BIAS + 2560;
static_assert(L_END <= RING_BYTES, "attention LDS");
constexpr int THRL = 8;
constexpr int NA_K = 0, NA_V = 32768;
#define MFMA32(a, b, c) __builtin_amdgcn_mfma_f32_32x32x16_bf16(a, b, c, 0, 0, 0)
__device__ __forceinline__ int crow(int r, int hi) { return (r & 3) + 8 * (r >> 2) + 4 * hi; }
__device__ __forceinline__ s16x4 vtr(const LAS unsigned char* p) { return __builtin_bit_cast(s16x4, __builtin_amdgcn_ds_read_tr16_b64_v4i16((LAS v4i16_t*)p)); }
__device__ __forceinline__ void glds(const void* g, LAS unsigned char* dst) { __builtin_amdgcn_global_load_lds((const unsigned*)g, (LAS unsigned*)dst, 16, 0, 0); }

struct SoftSt { float mhat, l; f32x16 o[2]; f32x16 negm; };

template <int ND, bool NA>
__device__ __forceinline__ void tile_step(SoftSt& st, const bf16x8 (&qr)[ND], const LAS unsigned char* kb, const LAS unsigned char* vp, LAS float* wsf, int r32, int hi, bool first,
                                          const LAS float* brow, int cs) {
    f32x16 C0, C1;
#pragma unroll
    for (int d0 = 0; d0 < ND; ++d0) {
        const bf16x8 b0 = *(const LAS bf16x8*)(kb + d0 * 2048), b1 = *(const LAS bf16x8*)(kb + d0 * 2048 + 512);
        if (d0 == 0) { C0 = MFMA32(b0, qr[0], st.negm); C1 = MFMA32(b1, qr[0], st.negm); } else { C0 = MFMA32(b0, qr[d0], C0); C1 = MFMA32(b1, qr[d0], C1); }
    }
    if (NA) {
#pragma unroll
        for (int r = 0; r < 16; ++r) { const int kc = (r & 3) + 8 * (r >> 2) + 4 * hi;
            C0[r] = ((unsigned)(kc - cs) < 16u) ? C0[r] + brow[kc] : -INFINITY;
            C1[r] = ((unsigned)(kc + 32 - cs) < 16u) ? C1[r] + brow[kc + 32] : -INFINITY; }
    }
#define MX3(a, b, c) __builtin_fmaxf(__builtin_fmaxf((a), (b)), (c))
    float a = MX3(C0[0], C0[1], C1[0]), b = MX3(C0[2], C0[3], C1[1]); a = MX3(a, C1[2], C1[3]);
#pragma unroll
    for (int r = 4; r < 16; r += 4) { a = MX3(a, C0[r], C0[r + 1]); b = MX3(b, C0[r + 2], C0[r + 3]); a = MX3(a, C1[r], C1[r + 1]); b = MX3(b, C1[r + 2], C1[r + 3]); }
#undef MX3
    float rm = __builtin_fmaxf(a, b);
    { auto rr = __builtin_amdgcn_permlane32_swap(__float_as_uint(rm), __float_as_uint(rm), false, false); rm = __builtin_fmaxf(__uint_as_float(rr[0]), __uint_as_float(rr[1])); }
    bool resc = false;
    if (first || __any(rm > (float)THRL)) {
        const float dl = first ? rm : __builtin_fmaxf(rm, 0.f); st.mhat += dl;
#pragma unroll
        for (int r = 0; r < 16; ++r) { C0[r] -= dl; C1[r] -= dl; st.negm[r] = -st.mhat; }
        const float f = first ? 0.f : __builtin_amdgcn_exp2f(-dl); st.l *= f; if (hi == 0) wsf[r32] = f; resc = true;
    }
    float sacc = 0.f;
#pragma unroll
    for (int r = 0; r < 16; ++r) { C0[r] = __builtin_amdgcn_exp2f(C0[r]); C1[r] = __builtin_amdgcn_exp2f(C1[r]); sacc += C0[r] + C1[r]; }
    st.l += sacc;
    u32x4 pw0, pw1, pw2, pw3;
    pw0 = (u32x4){pk2(C0[0], C0[1]), pk2(C0[2], C0[3]), pk2(C0[4], C0[5]), pk2(C0[6], C0[7])}; pw1 = (u32x4){pk2(C0[8], C0[9]), pk2(C0[10], C0[11]), pk2(C0[12], C0[13]), pk2(C0[14], C0[15])};
    pw2 = (u32x4){pk2(C1[0], C1[1]), pk2(C1[2], C1[3]), pk2(C1[4], C1[5]), pk2(C1[6], C1[7])}; pw3 = (u32x4){pk2(C1[8], C1[9]), pk2(C1[10], C1[11]), pk2(C1[12], C1[13]), pk2(C1[14], C1[15])};
    if (resc) {
#pragma unroll
        for (int r = 0; r < 16; ++r) { const float f = wsf[crow(r, hi)]; st.o[0][r] *= f; st.o[1][r] *= f; }
    }
#pragma unroll
    for (int d0 = 0; d0 < 2; ++d0) {
#pragma unroll
        for (int ks = 0; ks < 4; ++ks) { const s16x4 lo = vtr(vp + d0 * 4096 + ks * 1024), hh = vtr(vp + d0 * 4096 + ks * 1024 + 512);
            const bf16x8 vb = (bf16x8){lo[0], lo[1], lo[2], lo[3], hh[0], hh[1], hh[2], hh[3]};
            const bf16x8 pa = __builtin_bit_cast(bf16x8, ks == 0 ? pw0 : ks == 1 ? pw1 : ks == 2 ? pw2 : pw3);
            st.o[d0] = MFMA32(pa, vb, st.o[d0]); }
    }
}
__device__ __forceinline__ void attn_epilogue(SoftSt& st, LAS unsigned char* lds, int wid, int lane, int r32, int hi, bf16_t* Orow0  , float* SSrow0  ) {
    LAS float* wsf = (LAS float*)(lds + L_WS) + wid * 64;
    { auto rr = __builtin_amdgcn_permlane32_swap(__float_as_uint(st.l), __float_as_uint(st.l), false, false); st.l = __uint_as_float(rr[0]) + __uint_as_float(rr[1]); }
    if (hi == 0) wsf[32 + r32] = st.l;
    LAS bf16_t* stg = (LAS bf16_t*)(lds + L_OST) + wid * 2048;
#pragma unroll
    for (int r = 0; r < 16; ++r) { const int orow = crow(r, hi); const float rl = __builtin_amdgcn_rcpf(wsf[32 + orow]);
        const unsigned w0 = pk2(st.o[0][r] * rl, 0.f), w1 = pk2(st.o[1][r] * rl, 0.f);
        stg[orow * 64 + r32] = (bf16_t)(w0 & 0xffffu); stg[orow * 64 + 32 + r32] = (bf16_t)(w1 & 0xffffu); }
#pragma unroll
    for (int i = 0; i < 4; ++i) { const int row = i * 8 + (lane >> 3), ch = lane & 7; const u32x4 v = *(const LAS u32x4*)(stg + row * 64 + ch * 8);
        float s = 0.f;
#pragma unroll
        for (int j = 0; j < 4; ++j) { const float x = bflo(v[j]), y = bfhi(v[j]); s += x * x + y * y; }
        s += __shfl_xor(s, 1); s += __shfl_xor(s, 2); s += __shfl_xor(s, 4);
        if (ch == 0) SSrow0[(size_t)row * 8] = s;
        *(u32x4*)(Orow0 + (size_t)row * DM + ch * 8) = v; }
}

__device__ __forceinline__ void mla_unit(LAS unsigned char* lds, int rowbase, int S, int h, int q0, const bf16_t* Q, const bf16_t* KN, const bf16_t* KR, const bf16_t* V, bf16_t* AB, float* SSA) {
    const int tid = threadIdx.x, lane = tid & 63, r32 = lane & 31, hi = lane >> 5; const int wid = __builtin_amdgcn_readfirstlane(tid >> 6);
    const bf16_t* ksrc = KN + (size_t)(rowbase + lane) * 512 + h * 64 + wid * 8;
    const bf16_t* rsrc = KR + (size_t)(rowbase + lane) * 32 + (wid & 3) * 8;
    const bf16_t* vsrc = V + (size_t)(rowbase + 16 * (wid & 3) + (lane >> 2)) * 512 + h * 64 + (wid >> 2) * 32 + (lane & 3) * 8;
#define MLA_STAGE(t, s) do { glds(ksrc + (size_t)(t) * 64 * 512, lds + L_K + (s) * KSLOT + wid * 1024); \
        if (wid < 4) glds(rsrc + (size_t)(t) * 64 * 32, lds + L_K + (s) * KSLOT + (8 + wid) * 1024); \
        glds(vsrc + (size_t)(t) * 64 * 512, lds + L_V + (s) * VSLOT + wid * 1024); } while (0)
    const int NT = S / 64;
    MLA_STAGE(0, 0);
    const int qrow = rowbase + q0 + wid * 32;
    bf16x8 qr[6];
#pragma unroll
    for (int d0 = 0; d0 < 6; ++d0) qr[d0] = *(const bf16x8*)(Q + (size_t)(qrow + r32) * 768 + h * 96 + d0 * 16 + hi * 8);
    SoftSt st; st.mhat = 0.f; st.l = 0.f; st.o[0] = f32x16{}; st.o[1] = f32x16{}; st.negm = f32x16{};
    LAS float* wsf = (LAS float*)(lds + L_WS) + wid * 64;
    const int kboff = hi * 1024 + r32 * 16, vpoff = ((lane >> 4) & 1) * 32 + (lane & 3) * 8 + (4 * hi + ((lane & 15) >> 2)) * 64;
    asm volatile("s_waitcnt vmcnt(0)" ::: "memory"); __syncthreads();
    for (int t = 0; t < NT; ++t) {
        const int s = t & 1;
        if (t + 1 < NT) MLA_STAGE(t + 1, s ^ 1);
        tile_step<6, false>(st, qr, lds + L_K + s * KSLOT + kboff, lds + L_V + s * VSLOT + vpoff, wsf, r32, hi, t == 0, nullptr, 0);
        asm volatile("s_waitcnt vmcnt(0)" ::: "memory"); __syncthreads();
    }
#undef MLA_STAGE
    attn_epilogue(st, lds, wid, lane, r32, hi, AB + (size_t)qrow * DM + h * 64, SSA + (size_t)qrow * 8 + h);
}

__device__ __forceinline__ void na_unit(LAS unsigned char* lds, int rowbase, int rows, int h, int R0, const bf16_t* NAB, const float* rpb, bf16_t* AB, float* SSB) {
    const int tid = threadIdx.x, lane = tid & 63, r32 = lane & 31, hi = lane >> 5; const int wid = __builtin_amdgcn_readfirstlane(tid >> 6);
    LAS float* tab = (LAS float*)(lds + L_BIAS);
    for (int i = tid; i < 640; i += 512) { const int j = i - 48; tab[i] = (j >= 0 && j < 465) ? rpb[h * 465 + j] * LOG2E : 0.f; }
    const int r = R0 + (wid >> 1), qh = wid & 1;
    const int start_w = min(max(r - 4, 0), rows - 8);
    const int u_lo = min(max(R0 - 4, 0), rows - 8), u_hi = min(max(R0 - 1, 0), rows - 8) + 8;
    const bf16_t* ksrc = NAB + (size_t)(rowbase + lane) * 1536 + 512 + h * 64 + wid * 8;
    const bf16_t* vsrc = NAB + (size_t)(rowbase + 16 * (wid & 3) + (lane >> 2)) * 1536 + 1024 + h * 64 + (wid >> 2) * 32 + (lane & 3) * 8;
#define NA_STAGE(u, s) do { glds(ksrc + (size_t)(u) * 64 * 1536, lds + L_K + (s) * KSLOT + wid * 1024); glds(vsrc + (size_t)(u) * 64 * 1536, lds + L_V + (s) * VSLOT + wid * 1024); } while (0)
    NA_STAGE(u_lo, 0);
    const int qrow = rowbase + r * 64 + qh * 32;
    bf16x8 qr[4];
#pragma unroll
    for (int d0 = 0; d0 < 4; ++d0) qr[d0] = *(const bf16x8*)(NAB + (size_t)(qrow + r32) * 1536 + h * 64 + d0 * 16 + hi * 8);
    SoftSt st; st.mhat = 0.f; st.l = 0.f; st.o[0] = f32x16{}; st.o[1] = f32x16{}; st.negm = f32x16{};
    LAS float* wsf = (LAS float*)(lds + L_WS) + wid * 64;
    const int kboff = hi * 1024 + r32 * 16, vpoff = ((lane >> 4) & 1) * 32 + (lane & 3) * 8 + (4 * hi + ((lane & 15) >> 2)) * 64;
    const int qc = qh * 32 + r32, cs = min(max(qc - 8, 0), 48);
    asm volatile("s_waitcnt vmcnt(0)" ::: "memory"); __syncthreads();
    const int NT = u_hi - u_lo;
    for (int i = 0; i < NT; ++i) {
        const int s = i & 1, u = u_lo + i;
        if (i + 1 < NT) NA_STAGE(u + 1, s ^ 1);
        if (u >= start_w && u < start_w + 8)
            tile_step<4, true>(st, qr, lds + L_K + s * KSLOT + kboff, lds + L_V + s * VSLOT + vpoff, wsf, r32, hi, u == start_w, tab + 48 + (u - r + 7) * 31 + 15 - qc, cs);
        asm volatile("s_waitcnt vmcnt(0)" ::: "memory"); __syncthreads();
    }
#undef NA_STAGE
    attn_epilogue(st, lds, wid, lane, r32, hi, AB + (size_t)qrow * DM + 512 + h * 64, SSB + (size_t)qrow * 8 + h);
}
__device__ __forceinline__ void na_unit2(LAS unsigned char* lds, int rowbase, int rows, int h, int R0, const bf16_t* NAB, const float* rpb, bf16_t* AB, float* SSB) {
    const int tid = threadIdx.x, lane = tid & 63, q16 = lane & 15, quad = lane >> 4; const int wid = __builtin_amdgcn_readfirstlane(tid >> 6);
    LAS float* tab = (LAS float*)(lds + L_BIAS);
    for (int i = tid; i < 640; i += 512) { const int j = i - 48; tab[i] = (j >= 0 && j < 465) ? rpb[h * 465 + j] * LOG2E : 0.f; }
    const int r = R0 + (wid >> 1), qh = wid & 1;
    const int start_w = min(max(r - 4, 0), rows - 8);
    const int u_lo = min(max(R0 - 4, 0), rows - 8), u_hi = min(max(R0 - 1, 0), rows - 8) + 8;
    const bf16_t* ksrc = NAB + (size_t)(rowbase + lane) * 1536 + 512 + h * 64 + wid * 8;
    const bf16_t* vsrc = NAB + (size_t)(rowbase + 16 * (wid & 3) + (lane >> 2)) * 1536 + 1024 + h * 64 + (wid >> 2) * 32 + (lane & 3) * 8;
#define NA_STAGE(u, s) do { glds(ksrc + (size_t)(u) * 64 * 1536, lds + NA_K + (s) * 8192 + wid * 1024); glds(vsrc + (size_t)(u) * 64 * 1536, lds + NA_V + (s) * 8192 + wid * 1024); } while (0)
    const int NT = u_hi - u_lo;
    NA_STAGE(u_lo, 0); NA_STAGE(u_lo + 1, 1); NA_STAGE(u_lo + 2, 2);
    const int qrow = rowbase + r * 64 + qh * 32;
    bf16x8 qf[2][2];
#pragma unroll
    for (int jb = 0; jb < 2; ++jb)
#pragma unroll
        for (int ks = 0; ks < 2; ++ks) qf[jb][ks] = *(const bf16x8*)(NAB + (size_t)(qrow + 16 * jb + q16) * 1536 + h * 64 + 32 * ks + 8 * quad);
    float mhat[2] = {0.f, 0.f}, lsum[2] = {0.f, 0.f}; f32x4 o[2][4];
#pragma unroll
    for (int jb = 0; jb < 2; ++jb)
#pragma unroll
        for (int db = 0; db < 4; ++db) o[jb][db] = (f32x4){0.f, 0.f, 0.f, 0.f};
    int koff[2], cs[2], kaddr[2], vaddr[2], boff[2];
#pragma unroll
    for (int jb = 0; jb < 2; ++jb) { const int jq = 2 * qh + jb, qc = 16 * jq + q16; koff[jb] = jq == 0 ? 0 : jq == 1 ? 8 : jq == 2 ? 24 : 32; cs[jb] = min(max(qc - 8, 0), 48);
        kaddr[jb] = quad * 1024 + (koff[jb] + q16) * 16;
        const int vr = koff[jb] + 4 * quad + (q16 >> 2); vaddr[jb] = (vr >> 4) * 1024 + (vr & 15) * 64 + (lane & 3) * 8;
        boff[jb] = 48 + 15 - qc + koff[jb] + 4 * quad; }
    asm volatile("s_waitcnt vmcnt(4)" ::: "memory"); __syncthreads();
    for (int it = 0; it < NT; ++it) {
        const int s = it & 3, u = u_lo + it;
        if (it + 3 < NT) NA_STAGE(u + 3, (it + 3) & 3);
        if (u >= start_w && u < start_w + 8) {
            const bool first = (u == start_w);
            f32x4 C[2][2]; float rm[2];
#pragma unroll
            for (int jb = 0; jb < 2; ++jb) {
                const LAS unsigned char* kp = lds + NA_K + s * 8192 + kaddr[jb];
                const float nm = -mhat[jb]; C[jb][0] = (f32x4){nm, nm, nm, nm}; C[jb][1] = C[jb][0];
#pragma unroll
                for (int ks = 0; ks < 2; ++ks)
#pragma unroll
                    for (int kb = 0; kb < 2; ++kb) C[jb][kb] = __builtin_amdgcn_mfma_f32_16x16x32_bf16(*(const LAS bf16x8*)(kp + ks * 4096 + kb * 256), qf[jb][ks], C[jb][kb], 0, 0, 0);
            }
#pragma unroll
            for (int jb = 0; jb < 2; ++jb) {
                const LAS float* brow = tab + boff[jb] + (u - r + 7) * 31; const int kc0 = koff[jb] + 4 * quad - cs[jb];
#pragma unroll
                for (int kb = 0; kb < 2; ++kb)
#pragma unroll
                    for (int i = 0; i < 4; ++i) C[jb][kb][i] = ((unsigned)(kc0 + 16 * kb + i) < 16u) ? C[jb][kb][i] + brow[16 * kb + i] : -INFINITY;
                float m = __builtin_fmaxf(__builtin_fmaxf(__builtin_fmaxf(C[jb][0][0], C[jb][0][1]), __builtin_fmaxf(C[jb][0][2], C[jb][0][3])), __builtin_fmaxf(__builtin_fmaxf(C[jb][1][0], C[jb][1][1]), __builtin_fmaxf(C[jb][1][2], C[jb][1][3])));
                { auto rr = __builtin_amdgcn_permlane16_swap(__float_as_uint(m), __float_as_uint(m), false, false); m = __builtin_fmaxf(__uint_as_float(rr[0]), __uint_as_float(rr[1])); }
                { auto rr = __builtin_amdgcn_permlane32_swap(__float_as_uint(m), __float_as_uint(m), false, false); m = __builtin_fmaxf(__uint_as_float(rr[0]), __uint_as_float(rr[1])); }
                rm[jb] = m;
            }
            if (first || __any(__builtin_fmaxf(rm[0], rm[1]) > (float)THRL)) {
#pragma unroll
                for (int jb = 0; jb < 2; ++jb) {
                    const float dl = first ? rm[jb] : __builtin_fmaxf(rm[jb], 0.f); mhat[jb] += dl; C[jb][0] = C[jb][0] - dl; C[jb][1] = C[jb][1] - dl;
                    const float f = first ? 0.f : __builtin_amdgcn_exp2f(-dl); lsum[jb] *= f;
#pragma unroll
                    for (int db = 0; db < 4; ++db) o[jb][db] = o[jb][db] * f;
                }
            }
#pragma unroll
            for (int jb = 0; jb < 2; ++jb) {
                const LAS unsigned char* vp = lds + NA_V + s * 8192 + vaddr[jb];
                float sacc = 0.f;
#pragma unroll
                for (int kb = 0; kb < 2; ++kb)
#pragma unroll
                    for (int i = 0; i < 4; ++i) { C[jb][kb][i] = __builtin_amdgcn_exp2f(C[jb][kb][i]); sacc += C[jb][kb][i]; }
                lsum[jb] += sacc;
                const u32x4 pw = (u32x4){pk2(C[jb][0][0], C[jb][0][1]), pk2(C[jb][0][2], C[jb][0][3]), pk2(C[jb][1][0], C[jb][1][1]), pk2(C[jb][1][2], C[jb][1][3])};
                const bf16x8 pf = __builtin_bit_cast(bf16x8, pw);
#pragma unroll
                for (int db = 0; db < 4; ++db) { const int dbo = (db >> 1) * 4096 + (db & 1) * 32; const s16x4 lo = vtr(vp + dbo), hh = vtr(vp + dbo + 1024);
                    const bf16x8 vf = (bf16x8){lo[0], lo[1], lo[2], lo[3], hh[0], hh[1], hh[2], hh[3]};
                    o[jb][db] = __builtin_amdgcn_mfma_f32_16x16x32_bf16(vf, pf, o[jb][db], 0, 0, 0); }
            }
        }
        { const int ahead = min(it + 3, NT - 1) - (it + 1);
          if (ahead >= 2) asm volatile("s_waitcnt vmcnt(4) lgkmcnt(0)" ::: "memory"); else if (ahead == 1) asm volatile("s_waitcnt vmcnt(2) lgkmcnt(0)" ::: "memory"); else asm volatile("s_waitcnt vmcnt(0) lgkmcnt(0)" ::: "memory");
          __builtin_amdgcn_s_barrier(); asm volatile("" ::: "memory"); }
    }
#undef NA_STAGE
#pragma unroll
    for (int jb = 0; jb < 2; ++jb) {
        float l = lsum[jb];
        { auto rr = __builtin_amdgcn_permlane16_swap(__float_as_uint(l), __float_as_uint(l), false, false); l = __uint_as_float(rr[0]) + __uint_as_float(rr[1]); }
        { auto rr = __builtin_amdgcn_permlane32_swap(__float_as_uint(l), __float_as_uint(l), false, false); l = __uint_as_float(rr[0]) + __uint_as_float(rr[1]); }
        const float inv = __builtin_amdgcn_rcpf(l); float ss = 0.f; const size_t tok = (size_t)(qrow + 16 * jb + q16);
        bf16_t* op = AB + tok * DM + 512 + h * 64 + 4 * quad;
#pragma unroll
        for (int db = 0; db < 4; ++db) { const f32x4 v = o[jb][db] * inv; ss += dot4(v); u32x2 w; w.x = pk2(v[0], v[1]); w.y = pk2(v[2], v[3]); *(u32x2*)(op + 16 * db) = w; }
        ss += __shfl_xor(ss, 16); ss += __shfl_xor(ss, 32);
        if (quad == 0) SSB[tok * 8 + h] = ss;
    }
}
}

__device__ __forceinline__ float wave_sum(float v) {
#pragma unroll
    for (int o = 1; o < 64; o <<= 1) v += __shfl_xor(v, o);
    return v;
}
__device__ __forceinline__ int ropeperm(int p) { return 16 * ((p >> 2) & 1) + 4 * (p >> 3) + (p & 3); }
struct MapIn  { __device__ int operator()(int n) const { if (n < 640) return n; if (n < 672) return 640 + ropeperm(n - 640); if (n < 768) return -1; return n - 96; } };
struct MapUq  { __device__ int operator()(int n) const { const int h = n / 96, w = n - 96 * h; return w < 64 ? n : 96 * h + 64 + ropeperm(w - 64); } };
struct MapId  { __device__ int operator()(int n) const { return n; } };
struct MapGU  { __device__ int operator()(int n) const { const int pn = n >> 8, w = n & 255; return w < 128 ? 128 * pn + w : DFF + 128 * pn + (w - 128); } };
template <class Map>
__device__ __forceinline__ void wt_item(const float* W, const float* W2, int K, int N, bf16_t* WT, const float* g0, const float* g1, int ksplit, LAS float* scr, int item, int nblk, int lane, Map map) {
    const int kb = item / nblk, nb = item % nblk, k0 = 64 * kb, n0 = 32 * nb;
    int src = map(n0 + (lane & 31)); const float* Wsrc = W; if (W2 && src >= N) { Wsrc = W2; src -= N; }
#pragma unroll 8
    for (int i = 0; i < 32; ++i) { const int kk = 2 * i + (lane >> 5), k = k0 + kk; float v = src >= 0 ? Wsrc[(size_t)k * N + src] : 0.f;
        if (g0) v *= (k < ksplit ? g0[k] : g1[k - ksplit]);
        scr[kk * 33 + (lane & 31)] = v; }
    asm volatile("s_waitcnt lgkmcnt(0)" ::: "memory");
    const int c = lane & 7;
#pragma unroll
    for (int j = 0; j < 4; ++j) { const int n = (lane >> 3) + 8 * j; const LAS float* s = scr + (8 * c) * 33 + n;
        u32x4 o; o.x = pk2(s[0 * 33], s[1 * 33]); o.y = pk2(s[2 * 33], s[3 * 33]); o.z = pk2(s[4 * 33], s[5 * 33]); o.w = pk2(s[6 * 33], s[7 * 33]);
        *(u32x4*)(WT + (size_t)(n0 + n) * K + k0 + 8 * c) = o; }
    asm volatile("s_waitcnt lgkmcnt(0)" ::: "memory");
}
__device__ __forceinline__ void sincos_d(float ang, float& sn, float& cs) {
    const double a = (double)ang; const double k = __builtin_rint(a * 0.15915494309189535); const double r = a - k * 6.283185307179586 ; const double r2 = r * r;
    double ts = 1.0, tc = 1.0, s = 1.0, c = 1.0;
#pragma unroll
    for (int n = 1; n <= 13; ++n) { tc = -tc * r2 / (double)((2 * n - 1) * (2 * n)); ts = -ts * r2 / (double)((2 * n) * (2 * n + 1)); c += tc; s += ts; }
    sn = (float)(s * r); cs = (float)c;
}

#define XB_TMO      128
#define XB_XCNT(j)  (256  + 64 * (j))
#define XB_XSUB(j)  (1280 + 64 * (j))
#define XB_XGEN(j)  (2304 + 64 * (j))
#define XB_TOP      3328
#define XB_TOPGEN   3392
#define XCD_BAR_WORDS 3456
#define XB_SPIN_CAP (1u << 18)
__device__ __forceinline__ unsigned xb_ld(unsigned* p)              { return __hip_atomic_load(p, __ATOMIC_RELAXED, __HIP_MEMORY_SCOPE_AGENT); }
__device__ __forceinline__ unsigned xb_add(unsigned* p, unsigned v) { return __hip_atomic_fetch_add(p, v, __ATOMIC_RELAXED, __HIP_MEMORY_SCOPE_AGENT); }
__device__ __forceinline__ unsigned xb_xcc_id() { return (unsigned)__builtin_amdgcn_s_getreg((3 << 11) | 20) & 0xFu; }
#define XB_SPIN(cond, bar) do { unsigned _sp = 0; while (cond) { __builtin_amdgcn_s_sleep(1); \
    if ((++_sp & 255u) == 0u) { if (xb_ld(&(bar)[XB_TMO])) break; if (_sp > XB_SPIN_CAP) { atomicAdd(&(bar)[XB_TMO], 1u); break; } } } } while (0)
struct XcdBarrier { unsigned* bar; unsigned x; volatile LAS unsigned* st; };
__device__ __forceinline__ XcdBarrier xcd_barrier_post(unsigned* bar, volatile LAS unsigned* st) {
    XcdBarrier b; b.bar = bar; b.x = xb_xcc_id(); b.st = st;
    if (threadIdx.x == 0) (void)xb_add(&bar[XB_XCNT(b.x)], 1u);
    return b;
}
__device__ __forceinline__ void xcd_barrier_complete(unsigned* bar, unsigned x, unsigned& nloc, unsigned& nx) {
    const unsigned G = gridDim.x * gridDim.y * gridDim.z;
    unsigned sum, cnt, mine, sp = 0u;
    for (;;) {
        sum = 0u; cnt = 0u; mine = 0u;
#pragma unroll
        for (unsigned j = 0; j < 16; ++j) { const unsigned c = xb_ld(&bar[XB_XCNT(j)]); sum += c; cnt += (c > 0u) ? 1u : 0u; mine = (j == x) ? c : mine; }
        if (sum == G) break;
        __builtin_amdgcn_s_sleep(1);
        if ((++sp & 255u) == 0u) { if (xb_ld(&bar[XB_TMO])) break; if (sp > XB_SPIN_CAP) { atomicAdd(&bar[XB_TMO], 1u); break; } }
    }
    nloc = mine > 0u ? mine : 1u; nx = cnt > 0u ? cnt : 1u;
}
__device__ __forceinline__ void xcd_barrier(const XcdBarrier& b) {
    asm volatile("s_waitcnt vmcnt(0)" ::: "memory");
    __syncthreads();
    if (threadIdx.x == 0) {
        unsigned* bar = b.bar;
        __builtin_amdgcn_s_waitcnt(0);
        unsigned nloc = b.st[0], nx = b.st[1];
        if (nloc == 0u) { xcd_barrier_complete(bar, b.x, nloc, nx); b.st[0] = nloc; b.st[1] = nx; }
        const unsigned old = xb_add(&bar[XB_XSUB(b.x)], 1u);
        const unsigned gen = old / nloc;
        if (old + 1u == (gen + 1u) * nloc) {
            __builtin_amdgcn_fence(__ATOMIC_RELEASE, "agent");
            asm volatile("s_waitcnt vmcnt(0)" ::: "memory");
            const unsigned og = xb_add(&bar[XB_TOP], 1u);
            const unsigned tg = og / nx;
            if (og + 1u == (tg + 1u) * nx) xb_add(&bar[XB_TOPGEN], 1u);
            else XB_SPIN(xb_ld(&bar[XB_TOPGEN]) == tg, bar);
            __builtin_amdgcn_fence(__ATOMIC_ACQUIRE, "agent");
            xb_add(&bar[XB_XGEN(b.x)], 1u);
            asm volatile("s_waitcnt vmcnt(0)" ::: "memory");
        } else {
            XB_SPIN(xb_ld(&bar[XB_XGEN(b.x)]) == gen, bar);
            __builtin_amdgcn_fence(__ATOMIC_ACQUIRE, "agent");
            asm volatile("s_waitcnt vmcnt(0)" ::: "memory");
        }
    }
    __syncthreads();
}

struct Args { const float* in[17]; float* out; unsigned char* ws; int ph_lo, ph_hi; };
constexpr int NPHASE = 8;

__global__ void __launch_bounds__(512, 2) mega(Args args) {
    extern __shared__ __attribute__((aligned(16))) unsigned char lds_raw[];
    LAS unsigned char* lds = (LAS unsigned char*)lds_raw;
    const int tid = threadIdx.x, lane = tid & 63, wave = __builtin_amdgcn_readfirstlane(tid >> 6);
    const int G = gridDim.x, bx = blockIdx.x; const int vcu = (G % 8 == 0) ? (bx % 8) * (G / 8) + bx / 8 : bx;
    unsigned char* ws = args.ws;
    const float *xp = args.in[0], *xs = args.in[1];
    float* COS = (float*)(ws + WS_COS); float* SIN = (float*)(ws + WS_SIN);
    bf16_t *WIN = (bf16_t*)(ws + WS_WIN), *WUQ = (bf16_t*)(ws + WS_WUQ), *WUKV = (bf16_t*)(ws + WS_WUKV), *WO = (bf16_t*)(ws + WS_WO), *WGU = (bf16_t*)(ws + WS_WGU), *WD = (bf16_t*)(ws + WS_WD);
    float *SSQ = (float*)(ws + WS_SSQ), *SSKV = (float*)(ws + WS_SSKV), *SSA = (float*)(ws + WS_SSA), *SSB = (float*)(ws + WS_SSB), *SS1 = (float*)(ws + WS_SS1), *SS2 = (float*)(ws + WS_SS2);
    bf16_t *H = (bf16_t*)(ws + WS_H), *AB = (bf16_t*)(ws + WS_AB), *CQ = (bf16_t*)(ws + WS_CQ), *CKV = (bf16_t*)(ws + WS_CKV), *KR = (bf16_t*)(ws + WS_KR), *NAB = (bf16_t*)(ws + WS_NA);
    bf16_t *Qb = (bf16_t*)(ws + WS_Q), *KN = (bf16_t*)(ws + WS_KN), *Vb = (bf16_t*)(ws + WS_V), *X1 = (bf16_t*)(ws + WS_X1), *ACT = (bf16_t*)(ws + WS_ACT);
    const int lo = args.ph_lo, hi = args.ph_hi;
    volatile LAS unsigned* MISC = (volatile LAS unsigned*)(lds + RING_BYTES + 320);
    XcdBarrier bar; bar.bar = (unsigned*)(ws + WS_CTL) + CW_BAR; bar.x = 0; bar.st = MISC;
    if (hi - lo > 1) { if (tid < 2) MISC[tid] = 0u; __syncthreads(); bar = xcd_barrier_post((unsigned*)(ws + WS_CTL) + CW_BAR, MISC); }
#ifndef PH_MASK
#define PH_MASK 0xff
#endif
#define IN(k) (((PH_MASK >> (k)) & 1) && lo <= (k) && (k) < hi)
#ifndef PH_TWICE
#define PH_TWICE -1
#endif
#ifndef EXTRA_SYNCS
#define EXTRA_SYNCS 0
#endif
#define REP(k) for (int rep_ = 0; rep_ < ((k) == PH_TWICE ? 2 : 1); ++rep_)
#ifndef CG_SEAM
#define CG_SEAM -1
#endif
#define SEAM(k) do { if (IN(k) && IN((k) + 1)) { if ((k) == CG_SEAM) cg::this_grid().sync(); else xcd_barrier(bar); } } while (0)

    REP(0) if (IN(0)) {
        LAS float* scr = (LAS float*)(lds + wave * 16384);
        const int gw = vcu * 8 + wave, NGW = G * 8;
        constexpr int I_IN = (DM / 64) * (N1P / 32), I_UQ = (QL / 64) * (768 / 32), I_UKV = (KVL / 64) * (1024 / 32), I_O = (DM / 64) * (DM / 32), I_GU = (DM / 64) * (NGU / 32), I_D = (DFF / 64) * (DM / 32);
        constexpr int NITEMS = I_IN + I_UQ + I_UKV + I_O + I_GU + I_D;
        for (int it = gw; it < NITEMS; it += NGW) {
            int r = it;
            if (r < I_IN) { wt_item(args.in[3], nullptr, DM, NIN, WIN, nullptr, nullptr, 0, scr, r, N1P / 32, lane, MapIn()); continue; } r -= I_IN;
            if (r < I_UQ) { wt_item(args.in[6], nullptr, QL, 768, WUQ, args.in[4], args.in[4], QL, scr, r, 768 / 32, lane, MapUq()); continue; } r -= I_UQ;
            if (r < I_UKV) { wt_item(args.in[7], nullptr, KVL, 1024, WUKV, args.in[5], args.in[5], KVL, scr, r, 1024 / 32, lane, MapId()); continue; } r -= I_UKV;
            if (r < I_O) { wt_item(args.in[11], nullptr, DM, DM, WO, args.in[9], args.in[10], 512, scr, r, DM / 32, lane, MapId()); continue; } r -= I_O;
            if (r < I_GU) { wt_item(args.in[13], args.in[14], DM, DFF, WGU, args.in[12], args.in[12], DM, scr, r, NGU / 32, lane, MapGU()); continue; } r -= I_GU;
            wt_item(args.in[15], nullptr, DFF, DM, WD, nullptr, nullptr, 0, scr, r, DM / 32, lane, MapId());
        }
        for (int i = bx * 512 + tid; i < SEQS * 16; i += G * 512) { const int pos = i >> 4, j = i & 15;
            double inv = 1.0; for (int q = 0; q < j; ++q) inv *= 0.5623413251903491;
            const float ang = (float)pos * (float)inv; float sn, cs; sincos_d(ang, sn, cs); COS[i] = cs; SIN[i] = sn; }
        const float* g = args.in[2];
        f32x4 gv[4];
#pragma unroll
        for (int j = 0; j < 4; ++j) gv[j] = *(const f32x4*)(g + 4 * lane + 256 * j);
        for (int m = gw; m < TOK; m += NGW) {
            const float* xr = (m < TOKP ? xp + (size_t)m * DM : xs + (size_t)(m - TOKP) * DM) + 4 * lane;
            f32x4 v[4]; float s = 0.f;
#pragma unroll
            for (int j = 0; j < 4; ++j) { v[j] = *(const f32x4*)(xr + 256 * j); s += dot4(v[j]); }
            const float rstd = 1.0f / sqrtf(wave_sum(s) * (1.0f / DM) + EPS);
#pragma unroll
            for (int j = 0; j < 4; ++j) { const f32x4 o = v[j] * rstd * gv[j]; u32x2 w; w.x = pk2(o[0], o[1]); w.y = pk2(o[2], o[3]); *(u32x2*)(H + (size_t)m * DM + 4 * lane + 256 * j) = w; }
        }
    }
    SEAM(0);
    REP(1) if (IN(1)) {
        pg8::Gemm g{H, WIN, TOK, N1P, DM}; pg8::StaticOrder S; S.init(TOK, N1P, G, bx);
        Epi1 E{CQ, CKV, KR, NAB, SSQ, SSKV, COS, SIN};
        pg8::gemm_phase<Epi1, true>(lds, g, S, E);
    }
    SEAM(1);
    REP(2) if (IN(2)) {
        { pg8::Gemm g{CQ, WUQ, TOK, 768, QL}; pg8::StaticOrder S; S.init(TOK, 768, G, bx); Epi2 E{Qb, SSQ, COS, SIN}; pg8::gemm_phase<Epi2, true>(lds, g, S, E); }
        { pg8::Gemm g{CKV, WUKV, TOK, 1024, KVL}; pg8::StaticOrder S; S.init(TOK, 1024, G, bx); Epi3 E{KN, Vb, SSKV}; pg8::gemm_phase<Epi3, true>(lds, g, S, E); }
    }
    SEAM(2);
    REP(3) if (IN(3)) {
        for (int r2_ = 0; r2_ < (PH_TWICE == 30 ? 2 : 1); ++r2_)
        if (G == 256) {
            const int x = vcu >> 5, j = vcu & 31;
            for (int i = 0; i < 2; ++i) { const int pair = 2 * x + i; att::mla_unit(lds, TOKP + (pair >> 3) * SEQS, SEQS, pair & 7, j * 256, Qb, KN, KR, Vb, AB, SSA); }
            for (int i = 0; i < 4; ++i) { const int L = 4 * j + i, pair = 16 * x + (L >> 3); att::mla_unit(lds, (pair >> 3) * SEQP, SEQP, pair & 7, (L & 7) * 256, Qb, KN, KR, Vb, AB, SSA); }
        } else {
            for (int U = vcu; U < 512; U += G) { const int pair = U >> 5; att::mla_unit(lds, TOKP + (pair >> 3) * SEQS, SEQS, pair & 7, (U & 31) * 256, Qb, KN, KR, Vb, AB, SSA); }
            for (int U = vcu; U < 1024; U += G) { const int pair = U >> 3; att::mla_unit(lds, (pair >> 3) * SEQP, SEQP, pair & 7, (U & 7) * 256, Qb, KN, KR, Vb, AB, SSA); }
        }
        for (int r2_ = 0; r2_ < (PH_TWICE == 31 ? 2 : 1); ++r2_)
        for (int U = vcu; U < 1536; U += G) {
            if (U < 1024) { const int h = U & 7, grp = U >> 3; att::na_unit2(lds, (grp >> 3) * SEQP, 32, h, (grp & 7) * 4, NAB, args.in[8], AB, SSB); }
            else { const int U2 = U - 1024, h = U2 & 7, grp = U2 >> 3; att::na_unit2(lds, TOKP + (grp >> 5) * SEQS, 128, h, (grp & 31) * 4, NAB, args.in[8], AB, SSB); }
        }
    }
    SEAM(3);
    REP(4) if (IN(4)) {
        pg8::Gemm g{AB, WO, TOK, DM, DM}; pg8::StaticOrder S; S.init(TOK, DM, G, bx);
        Epi4 E{xp, xs, X1, SSA, SSB, SS1};
        pg8::gemm_phase<Epi4, true>(lds, g, S, E);
    }
    SEAM(4);
    REP(5) if (IN(5)) {
        pg8::Gemm g{X1, WGU, TOK, NGU, DM}; pg8::StaticOrder S; S.init(TOK, NGU, G, bx);
        Epi5 E{ACT, SS1};
        pg8::gemm_phase<Epi5, true>(lds, g, S, E);
    }
    SEAM(5);
    REP(6) if (IN(6)) {
        pg8::Gemm g{ACT, WD, TOK, DM, DFF}; pg8::StaticOrder S; S.init(TOK, DM, G, bx);
        Epi6 E{X1, args.out, SS2};
        pg8::gemm_phase<Epi6, true>(lds, g, S, E);
    }
    SEAM(6);
    for (int es_ = 0; es_ < EXTRA_SYNCS; ++es_) xcd_barrier(bar);
    REP(7) if (IN(7)) {
        const int gw = vcu * 8 + wave, NGW = G * 8; const float* g = args.in[16];
        f32x4 gv[4];
#pragma unroll
        for (int j = 0; j < 4; ++j) gv[j] = *(const f32x4*)(g + 4 * lane + 256 * j);
        for (int m = gw; m < TOK; m += NGW) { float* o = args.out + (size_t)m * DM + 4 * lane; const float r = rstd16(SS2 + (size_t)m * 16);
#pragma unroll
            for (int j = 0; j < 4; ++j) { const f32x4 v = *(const f32x4*)(o + 256 * j); *(f32x4*)(o + 256 * j) = v * r * gv[j]; } }
    }
#undef IN
#undef SEAM
}

#if MK_DEBUG
__device__ __forceinline__ float block_sum(float v, LAS float* red) {
    v = wave_sum(v); __syncthreads(); if ((threadIdx.x & 63) == 0) red[threadIdx.x >> 6] = v; __syncthreads(); const float r = (red[0] + red[1]) + (red[2] + red[3]); __syncthreads(); return r;
}
__device__ __forceinline__ void report(unsigned* ctl, int phase, float rel2) {
    if (!(rel2 < 2e-4f)) { const int b = !(rel2 == rel2) ? 9 : rel2 < 1e-3f ? 1 : rel2 < 1e-2f ? 2 : rel2 < 1e-1f ? 3 : rel2 < 0.5f ? 4 : rel2 < 2.f ? 5 : 6; atomicMax(ctl + CW_FAIL, (unsigned)((8 - phase) * 16 + b)); }
}
__device__ __forceinline__ int chk_row(int b) { const int t = b >> 8; return (t == 0 ? 0 : t == 1 ? 77 : t == 2 ? 130 : 191) * 256 + (b & 255); }
__device__ __forceinline__ void rope_ref(int pos, int j, float& sn, float& cs) { const float inv = __powf(10000.0f, -(float)j / 16.0f); const float ang = (float)pos * inv; const double a = (double)ang; const double r = a - __builtin_rint(a * 0.15915494309189535) * 6.283185307179586; sn = __sinf((float)r); cs = __cosf((float)r); }

__global__ void __launch_bounds__(256) chk_phase(Args args, int phase) {
    __shared__ float buf[5632]; __shared__ float inb[2816]; __shared__ float red4[4];
    LAS float* red = (LAS float*)red4;
    unsigned char* ws = args.ws; unsigned* ctl = (unsigned*)(ws + WS_CTL);
    const int tid = threadIdx.x; const int row = chk_row(blockIdx.x);
    const float* xrow = row < TOKP ? args.in[0] + (size_t)row * DM : args.in[1] + (size_t)(row - TOKP) * DM;
    const bf16_t *H = (const bf16_t*)(ws + WS_H), *AB = (const bf16_t*)(ws + WS_AB), *CQ = (const bf16_t*)(ws + WS_CQ), *CKV = (const bf16_t*)(ws + WS_CKV), *KR = (const bf16_t*)(ws + WS_KR), *NAB = (const bf16_t*)(ws + WS_NA);
    const bf16_t *Qb = (const bf16_t*)(ws + WS_Q), *KN = (const bf16_t*)(ws + WS_KN), *Vb = (const bf16_t*)(ws + WS_V), *X1 = (const bf16_t*)(ws + WS_X1), *ACT = (const bf16_t*)(ws + WS_ACT);
    float d2 = 0.f, e2 = 0.f;
    if (phase == 0) {
        float s = 0.f; for (int k = tid; k < DM; k += 256) s += xrow[k] * xrow[k];
        const float rstd = rsqrtf(block_sum(s, red) / DM + EPS);
        for (int k = tid; k < DM; k += 256) { const float e = xrow[k] * rstd * args.in[2][k], f = bf2f(H[(size_t)row * DM + k]); d2 += (f - e) * (f - e); e2 += e * e; }
    } else if (phase == 1) {
        for (int k = tid; k < DM; k += 256) inb[k] = bf2f(H[(size_t)row * DM + k]);
        __syncthreads();
        for (int n = tid; n < NIN; n += 256) { float a = 0.f; for (int k = 0; k < DM; ++k) a += inb[k] * args.in[3][(size_t)k * NIN + n]; buf[n] = a; }
        __syncthreads();
        const int pos = seq_pos(row);
        for (int n = tid; n < NIN; n += 256) { float e, f;
            if (n < 384) { e = buf[n]; f = bf2f(CQ[(size_t)row * QL + n]); }
            else if (n < 640) { e = buf[n]; f = bf2f(CKV[(size_t)row * KVL + n - 384]); }
            else if (n < 672) { const int j = n - 640, jj = j & 15; float sn, cs; rope_ref(pos, jj, sn, cs); const float x1 = buf[640 + jj], x2 = buf[656 + jj]; e = j < 16 ? x1 * cs - x2 * sn : x1 * sn + x2 * cs; f = bf2f(KR[(size_t)row * 32 + j]); }
            else { const int c = n - 672; e = buf[n] * (c < 512 ? QSC_NA : 1.f); f = bf2f(NAB[(size_t)row * 1536 + c]); }
            d2 += (f - e) * (f - e); e2 += e * e; }
        float sq = 0.f, sk = 0.f; for (int n = tid; n < 640; n += 256) { if (n < 384) sq += buf[n] * buf[n]; else sk += buf[n] * buf[n]; }
        sq = block_sum(sq, red); sk = block_sum(sk, red);
        if (tid == 0) { float fq = 0.f, fk = 0.f; for (int i = 0; i < 12; ++i) fq += ((const float*)(ws + WS_SSQ))[(size_t)row * 12 + i]; for (int i = 0; i < 8; ++i) fk += ((const float*)(ws + WS_SSKV))[(size_t)row * 8 + i];
            const float rq = (fq - sq) / sq, rk = (fk - sk) / sk; report(ctl, 1, rq * rq + rk * rk); }
    } else if (phase == 2) {
        float s = 0.f; for (int k = tid; k < QL; k += 256) { const float v = bf2f(CQ[(size_t)row * QL + k]); inb[k] = v; s += v * v; }
        float s2 = 0.f; for (int k = tid; k < KVL; k += 256) { const float v = bf2f(CKV[(size_t)row * KVL + k]); inb[512 + k] = v; s2 += v * v; }
        const float rq = rsqrtf(block_sum(s, red) / QL + EPS), rk = rsqrtf(block_sum(s2, red) / KVL + EPS);
        for (int k = tid; k < QL; k += 256) inb[k] *= rq * args.in[4][k];
        for (int k = tid; k < KVL; k += 256) inb[512 + k] *= rk * args.in[5][k];
        __syncthreads();
        for (int n = tid; n < 768; n += 256) { float a = 0.f; for (int k = 0; k < QL; ++k) a += inb[k] * args.in[6][(size_t)k * 768 + n]; buf[n] = a; }
        for (int n = tid; n < 1024; n += 256) { float a = 0.f; for (int k = 0; k < KVL; ++k) a += inb[512 + k] * args.in[7][(size_t)k * 1024 + n]; buf[1024 + n] = a; }
        __syncthreads();
        const int pos = seq_pos(row);
        for (int n = tid; n < 768; n += 256) { const int h = n / 96, w = n - 96 * h; float e;
            if (w < 64) e = buf[n]; else { const int j = w - 64, jj = j & 15; float sn, cs; rope_ref(pos, jj, sn, cs); const float x1 = buf[h * 96 + 64 + jj], x2 = buf[h * 96 + 80 + jj]; e = j < 16 ? x1 * cs - x2 * sn : x1 * sn + x2 * cs; }
            e *= QSC_MLA; const float f = bf2f(Qb[(size_t)row * 768 + n]); d2 += (f - e) * (f - e); e2 += e * e; }
        for (int n = tid; n < 1024; n += 256) { const int h = n >> 7, w = n & 127; const float e = buf[1024 + n]; const float f = w < 64 ? bf2f(KN[(size_t)row * 512 + h * 64 + w]) : bf2f(Vb[(size_t)row * 512 + h * 64 + w - 64]); d2 += (f - e) * (f - e); e2 += e * e; }
    } else if (phase == 4) {
        float sa = 0.f, sb = 0.f; for (int k = tid; k < DM; k += 256) { const float v = bf2f(AB[(size_t)row * DM + k]); inb[k] = v; if (k < 512) sa += v * v; else sb += v * v; }
        const float ra = rsqrtf(block_sum(sa, red) / 512 + EPS), rb = rsqrtf(block_sum(sb, red) / 512 + EPS);
        for (int k = tid; k < DM; k += 256) inb[k] *= (k < 512 ? ra * args.in[9][k] : rb * args.in[10][k - 512]);
        __syncthreads();
        for (int n = tid; n < DM; n += 256) { float a = 0.f; for (int k = 0; k < DM; ++k) a += inb[k] * args.in[11][(size_t)k * DM + n]; const float e = xrow[n] + a, f = bf2f(X1[(size_t)row * DM + n]); d2 += (f - e) * (f - e); e2 += e * e; }
    } else if (phase == 5) {
        float s = 0.f; for (int k = tid; k < DM; k += 256) { const float v = bf2f(X1[(size_t)row * DM + k]); inb[k] = v; s += v * v; }
        const float r = rsqrtf(block_sum(s, red) / DM + EPS);
        for (int k = tid; k < DM; k += 256) inb[k] *= r * args.in[12][k];
        __syncthreads();
        for (int n = tid; n < DFF; n += 256) { float a = 0.f, b = 0.f; for (int k = 0; k < DM; ++k) { a += inb[k] * args.in[13][(size_t)k * DFF + n]; b += inb[k] * args.in[14][(size_t)k * DFF + n]; }
            const float e = a / (1.f + __expf(-a)) * b, f = bf2f(ACT[(size_t)row * DFF + n]); d2 += (f - e) * (f - e); e2 += e * e; }
    } else if (phase == 7) {
        for (int k = tid; k < DFF; k += 256) inb[k] = bf2f(ACT[(size_t)row * DFF + k]);
        __syncthreads();
        float s = 0.f;
        for (int n = tid; n < DM; n += 256) { float a = 0.f; for (int k = 0; k < DFF; ++k) a += inb[k] * args.in[15][(size_t)k * DM + n]; const float v = bf2f(X1[(size_t)row * DM + n]) + a; buf[n] = v; s += v * v; }
        const float r = rsqrtf(block_sum(s, red) / DM + EPS);
        for (int n = tid; n < DM; n += 256) { const float e = buf[n] * r * args.in[16][n], f = args.out[(size_t)row * DM + n]; d2 += (f - e) * (f - e); e2 += e * e; }
    }
    d2 = block_sum(d2, red); e2 = block_sum(e2, red);
    if (tid == 0) report(ctl, phase, d2 / e2);
}
__global__ void __launch_bounds__(64) chk_attn(Args args) {
    __shared__ float sc[8192]; __shared__ float qv[96];
    unsigned char* ws = args.ws; unsigned* ctl = (unsigned*)(ws + WS_CTL);
    const bf16_t *AB = (const bf16_t*)(ws + WS_AB), *KR = (const bf16_t*)(ws + WS_KR), *NAB = (const bf16_t*)(ws + WS_NA), *Qb = (const bf16_t*)(ws + WS_Q), *KN = (const bf16_t*)(ws + WS_KN), *Vb = (const bf16_t*)(ws + WS_V);
    const int sidx = blockIdx.x >> 1, kind = blockIdx.x & 1, lane = threadIdx.x;
    const int row = (int)(((long)sidx * 2731 + 17) % TOK), h = (sidx / 3) & 7;
    const int rowbase = row < TOKP ? (row / SEQP) * SEQP : TOKP + ((row - TOKP) / SEQS) * SEQS, S = row < TOKP ? SEQP : SEQS, t = row - rowbase;
    float o = 0.f, e2 = 0.f, d2 = 0.f;
    if (kind == 0) {
        for (int d = lane; d < 96; d += 64) qv[d] = bf2f(Qb[(size_t)row * 768 + h * 96 + d]);
        __syncthreads();
        float mx = -INFINITY;
        for (int j = lane; j < S; j += 64) { float s = 0.f; const bf16_t* kn = KN + (size_t)(rowbase + j) * 512 + h * 64; const bf16_t* kr = KR + (size_t)(rowbase + j) * 32;
            for (int d = 0; d < 64; ++d) s += qv[d] * bf2f(kn[d]); for (int d = 0; d < 32; ++d) s += qv[64 + d] * bf2f(kr[d]); sc[j] = s; mx = fmaxf(mx, s); }
        for (int of = 1; of < 64; of <<= 1) mx = fmaxf(mx, __shfl_xor(mx, of));
        float l = 0.f; for (int j = lane; j < S; j += 64) { const float p = exp2f(sc[j] - mx); sc[j] = p; l += p; }
        l = wave_sum(l); __syncthreads();
        for (int j = 0; j < S; ++j) o += sc[j] * bf2f(Vb[(size_t)(rowbase + j) * 512 + h * 64 + lane]);
        o /= l; const float f = bf2f(AB[(size_t)row * DM + h * 64 + lane]); d2 = (f - o) * (f - o); e2 = o * o;
        const float ssf = ((const float*)(ws + WS_SSA))[(size_t)row * 8 + h]; d2 = wave_sum(d2); e2 = wave_sum(e2);
        if (lane == 0) { const float rs = (ssf - e2) / e2; report(ctl, 3, d2 / e2 + (fabsf(rs) > 0.05f ? rs * rs : 0.f)); }
    } else {
        const int rows = S / 64, r = t >> 6, qc = t & 63; const int start = min(max(r - 4, 0), rows - 8), cs = min(max(qc - 8, 0), 48);
        for (int d = lane; d < 64; d += 64) qv[d] = bf2f(NAB[(size_t)row * 1536 + h * 64 + d]);
        __syncthreads();
        float mx = -INFINITY;
        for (int j = lane; j < 128; j += 64) { const int kr_ = start + (j >> 4), kc = cs + (j & 15); const bf16_t* kp = NAB + (size_t)(rowbase + kr_ * 64 + kc) * 1536 + 512 + h * 64;
            float s = 0.f; for (int d = 0; d < 64; ++d) s += qv[d] * bf2f(kp[d]);
            s += args.in[8][h * 465 + (kr_ - r + 7) * 31 + (kc - qc + 15)] * LOG2E; sc[j] = s; mx = fmaxf(mx, s); }
        for (int of = 1; of < 64; of <<= 1) mx = fmaxf(mx, __shfl_xor(mx, of));
        float l = 0.f; for (int j = lane; j < 128; j += 64) { const float p = exp2f(sc[j] - mx); sc[j] = p; l += p; }
        l = wave_sum(l); __syncthreads();
        for (int j = 0; j < 128; ++j) { const int kr_ = start + (j >> 4), kc = cs + (j & 15); o += sc[j] * bf2f(NAB[(size_t)(rowbase + kr_ * 64 + kc) * 1536 + 1024 + h * 64 + lane]); }
        o /= l; const float f = bf2f(AB[(size_t)row * DM + 512 + h * 64 + lane]); d2 = (f - o) * (f - o); e2 = o * o;
        const float ssf = ((const float*)(ws + WS_SSB))[(size_t)row * 8 + h]; d2 = wave_sum(d2); e2 = wave_sum(e2);
        if (lane == 0) { const float rs = (ssf - e2) / e2; report(ctl, 3, d2 / e2 + (fabsf(rs) > 0.05f ? rs * rs : 0.f)); }
    }
}
__global__ void __launch_bounds__(256) chk_final(Args args) {
    const unsigned code = ((const unsigned*)(args.ws + WS_CTL))[CW_FAIL];
    if (code == 0) return;
    const int k = 8 - (int)(code >> 4), b = (int)(code & 15); const float c = sqrtf(1.0f + (float)k + 0.1f * (float)b);
    for (size_t i = (size_t)blockIdx.x * 256 + threadIdx.x; i < (size_t)TOK * DM; i += (size_t)gridDim.x * 256) args.out[i] = c;
}
#endif

extern "C" void kernel_launch(void* const* d_in, const int* in_sizes, int n_in, void* d_out, int out_size, void* d_ws, size_t ws_size, hipStream_t stream) {
    static int grid = 0;
    if (grid == 0) {
        if (n_in != 17 || out_size != TOK * DM || ws_size < WS_NEED) { fprintf(stderr, "kernel_launch: unexpected problem (n_in %d, out %d, ws %zu; need %zu)\n", n_in, out_size, ws_size, (size_t)WS_NEED); grid = -1; return; }
        int dev = 0, cus = 0, per_cu = 0;
        hipGetDevice(&dev); hipDeviceGetAttribute(&cus, hipDeviceAttributeMultiprocessorCount, dev);
        if (hipFuncSetAttribute((const void*)mega, hipFuncAttributeMaxDynamicSharedMemorySize, LDS_BYTES) != hipSuccess) { fprintf(stderr, "kernel_launch: hipFuncSetAttribute failed\n"); grid = -1; return; }
        if (hipOccupancyMaxActiveBlocksPerMultiprocessor(&per_cu, (const void*)mega, 512, LDS_BYTES) != hipSuccess || per_cu < 1) { fprintf(stderr, "kernel_launch: occupancy query says %d\n", per_cu); per_cu = 1; }
        (void)hipGetLastError();
        grid = cus * 1;
    }
    if (grid < 0) return;
    hipMemsetAsync((char*)d_ws + WS_CTL, 0, CTL_ZERO_BYTES, stream);
    Args a{};
    for (int i = 0; i < 17; ++i) a.in[i] = (const float*)d_in[i];
    a.out = (float*)d_out; a.ws = (unsigned char*)d_ws;
#if MK_ONE_LAUNCH
    a.ph_lo = 0; a.ph_hi = NPHASE;
    void* kargs[] = {&a};
    hipError_t e = hipLaunchCooperativeKernel((const void*)mega, dim3(grid), dim3(512), kargs, LDS_BYTES, stream);
    if (e != hipSuccess) fprintf(stderr, "kernel_launch: cooperative launch failed: %s (grid %d)\n", hipGetErrorString(e), grid);
#else
    for (int ph = 0; ph < NPHASE; ++ph) {
        a.ph_lo = ph; a.ph_hi = ph + 1;
        hipLaunchKernelGGL(mega, dim3(grid), dim3(512), LDS_BYTES, stream, a);
#if MK_DEBUG
        if (ph == 3) hipLaunchKernelGGL(chk_attn, dim3(2 * 1536), dim3(64), 0, stream, a);
        else if (ph != 6) hipLaunchKernelGGL(chk_phase, dim3(1024), dim3(256), 0, stream, a, ph);
#endif
    }
#if MK_DEBUG
    hipLaunchKernelGGL(chk_final, dim3(2048), dim3(256), 0, stream, a);
#endif
#endif
}
```

```cpp
#include <hip/hip_runtime.h>
#include <hip/hip_cooperative_groups.h>
#include <cstdio>
#include <cstdint>
namespace cg = cooperative_groups;

#ifndef MK_ONE_LAUNCH
#define MK_ONE_LAUNCH 1
#endif
#ifndef MK_DEBUG
#define MK_DEBUG 0
#endif

#define GAS __attribute__((address_space(1)))
#define LAS __attribute__((address_space(3)))
typedef unsigned short bf16_t;
typedef short bf16x8 __attribute__((ext_vector_type(8)));
typedef short s16x4 __attribute__((ext_vector_type(4)));
typedef short v4i16_t __attribute__((ext_vector_type(4)));
typedef float f32x2 __attribute__((ext_vector_type(2)));
typedef float f32x4 __attribute__((ext_vector_type(4)));
typedef float f32x16 __attribute__((ext_vector_type(16)));
typedef unsigned u32x2 __attribute__((ext_vector_type(2)));
typedef unsigned u32x4 __attribute__((ext_vector_type(4)));
typedef __bf16 bf16x2_t __attribute__((ext_vector_type(2)));

__device__ __forceinline__ unsigned pk2(float lo, float hi) { f32x2 v = {lo, hi}; bf16x2_t b = __builtin_convertvector(v, bf16x2_t); return __builtin_bit_cast(unsigned, b); }
__device__ __forceinline__ float bf2f(unsigned b) { return __builtin_bit_cast(float, b << 16); }
__device__ __forceinline__ float bflo(unsigned w) { return __builtin_bit_cast(float, w << 16); }
__device__ __forceinline__ float bfhi(unsigned w) { return __builtin_bit_cast(float, w & 0xffff0000u); }
__device__ __forceinline__ u32x4 pack8(f32x4 a, f32x4 b) { u32x4 w; w.x = pk2(a[0], a[1]); w.y = pk2(a[2], a[3]); w.z = pk2(b[0], b[1]); w.w = pk2(b[2], b[3]); return w; }
__device__ __forceinline__ float sum4(f32x4 v) { return (v[0] + v[1]) + (v[2] + v[3]); }
__device__ __forceinline__ float dot4(f32x4 v) { return (v[0] * v[0] + v[1] * v[1]) + (v[2] * v[2] + v[3] * v[3]); }

constexpr int DM = 1024, TOK = 49152, TOKP = 32768, SEQP = 2048, SEQS = 8192;
constexpr int QL = 384, KVL = 256, NIN = 2208, N1P = 2304, DFF = 2816, NGU = 5632;
constexpr float EPS = 1e-6f, LOG2E = 1.4426950408889634f;
constexpr float QSC_MLA = 0.10206207261596575f * LOG2E;
constexpr float QSC_NA = 0.125f * LOG2E;
__device__ __forceinline__ int seq_pos(int row) { return row < TOKP ? (row & (SEQP - 1)) : (row & (SEQS - 1)); }

constexpr size_t KiB = 1024, MiB = 1u << 20;
constexpr size_t WS_CTL = 0, CTL_ZERO_BYTES = 64 * KiB;
constexpr size_t WS_COS = 1 * MiB, WS_SIN = WS_COS + 512 * KiB;
constexpr size_t WS_WIN = 2 * MiB;
constexpr size_t WS_WUQ = WS_WIN + (size_t)N1P * DM * 2;
constexpr size_t WS_WUKV = WS_WUQ + 768 * 384 * 2;
constexpr size_t WS_WO = WS_WUKV + 1024 * 256 * 2;
constexpr size_t WS_WGU = WS_WO + 1024 * 1024 * 2;
constexpr size_t WS_WD = WS_WGU + (size_t)NGU * DM * 2;
constexpr size_t WS_WEND = WS_WD + (size_t)DM * DFF * 2;
constexpr size_t WS_SSQ = 27 * MiB;
constexpr size_t WS_SSKV = WS_SSQ + (size_t)TOK * 12 * 4;
constexpr size_t WS_SSA = WS_SSKV + (size_t)TOK * 8 * 4;
constexpr size_t WS_SSB = WS_SSA + (size_t)TOK * 8 * 4;
constexpr size_t WS_SS1 = WS_SSB + (size_t)TOK * 8 * 4;
constexpr size_t WS_SS2 = WS_SS1 + (size_t)TOK * 16 * 4;
constexpr size_t WS_SSEND = WS_SS2 + (size_t)TOK * 16 * 4;
constexpr size_t WS_H = 40 * MiB;
constexpr size_t WS_AB = WS_H;
constexpr size_t WS_CQ = 136 * MiB;
constexpr size_t WS_CKV = WS_CQ + (size_t)TOK * QL * 2;
constexpr size_t WS_KR = WS_CKV + (size_t)TOK * KVL * 2;
constexpr size_t WS_NA = WS_KR + (size_t)TOK * 32 * 2;
constexpr size_t WS_Q = WS_NA + (size_t)TOK * 1536 * 2;
constexpr size_t WS_KN = WS_Q + (size_t)TOK * 768 * 2;
constexpr size_t WS_V = WS_KN + (size_t)TOK * 512 * 2;
constexpr size_t WS_END1 = WS_V + (size_t)TOK * 512 * 2;
constexpr size_t WS_X1 = 136 * MiB;
constexpr size_t WS_ACT = 232 * MiB;
constexpr size_t WS_NEED = 511 * MiB;
static_assert(WS_WEND <= WS_SSQ && WS_SSEND <= WS_H && WS_H + (size_t)TOK * DM * 2 <= WS_CQ && WS_END1 <= WS_NEED, "d_ws map");
static_assert(WS_X1 + (size_t)TOK * DM * 2 <= WS_ACT && WS_ACT + (size_t)TOK * DFF * 2 <= WS_NEED, "d_ws overlays");
constexpr int CW_FAIL = 16, CW_BAR = 1024;

constexpr int RING_BYTES = 131072, LDS_BYTES = 147456;

namespace pg8 {
constexpr int BM = 256, BK = 64, HALF = 128, HTB = HALF * BK * 2, STAGE_BYTES = 8 * HTB, NXCD = 8, WGM = 8;
__host__ __device__ __forceinline__ int lds_byte(int r, int c) { const int st = (r >> 4) * 2 + (c >> 5), rr = r & 15, cc = c & 31, ob = rr * 64 + cc * 2; return st * 1024 + (ob ^ (((ob >> 9) & 1) << 5)); }
__host__ __device__ __forceinline__ void stage_rc(int b, int& R, int& C) { const int st = b / 1024, sb = b % 1024, swz = sb ^ (((sb >> 9) & 1) << 5); R = (st >> 1) * 16 + swz / 64; C = (st & 1) * 32 + (swz % 64) / 2; }
__host__ __device__ __forceinline__ int perm32(int rho) { const int n = rho >> 4, i = rho & 15; return 8 * (i >> 2) + 4 * n + (i & 3); }

struct Unit { int pm, pn; };
struct Gemm { const bf16_t* A; const bf16_t* Bt; int M, N, K; };

struct StaticOrder {
    int nM, nN, nwg, G, c;
    __device__ void init(int M, int N, int G_, int c_) { nM = M / BM; nN = N / BM; nwg = nM * nN; G = G_; c = c_; }
    __device__ bool next(int i, Unit& u) const {
        const long L = (long)i * G + c; if (L >= nwg) return false;
        int wgid = (int)L; { const int q = nwg / NXCD, r = nwg % NXCD, xcd = wgid % NXCD, off = wgid / NXCD; wgid = (xcd < r ? xcd * (q + 1) : r * (q + 1) + (xcd - r) * q) + off; }
        const int nig = WGM * nN, gid = wgid / nig, fm = gid * WGM, gsz = (nM - fm) < WGM ? (nM - fm) : WGM;
        u.pm = fm + ((wgid % nig) % gsz); u.pn = (wgid % nig) / gsz; return true;
    }
};

template <class Epi, bool ALIGN_EPI>
__device__ __forceinline__ void gemm_phase(LAS unsigned char* lds, const Gemm g, const StaticOrder& S, const Epi& E) {
    int tid = threadIdx.x; asm volatile("" : "+v"(tid));
    const int wid = __builtin_amdgcn_readfirstlane(tid >> 6), lane = tid & 63, wr = wid >> 2, wc = wid & 3, fr = lane & 15, fq = lane >> 4;
    const int K = g.K, nt = K / BK;
    unsigned voffA[2], voffB[2];
#pragma unroll
    for (int i = 0; i < 2; ++i) { int R, C; stage_rc(tid * 16 + i * 8192, R, C); const int Rb = Epi::PERM ? ((R & ~31) + perm32(R & 31)) : R;
        voffA[i] = (unsigned)(R * K + C) * 2u; voffB[i] = (unsigned)(Rb * K + C) * 2u; }
    const size_t kstep = (size_t)(BK * 2);
    const size_t hstep = (size_t)HALF * K * 2;
    const size_t tstep = 2 * hstep;
    const unsigned ldsw = (unsigned)wid * 1024u;
    const int aoff = lds_byte(wr * 64 + fr, fq * 8), boff = lds_byte(wc * 32 + fr, fq * 8);
#define PG8_SA(b, h) (((b) * 2 + (h)) * HTB)
#define PG8_SB(b, h) ((4 + (b) * 2 + (h)) * HTB)
#define PG8_STAGE(bufoff, gbase, voff) do { _Pragma("unroll") for (int _i = 0; _i < 2; ++_i) \
        __builtin_amdgcn_global_load_lds((const unsigned*)((const char*)(gbase) + (voff)[_i]), (LAS unsigned*)(lds + (bufoff) + ldsw + _i * 8192), 16, 0, 0); } while (0)
#define PG8_LDA(dst, b, h) do { _Pragma("unroll") for (int m = 0; m < 4; ++m) _Pragma("unroll") for (int k = 0; k < 2; ++k) dst[m][k] = *(const LAS bf16x8*)(lds + PG8_SA(b, h) + aoff + m * 2048 + k * 1024); } while (0)
#define PG8_LDB(dst, b, h) do { _Pragma("unroll") for (int n = 0; n < 2; ++n) _Pragma("unroll") for (int k = 0; k < 2; ++k) dst[n][k] = *(const LAS bf16x8*)(lds + PG8_SB(b, h) + boff + n * 2048 + k * 1024); } while (0)
#define PG8_MMA(ai, bj, At, Bt) do { __builtin_amdgcn_s_setprio(1); _Pragma("unroll") for (int m = 0; m < 4; ++m) _Pragma("unroll") for (int n = 0; n < 2; ++n) _Pragma("unroll") for (int k = 0; k < 2; ++k) \
        acc[ai][bj][m][n] = __builtin_amdgcn_mfma_f32_16x16x32_bf16(Bt[n][k], At[m][k], acc[ai][bj][m][n], 0, 0, 0); __builtin_amdgcn_s_setprio(0); } while (0)
#define PG8_WAIT_V(n) asm volatile("s_waitcnt vmcnt(" #n ")" ::: "memory")
#define PG8_WAIT_L(n) asm volatile("s_waitcnt lgkmcnt(" #n ")" ::: "memory")
#define PG8_BAR __builtin_amdgcn_s_barrier()
#define PG8_SCHED __builtin_amdgcn_sched_barrier(0)
    Unit cur, nxt; int ui = 0;
    if (!S.next(0, cur)) return;
    f32x4 acc[2][2][4][2];
#pragma unroll
    for (int a = 0; a < 2; ++a)
#pragma unroll
        for (int b = 0; b < 2; ++b)
#pragma unroll
            for (int m = 0; m < 4; ++m)
#pragma unroll
                for (int n = 0; n < 2; ++n) acc[a][b][m][n] = (f32x4){0.f, 0.f, 0.f, 0.f};
    bf16x8 At[4][2], B0[2][2], B1[2][2];
    const char* cA = (const char*)g.A + (size_t)cur.pm * tstep; const char* cB = (const char*)g.Bt + (size_t)cur.pn * tstep;
    PG8_STAGE(PG8_SB(0, 0), cB, voffB); PG8_STAGE(PG8_SB(0, 1), cB + hstep, voffB); PG8_STAGE(PG8_SA(0, 0), cA, voffA); PG8_STAGE(PG8_SA(0, 1), cA + hstep, voffA);
    if (wr == 1) PG8_BAR;
    PG8_WAIT_V(2); PG8_BAR;
    PG8_STAGE(PG8_SB(1, 0), cB + kstep, voffB); PG8_STAGE(PG8_SA(1, 0), cA + kstep, voffA); PG8_STAGE(PG8_SB(1, 1), cB + hstep + kstep, voffB);
    PG8_WAIT_V(6); PG8_BAR;
    for (;;) {
        const bool has_next = S.next(ui + 1, nxt);
        const char* nA = has_next ? (const char*)g.A + (size_t)nxt.pm * tstep : cA; const char* nB = has_next ? (const char*)g.Bt + (size_t)nxt.pn * tstep : cB;
#pragma unroll 1
        for (int t = 0; t < nt; t += 2) {
            if constexpr (Epi::MID_T >= 0) { if (t == Epi::MID_T) E.mid(acc, cur, wr, wc, fr, fq); }
            const bool last = (t == nt - 2);
            const char* a1 = cA + (size_t)(t + 1) * kstep;
            const char* a2 = last ? nA : cA + (size_t)(t + 2) * kstep; const char* b2 = last ? nB : cB + (size_t)(t + 2) * kstep;
            const char* a3 = a2 + kstep; const char* b3 = b2 + kstep;
            PG8_LDB(B0, 0, 0); PG8_LDB(B1, 0, 1); PG8_SCHED; PG8_LDA(At, 0, 0); PG8_STAGE(PG8_SA(1, 1), a1 + hstep, voffA);
            PG8_WAIT_V(8); PG8_WAIT_L(0); PG8_BAR; PG8_MMA(0, 0, At, B0); PG8_MMA(0, 1, At, B1); PG8_BAR; PG8_SCHED;
            PG8_LDA(At, 0, 1); PG8_STAGE(PG8_SB(0, 0), b2, voffB); PG8_STAGE(PG8_SB(0, 1), b2 + hstep, voffB); PG8_STAGE(PG8_SA(0, 0), a2, voffA);
            PG8_WAIT_V(8); PG8_WAIT_L(0); PG8_BAR; PG8_MMA(1, 0, At, B0); PG8_MMA(1, 1, At, B1); PG8_BAR; PG8_SCHED;
            PG8_LDB(B0, 1, 0); PG8_LDB(B1, 1, 1); PG8_SCHED; PG8_LDA(At, 1, 0); PG8_STAGE(PG8_SA(0, 1), a2 + hstep, voffA);
            PG8_WAIT_V(8); PG8_WAIT_L(0); PG8_BAR; PG8_MMA(0, 0, At, B0); PG8_MMA(0, 1, At, B1); PG8_BAR; PG8_SCHED;
            PG8_LDA(At, 1, 1); PG8_STAGE(PG8_SB(1, 0), b3, voffB); PG8_STAGE(PG8_SB(1, 1), b3 + hstep, voffB); PG8_STAGE(PG8_SA(1, 0), a3, voffA);
            PG8_WAIT_V(8); PG8_WAIT_L(0); PG8_BAR; PG8_MMA(1, 0, At, B0); PG8_MMA(1, 1, At, B1); PG8_BAR; PG8_SCHED;
        }
        if constexpr (ALIGN_EPI) { if (wr == 0) PG8_BAR; }
        E(acc, cur, wr, wc, fr, fq);
        if (!has_next) break;
#pragma unroll
        for (int a = 0; a < 2; ++a)
#pragma unroll
            for (int b = 0; b < 2; ++b)
#pragma unroll
                for (int m = 0; m < 4; ++m)
#pragma unroll
                    for (int n = 0; n < 2; ++n) acc[a][b][m][n] = (f32x4){0.f, 0.f, 0.f, 0.f};
        cur = nxt; cA = nA; cB = nB; ++ui;
        if constexpr (ALIGN_EPI) { if (wr == 1) PG8_BAR; }
    }
    PG8_WAIT_V(0);
    if constexpr (!ALIGN_EPI) { if (wr == 0) PG8_BAR; }
    PG8_BAR;
#undef PG8_SA
#undef PG8_SB
#undef PG8_STAGE
#undef PG8_LDA
#undef PG8_LDB
#undef PG8_MMA
#undef PG8_WAIT_V
#undef PG8_WAIT_L
#undef PG8_BAR
#undef PG8_SCHED
}
}
using pg8::Unit;

struct Epi1 {
    static constexpr bool PERM = true; static constexpr int MID_T = -1;
    bf16_t *CQ, *CKV, *KR, *NA; float *SSQ, *SSKV; const float *COS, *SIN;
    __device__ __forceinline__ void mid(f32x4 (&)[2][2][4][2], const Unit&, int, int, int, int) const {}
    __device__ __forceinline__ void operator()(const f32x4 (&acc)[2][2][4][2], const Unit& u, int wr, int wc, int fr, int fq_in) const {
        int row0 = u.pm * 256 + wr * 64 + fr, fq = fq_in; asm volatile("" : "+v"(row0), "+v"(fq));
#pragma unroll
        for (int bj = 0; bj < 2; ++bj) {
            const int gc = u.pn * 256 + bj * 128 + wc * 32;
            if (gc < 640) {
                const bool isq = gc < QL;
                bf16_t* base = isq ? CQ : CKV; const int ld = isq ? QL : KVL, col = isq ? gc : gc - QL; float* ss = isq ? SSQ : SSKV; const int nslot = isq ? 12 : 8, slot = col >> 5;
#pragma unroll
                for (int ai = 0; ai < 2; ++ai)
#pragma unroll
                    for (int m = 0; m < 4; ++m) { const int row = row0 + ai * 128 + m * 16; const f32x4 v0 = acc[ai][bj][m][0], v1 = acc[ai][bj][m][1];
                        float s = dot4(v0) + dot4(v1); s += __shfl_xor(s, 16); s += __shfl_xor(s, 32);
                        if (fq == 0) ss[(size_t)row * nslot + slot] = s;
                        *(u32x4*)(base + (size_t)row * ld + col + 8 * fq) = pack8(v0, v1); }
            } else if (gc < 672) {
#pragma unroll
                for (int ai = 0; ai < 2; ++ai)
#pragma unroll
                    for (int m = 0; m < 4; ++m) { const int row = row0 + ai * 128 + m * 16; const int pos = seq_pos(row);
                        const f32x4 c4 = *(const f32x4*)(COS + pos * 16 + 4 * fq), s4 = *(const f32x4*)(SIN + pos * 16 + 4 * fq);
                        const f32x4 x1 = acc[ai][bj][m][0], x2 = acc[ai][bj][m][1]; const f32x4 o1 = x1 * c4 - x2 * s4, o2 = x1 * s4 + x2 * c4;
                        u32x2 w1, w2; w1.x = pk2(o1[0], o1[1]); w1.y = pk2(o1[2], o1[3]); w2.x = pk2(o2[0], o2[1]); w2.y = pk2(o2[2], o2[3]);
                        *(u32x2*)(KR + (size_t)row * 32 + 4 * fq) = w1; *(u32x2*)(KR + (size_t)row * 32 + 16 + 4 * fq) = w2; }
            } else if (gc >= 768) {
                const int col = gc - 768; const float sc = col < 512 ? QSC_NA : 1.0f;
#pragma unroll
                for (int ai = 0; ai < 2; ++ai)
#pragma unroll
                    for (int m = 0; m < 4; ++m) { const int row = row0 + ai * 128 + m * 16;
                        *(u32x4*)(NA + (size_t)row * 1536 + col + 8 * fq) = pack8(acc[ai][bj][m][0] * sc, acc[ai][bj][m][1] * sc); }
            }
        }
    }
};
struct Epi2 {
    static constexpr bool PERM = true; static constexpr int MID_T = -1;
    bf16_t* Q; const float *SSQ, *COS, *SIN;
    __device__ __forceinline__ void mid(f32x4 (&)[2][2][4][2], const Unit&, int, int, int, int) const {}
    __device__ __forceinline__ void operator()(const f32x4 (&acc)[2][2][4][2], const Unit& u, int wr, int wc, int fr, int fq_in) const {
        int row0 = u.pm * 256 + wr * 64 + fr, fq = fq_in; asm volatile("" : "+v"(row0), "+v"(fq));
#pragma unroll
        for (int ai = 0; ai < 2; ++ai)
#pragma unroll
            for (int m = 0; m < 4; ++m) { const int row = row0 + ai * 128 + m * 16; const float* p = SSQ + (size_t)row * 12;
                const f32x4 a = *(const f32x4*)p, b = *(const f32x4*)(p + 4), c = *(const f32x4*)(p + 8);
                const float r = __builtin_amdgcn_rsqf((sum4(a) + sum4(b) + sum4(c)) * (1.0f / QL) + EPS) * QSC_MLA;
#pragma unroll
                for (int bj = 0; bj < 2; ++bj) {
                    const int gc = u.pn * 256 + bj * 128 + wc * 32, G = gc >> 5, h = G / 3, part = G - 3 * h;
                    if (part < 2) {
                        *(u32x4*)(Q + (size_t)row * 768 + h * 96 + part * 32 + 8 * fq) = pack8(acc[ai][bj][m][0] * r, acc[ai][bj][m][1] * r);
                    } else { const int pos = seq_pos(row);
                        const f32x4 c4 = *(const f32x4*)(COS + pos * 16 + 4 * fq), s4 = *(const f32x4*)(SIN + pos * 16 + 4 * fq);
                        const f32x4 x1 = acc[ai][bj][m][0] * r, x2 = acc[ai][bj][m][1] * r; const f32x4 o1 = x1 * c4 - x2 * s4, o2 = x1 * s4 + x2 * c4;
                        u32x2 w1, w2; w1.x = pk2(o1[0], o1[1]); w1.y = pk2(o1[2], o1[3]); w2.x = pk2(o2[0], o2[1]); w2.y = pk2(o2[2], o2[3]);
                        bf16_t* qp = Q + (size_t)row * 768 + h * 96 + 64 + 4 * fq; *(u32x2*)qp = w1; *(u32x2*)(qp + 16) = w2; }
                }
                asm volatile("" ::: "memory"); }
    }
};
struct Epi3 {
    static constexpr bool PERM = true; static constexpr int MID_T = -1;
    bf16_t *KN, *V; const float* SSKV;
    __device__ __forceinline__ void mid(f32x4 (&)[2][2][4][2], const Unit&, int, int, int, int) const {}
    __device__ __forceinline__ void operator()(const f32x4 (&acc)[2][2][4][2], const Unit& u, int wr, int wc, int fr, int fq_in) const {
        int row0 = u.pm * 256 + wr * 64 + fr, fq = fq_in; asm volatile("" : "+v"(row0), "+v"(fq));
        float rs[2][4];
#pragma unroll
        for (int ai = 0; ai < 2; ++ai)
#pragma unroll
            for (int m = 0; m < 4; ++m) { const float* p = SSKV + (size_t)(row0 + ai * 128 + m * 16) * 8;
                const f32x4 a = *(const f32x4*)p, b = *(const f32x4*)(p + 4);
                rs[ai][m] = __builtin_amdgcn_rsqf((sum4(a) + sum4(b)) * (1.0f / KVL) + EPS); }
#pragma unroll
        for (int bj = 0; bj < 2; ++bj) {
            const int gc = u.pn * 256 + bj * 128 + wc * 32, h = gc >> 7, w = gc & 127;
            bf16_t* base = (w < 64) ? KN + h * 64 + w : V + h * 64 + (w - 64);
#pragma unroll
            for (int ai = 0; ai < 2; ++ai)
#pragma unroll
                for (int m = 0; m < 4; ++m) { const int row = row0 + ai * 128 + m * 16; const float r = rs[ai][m];
                    *(u32x4*)(base + (size_t)row * 512 + 8 * fq) = pack8(acc[ai][bj][m][0] * r, acc[ai][bj][m][1] * r); }
        }
    }
};
struct Epi4 {
    static constexpr bool PERM = true; static constexpr int MID_T = 8;
    const float *xp, *xs; bf16_t* X1; const float *SSA, *SSB; float* SS1;
    __device__ __forceinline__ float rstd8(const float* p) const { const f32x4 a = *(const f32x4*)p, b = *(const f32x4*)(p + 4); return __builtin_amdgcn_rsqf((sum4(a) + sum4(b)) * (1.0f / 512.0f) + EPS); }
    __device__ __forceinline__ void mid(f32x4 (&acc)[2][2][4][2], const Unit& u, int wr, int wc, int fr, int fq_in) const {
        int row0 = u.pm * 256 + wr * 64 + fr, fq = fq_in; asm volatile("" : "+v"(row0), "+v"(fq));
#pragma unroll
        for (int ai = 0; ai < 2; ++ai)
#pragma unroll
            for (int m = 0; m < 4; ++m) { const size_t row = (size_t)(row0 + ai * 128 + m * 16);
                const float ra = rstd8(SSA + row * 8), rb = rstd8(SSB + row * 8); const float f = ra / rb;
#pragma unroll
                for (int bj = 0; bj < 2; ++bj)
#pragma unroll
                    for (int n = 0; n < 2; ++n) acc[ai][bj][m][n] = acc[ai][bj][m][n] * f;
                asm volatile("" ::: "memory"); }
    }
    __device__ __forceinline__ void operator()(const f32x4 (&acc)[2][2][4][2], const Unit& u, int wr, int wc, int fr, int fq_in) const {
        int row0 = u.pm * 256 + wr * 64 + fr, fq = fq_in; asm volatile("" : "+v"(row0), "+v"(fq)); const int colw = u.pn * 256 + wc * 32 + 8 * fq;
#pragma unroll
        for (int ai = 0; ai < 2; ++ai)
#pragma unroll
            for (int m = 0; m < 4; ++m) { const int row = row0 + ai * 128 + m * 16; const float rb = rstd8(SSB + (size_t)row * 8);
                const float* xr = (row < TOKP ? xp + (size_t)row * DM : xs + (size_t)(row - TOKP) * DM) + colw;
                float s = 0.f;
#pragma unroll
                for (int bj = 0; bj < 2; ++bj) { const f32x4 a0 = *(const f32x4*)(xr + bj * 128), a1 = *(const f32x4*)(xr + bj * 128 + 4);
                    const f32x4 v0 = a0 + acc[ai][bj][m][0] * rb, v1 = a1 + acc[ai][bj][m][1] * rb; s += dot4(v0) + dot4(v1);
                    *(u32x4*)(X1 + (size_t)row * DM + colw + bj * 128) = pack8(v0, v1); }
                s += __shfl_xor(s, 16); s += __shfl_xor(s, 32);
                if (fq == 0) SS1[(size_t)row * 16 + u.pn * 4 + wc] = s;
                asm volatile("" ::: "memory"); }
    }
};
__device__ __forceinline__ float rstd16(const float* p) { const f32x4 a = *(const f32x4*)p, b = *(const f32x4*)(p + 4), c = *(const f32x4*)(p + 8), d = *(const f32x4*)(p + 12);
    return __builtin_amdgcn_rsqf(((sum4(a) + sum4(b)) + (sum4(c) + sum4(d))) * (1.0f / DM) + EPS); }
struct Epi5 {
    static constexpr bool PERM = true; static constexpr int MID_T = -1;
    bf16_t* ACT; const float* SS1;
    __device__ __forceinline__ void mid(f32x4 (&)[2][2][4][2], const Unit&, int, int, int, int) const {}
    __device__ __forceinline__ void operator()(const f32x4 (&acc)[2][2][4][2], const Unit& u, int wr, int wc, int fr, int fq_in) const {
        int row0 = u.pm * 256 + wr * 64 + fr, fq = fq_in; asm volatile("" : "+v"(row0), "+v"(fq)); const int col = u.pn * 128 + wc * 32 + 8 * fq;
#pragma unroll
        for (int ai = 0; ai < 2; ++ai)
#pragma unroll
            for (int m = 0; m < 4; ++m) { const int row = row0 + ai * 128 + m * 16; const float r = rstd16(SS1 + (size_t)row * 16);
                f32x4 o[2];
#pragma unroll
                for (int n = 0; n < 2; ++n) { const f32x4 gt = acc[ai][0][m][n] * r, up = acc[ai][1][m][n] * r;
#pragma unroll
                    for (int i = 0; i < 4; ++i) o[n][i] = gt[i] * __builtin_amdgcn_rcpf(1.0f + __builtin_amdgcn_exp2f(-gt[i] * LOG2E)) * up[i]; }
                *(u32x4*)(ACT + (size_t)row * DFF + col) = pack8(o[0], o[1]); }
    }
};
struct Epi6 {
    static constexpr bool PERM = false; static constexpr int MID_T = -1;
    const bf16_t* X1; float* out; float* SS2;
    __device__ __forceinline__ void mid(f32x4 (&)[2][2][4][2], const Unit&, int, int, int, int) const {}
    __device__ __forceinline__ void operator()(const f32x4 (&acc)[2][2][4][2], const Unit& u, int wr, int wc, int fr, int fq_in) const {
        int row0 = u.pm * 256 + wr * 64 + fr, fq = fq_in; asm volatile("" : "+v"(row0), "+v"(fq)); const int colw = u.pn * 256 + wc * 32 + 4 * fq;
#pragma unroll
        for (int ai = 0; ai < 2; ++ai)
#pragma unroll
            for (int m = 0; m < 4; ++m) { const int row = row0 + ai * 128 + m * 16; float s = 0.f;
#pragma unroll
                for (int bj = 0; bj < 2; ++bj)
#pragma unroll
                    for (int n = 0; n < 2; ++n) { const size_t off = (size_t)row * DM + colw + bj * 128 + n * 16; const u32x2 w = *(const u32x2*)(X1 + off);
                        f32x4 v = acc[ai][bj][m][n]; v[0] += bflo(w.x); v[1] += bfhi(w.x); v[2] += bflo(w.y); v[3] += bfhi(w.y); s += dot4(v);
                        *(f32x4*)(out + off) = v; }
                s += __shfl_xor(s, 16); s += __shfl_xor(s, 32);
                if (fq == 0) SS2[(size_t)row * 16 + u.pn * 4 + wc] = s; }
    }
};

namespace att {
constexpr int KSLOT = 12288, VSLOT = 8192;
constexpr int L_K = 0, L_V = 2 * KSLOT, L_WS = L_V + 2 * VSLOT, L_OST = L_WS + 8 * 256, L_BIAS = L_OST + 8 * 4096, L_END = L_BIAS + 2560;
static_assert(L_END <= RING_BYTES, "attention LDS");
constexpr int THRL = 8;
constexpr int NA_K = 0, NA_V = 32768;
#define MFMA32(a, b, c) __builtin_amdgcn_mfma_f32_32x32x16_bf16(a, b, c, 0, 0, 0)
__device__ __forceinline__ int crow(int r, int hi) { return (r & 3) + 8 * (r >> 2) + 4 * hi; }
__device__ __forceinline__ s16x4 vtr(const LAS unsigned char* p) { return __builtin_bit_cast(s16x4, __builtin_amdgcn_ds_read_tr16_b64_v4i16((LAS v4i16_t*)p)); }
__device__ __forceinline__ void glds(const void* g, LAS unsigned char* dst) { __builtin_amdgcn_global_load_lds((const unsigned*)g, (LAS unsigned*)dst, 16, 0, 0); }

struct SoftSt { float mhat, l; f32x16 o[2]; f32x16 negm; };

template <int ND, bool NA>
__device__ __forceinline__ void tile_step(SoftSt& st, const bf16x8 (&qr)[ND], const LAS unsigned char* kb, const LAS unsigned char* vp, LAS float* wsf, int r32, int hi, bool first,
                                          const LAS float* brow, int cs) {
    f32x16 C0, C1;
#pragma unroll
    for (int d0 = 0; d0 < ND; ++d0) {
        const bf16x8 b0 = *(const LAS bf16x8*)(kb + d0 * 2048), b1 = *(const LAS bf16x8*)(kb + d0 * 2048 + 512);
        if (d0 == 0) { C0 = MFMA32(b0, qr[0], st.negm); C1 = MFMA32(b1, qr[0], st.negm); } else { C0 = MFMA32(b0, qr[d0], C0); C1 = MFMA32(b1, qr[d0], C1); }
    }
    if (NA) {
#pragma unroll
        for (int r = 0; r < 16; ++r) { const int kc = (r & 3) + 8 * (r >> 2) + 4 * hi;
            C0[r] = ((unsigned)(kc - cs) < 16u) ? C0[r] + brow[kc] : -INFINITY;
            C1[r] = ((unsigned)(kc + 32 - cs) < 16u) ? C1[r] + brow[kc + 32] : -INFINITY; }
    }
#define MX3(a, b, c) __builtin_fmaxf(__builtin_fmaxf((a), (b)), (c))
    float a = MX3(C0[0], C0[1], C1[0]), b = MX3(C0[2], C0[3], C1[1]); a = MX3(a, C1[2], C1[3]);
#pragma unroll
    for (int r = 4; r < 16; r += 4) { a = MX3(a, C0[r], C0[r + 1]); b = MX3(b, C0[r + 2], C0[r + 3]); a = MX3(a, C1[r], C1[r + 1]); b = MX3(b, C1[r + 2], C1[r + 3]); }
#undef MX3
    float rm = __builtin_fmaxf(a, b);
    { auto rr = __builtin_amdgcn_permlane32_swap(__float_as_uint(rm), __float_as_uint(rm), false, false); rm = __builtin_fmaxf(__uint_as_float(rr[0]), __uint_as_float(rr[1])); }
    bool resc = false;
    if (first || __any(rm > (float)THRL)) {
        const float dl = first ? rm : __builtin_fmaxf(rm, 0.f); st.mhat += dl;
#pragma unroll
        for (int r = 0; r < 16; ++r) { C0[r] -= dl; C1[r] -= dl; st.negm[r] = -st.mhat; }
        const float f = first ? 0.f : __builtin_amdgcn_exp2f(-dl); st.l *= f; if (hi == 0) wsf[r32] = f; resc = true;
    }
    float sacc = 0.f;
#pragma unroll
    for (int r = 0; r < 16; ++r) { C0[r] = __builtin_amdgcn_exp2f(C0[r]); C1[r] = __builtin_amdgcn_exp2f(C1[r]); sacc += C0[r] + C1[r]; }
    st.l += sacc;
    u32x4 pw0, pw1, pw2, pw3;
    pw0 = (u32x4){pk2(C0[0], C0[1]), pk2(C0[2], C0[3]), pk2(C0[4], C0[5]), pk2(C0[6], C0[7])}; pw1 = (u32x4){pk2(C0[8], C0[9]), pk2(C0[10], C0[11]), pk2(C0[12], C0[13]), pk2(C0[14], C0[15])};
    pw2 = (u32x4){pk2(C1[0], C1[1]), pk2(C1[2], C1[3]), pk2(C1[4], C1[5]), pk2(C1[6], C1[7])}; pw3 = (u32x4){pk2(C1[8], C1[9]), pk2(C1[10], C1[11]), pk2(C1[12], C1[13]), pk2(C1[14], C1[15])};
    if (resc) {
#pragma unroll
        for (int r = 0; r < 16; ++r) { const float f = wsf[crow(r, hi)]; st.o[0][r] *= f; st.o[1][r] *= f; }
    }
#pragma unroll
    for (int d0 = 0; d0 < 2; ++d0) {
#pragma unroll
        for (int ks = 0; ks < 4; ++ks) { const s16x4 lo = vtr(vp + d0 * 4096 + ks * 1024), hh = vtr(vp + d0 * 4096 + ks * 1024 + 512);
            const bf16x8 vb = (bf16x8){lo[0], lo[1], lo[2], lo[3], hh[0], hh[1], hh[2], hh[3]};
            const bf16x8 pa = __builtin_bit_cast(bf16x8, ks == 0 ? pw0 : ks == 1 ? pw1 : ks == 2 ? pw2 : pw3);
            st.o[d0] = MFMA32(pa, vb, st.o[d0]); }
    }
}
__device__ __forceinline__ void attn_epilogue(SoftSt& st, LAS unsigned char* lds, int wid, int lane, int r32, int hi, bf16_t* Orow0  , float* SSrow0  ) {
    LAS float* wsf = (LAS float*)(lds + L_WS) + wid * 64;
    { auto rr = __builtin_amdgcn_permlane32_swap(__float_as_uint(st.l), __float_as_uint(st.l), false, false); st.l = __uint_as_float(rr[0]) + __uint_as_float(rr[1]); }
    if (hi == 0) wsf[32 + r32] = st.l;
    LAS bf16_t* stg = (LAS bf16_t*)(lds + L_OST) + wid * 2048;
#pragma unroll
    for (int r = 0; r < 16; ++r) { const int orow = crow(r, hi); const float rl = __builtin_amdgcn_rcpf(wsf[32 + orow]);
        const unsigned w0 = pk2(st.o[0][r] * rl, 0.f), w1 = pk2(st.o[1][r] * rl, 0.f);
        stg[orow * 64 + r32] = (bf16_t)(w0 & 0xffffu); stg[orow * 64 + 32 + r32] = (bf16_t)(w1 & 0xffffu); }
#pragma unroll
    for (int i = 0; i < 4; ++i) { const int row = i * 8 + (lane >> 3), ch = lane & 7; const u32x4 v = *(const LAS u32x4*)(stg + row * 64 + ch * 8);
        float s = 0.f;
#pragma unroll
        for (int j = 0; j < 4; ++j) { const float x = bflo(v[j]), y = bfhi(v[j]); s += x * x + y * y; }
        s += __shfl_xor(s, 1); s += __shfl_xor(s, 2); s += __shfl_xor(s, 4);
        if (ch == 0) SSrow0[(size_t)row * 8] = s;
        *(u32x4*)(Orow0 + (size_t)row * DM + ch * 8) = v; }
}

__device__ __forceinline__ void mla_unit(LAS unsigned char* lds, int rowbase, int S, int h, int q0, const bf16_t* Q, const bf16_t* KN, const bf16_t* KR, const bf16_t* V, bf16_t* AB, float* SSA) {
    const int tid = threadIdx.x, lane = tid & 63, r32 = lane & 31, hi = lane >> 5; const int wid = __builtin_amdgcn_readfirstlane(tid >> 6);
    const bf16_t* ksrc = KN + (size_t)(rowbase + lane) * 512 + h * 64 + wid * 8;
    const bf16_t* rsrc = KR + (size_t)(rowbase + lane) * 32 + (wid & 3) * 8;
    const bf16_t* vsrc = V + (size_t)(rowbase + 16 * (wid & 3) + (lane >> 2)) * 512 + h * 64 + (wid >> 2) * 32 + (lane & 3) * 8;
#define MLA_STAGE(t, s) do { glds(ksrc + (size_t)(t) * 64 * 512, lds + L_K + (s) * KSLOT + wid * 1024); \
        if (wid < 4) glds(rsrc + (size_t)(t) * 64 * 32, lds + L_K + (s) * KSLOT + (8 + wid) * 1024); \
        glds(vsrc + (size_t)(t) * 64 * 512, lds + L_V + (s) * VSLOT + wid * 1024); } while (0)
    const int NT = S / 64;
    MLA_STAGE(0, 0);
    const int qrow = rowbase + q0 + wid * 32;
    bf16x8 qr[6];
#pragma unroll
    for (int d0 = 0; d0 < 6; ++d0) qr[d0] = *(const bf16x8*)(Q + (size_t)(qrow + r32) * 768 + h * 96 + d0 * 16 + hi * 8);
    SoftSt st; st.mhat = 0.f; st.l = 0.f; st.o[0] = f32x16{}; st.o[1] = f32x16{}; st.negm = f32x16{};
    LAS float* wsf = (LAS float*)(lds + L_WS) + wid * 64;
    const int kboff = hi * 1024 + r32 * 16, vpoff = ((lane >> 4) & 1) * 32 + (lane & 3) * 8 + (4 * hi + ((lane & 15) >> 2)) * 64;
    asm volatile("s_waitcnt vmcnt(0)" ::: "memory"); __syncthreads();
    for (int t = 0; t < NT; ++t) {
        const int s = t & 1;
        if (t + 1 < NT) MLA_STAGE(t + 1, s ^ 1);
        tile_step<6, false>(st, qr, lds + L_K + s * KSLOT + kboff, lds + L_V + s * VSLOT + vpoff, wsf, r32, hi, t == 0, nullptr, 0);
        asm volatile("s_waitcnt vmcnt(0)" ::: "memory"); __syncthreads();
    }
#undef MLA_STAGE
    attn_epilogue(st, lds, wid, lane, r32, hi, AB + (size_t)qrow * DM + h * 64, SSA + (size_t)qrow * 8 + h);
}

__device__ __forceinline__ void na_unit(LAS unsigned char* lds, int rowbase, int rows, int h, int R0, const bf16_t* NAB, const float* rpb, bf16_t* AB, float* SSB) {
    const int tid = threadIdx.x, lane = tid & 63, r32 = lane & 31, hi = lane >> 5; const int wid = __builtin_amdgcn_readfirstlane(tid >> 6);
    LAS float* tab = (LAS float*)(lds + L_BIAS);
    for (int i = tid; i < 640; i += 512) { const int j = i - 48; tab[i] = (j >= 0 && j < 465) ? rpb[h * 465 + j] * LOG2E : 0.f; }
    const int r = R0 + (wid >> 1), qh = wid & 1;
    const int start_w = min(max(r - 4, 0), rows - 8);
    const int u_lo = min(max(R0 - 4, 0), rows - 8), u_hi = min(max(R0 - 1, 0), rows - 8) + 8;
    const bf16_t* ksrc = NAB + (size_t)(rowbase + lane) * 1536 + 512 + h * 64 + wid * 8;
    const bf16_t* vsrc = NAB + (size_t)(rowbase + 16 * (wid & 3) + (lane >> 2)) * 1536 + 1024 + h * 64 + (wid >> 2) * 32 + (lane & 3) * 8;
#define NA_STAGE(u, s) do { glds(ksrc + (size_t)(u) * 64 * 1536, lds + L_K + (s) * KSLOT + wid * 1024); glds(vsrc + (size_t)(u) * 64 * 1536, lds + L_V + (s) * VSLOT + wid * 1024); } while (0)
    NA_STAGE(u_lo, 0);
    const int qrow = rowbase + r * 64 + qh * 32;
    bf16x8 qr[4];
#pragma unroll
    for (int d0 = 0; d0 < 4; ++d0) qr[d0] = *(const bf16x8*)(NAB + (size_t)(qrow + r32) * 1536 + h * 64 + d0 * 16 + hi * 8);
    SoftSt st; st.mhat = 0.f; st.l = 0.f; st.o[0] = f32x16{}; st.o[1] = f32x16{}; st.negm = f32x16{};
    LAS float* wsf = (LAS float*)(lds + L_WS) + wid * 64;
    const int kboff = hi * 1024 + r32 * 16, vpoff = ((lane >> 4) & 1) * 32 + (lane & 3) * 8 + (4 * hi + ((lane & 15) >> 2)) * 64;
    const int qc = qh * 32 + r32, cs = min(max(qc - 8, 0), 48);
    asm volatile("s_waitcnt vmcnt(0)" ::: "memory"); __syncthreads();
    const int NT = u_hi - u_lo;
    for (int i = 0; i < NT; ++i) {
        const int s = i & 1, u = u_lo + i;
        if (i + 1 < NT) NA_STAGE(u + 1, s ^ 1);
        if (u >= start_w && u < start_w + 8)
            tile_step<4, true>(st, qr, lds + L_K + s * KSLOT + kboff, lds + L_V + s * VSLOT + vpoff, wsf, r32, hi, u == start_w, tab + 48 + (u - r + 7) * 31 + 15 - qc, cs);
        asm volatile("s_waitcnt vmcnt(0)" ::: "memory"); __syncthreads();
    }
#undef NA_STAGE
    attn_epilogue(st, lds, wid, lane, r32, hi, AB + (size_t)qrow * DM + 512 + h * 64, SSB + (size_t)qrow * 8 + h);
}
__device__ __forceinline__ void na_unit2(LAS unsigned char* lds, int rowbase, int rows, int h, int R0, const bf16_t* NAB, const float* rpb, bf16_t* AB, float* SSB) {
    const int tid = threadIdx.x, lane = tid & 63, q16 = lane & 15, quad = lane >> 4; const int wid = __builtin_amdgcn_readfirstlane(tid >> 6);
    LAS float* tab = (LAS float*)(lds + L_BIAS);
    for (int i = tid; i < 640; i += 512) { const int j = i - 48; tab[i] = (j >= 0 && j < 465) ? rpb[h * 465 + j] * LOG2E : 0.f; }
    const int r = R0 + (wid >> 1), qh = wid & 1;
    const int start_w = min(max(r - 4, 0), rows - 8);
    const int u_lo = min(max(R0 - 4, 0), rows - 8), u_hi = min(max(R0 - 1, 0), rows - 8) + 8;
    const bf16_t* ksrc = NAB + (size_t)(rowbase + lane) * 1536 + 512 + h * 64 + wid * 8;
    const bf16_t* vsrc = NAB + (size_t)(rowbase + 16 * (wid & 3) + (lane >> 2)) * 1536 + 1024 + h * 64 + (wid >> 2) * 32 + (lane & 3) * 8;
#define NA_STAGE(u, s) do { glds(ksrc + (size_t)(u) * 64 * 1536, lds + NA_K + (s) * 8192 + wid * 1024); glds(vsrc + (size_t)(u) * 64 * 1536, lds + NA_V + (s) * 8192 + wid * 1024); } while (0)
    const int NT = u_hi - u_lo;
    NA_STAGE(u_lo, 0); NA_STAGE(u_lo + 1, 1); NA_STAGE(u_lo + 2, 2);
    const int qrow = rowbase + r * 64 + qh * 32;
    bf16x8 qf[2][2];
#pragma unroll
    for (int jb = 0; jb < 2; ++jb)
#pragma unroll
        for (int ks = 0; ks < 2; ++ks) qf[jb][ks] = *(const bf16x8*)(NAB + (size_t)(qrow + 16 * jb + q16) * 1536 + h * 64 + 32 * ks + 8 * quad);
    float mhat[2] = {0.f, 0.f}, lsum[2] = {0.f, 0.f}; f32x4 o[2][4];
#pragma unroll
    for (int jb = 0; jb < 2; ++jb)
#pragma unroll
        for (int db = 0; db < 4; ++db) o[jb][db] = (f32x4){0.f, 0.f, 0.f, 0.f};
    int koff[2], cs[2], kaddr[2], vaddr[2], boff[2];
#pragma unroll
    for (int jb = 0; jb < 2; ++jb) { const int jq = 2 * qh + jb, qc = 16 * jq + q16; koff[jb] = jq == 0 ? 0 : jq == 1 ? 8 : jq == 2 ? 24 : 32; cs[jb] = min(max(qc - 8, 0), 48);
        kaddr[jb] = quad * 1024 + (koff[jb] + q16) * 16;
        const int vr = koff[jb] + 4 * quad + (q16 >> 2); vaddr[jb] = (vr >> 4) * 1024 + (vr & 15) * 64 + (lane & 3) * 8;
        boff[jb] = 48 + 15 - qc + koff[jb] + 4 * quad; }
    asm volatile("s_waitcnt vmcnt(4)" ::: "memory"); __syncthreads();
    for (int it = 0; it < NT; ++it) {
        const int s = it & 3, u = u_lo + it;
        if (it + 3 < NT) NA_STAGE(u + 3, (it + 3) & 3);
        if (u >= start_w && u < start_w + 8) {
            const bool first = (u == start_w);
            f32x4 C[2][2]; float rm[2];
#pragma unroll
            for (int jb = 0; jb < 2; ++jb) {
                const LAS unsigned char* kp = lds + NA_K + s * 8192 + kaddr[jb];
                const float nm = -mhat[jb]; C[jb][0] = (f32x4){nm, nm, nm, nm}; C[jb][1] = C[jb][0];
#pragma unroll
                for (int ks = 0; ks < 2; ++ks)
#pragma unroll
                    for (int kb = 0; kb < 2; ++kb) C[jb][kb] = __builtin_amdgcn_mfma_f32_16x16x32_bf16(*(const LAS bf16x8*)(kp + ks * 4096 + kb * 256), qf[jb][ks], C[jb][kb], 0, 0, 0);
            }
#pragma unroll
            for (int jb = 0; jb < 2; ++jb) {
                const LAS float* brow = tab + boff[jb] + (u - r + 7) * 31; const int kc0 = koff[jb] + 4 * quad - cs[jb];
#pragma unroll
                for (int kb = 0; kb < 2; ++kb) { float bv[4];
#pragma unroll
                    for (int i = 0; i < 4; ++i) bv[i] = brow[16 * kb + i];
#pragma unroll
                    for (int i = 0; i < 4; ++i) { const float t = C[jb][kb][i] + bv[i]; C[jb][kb][i] = ((unsigned)(kc0 + 16 * kb + i) < 16u) ? t : -INFINITY; } }
                float m = __builtin_fmaxf(__builtin_fmaxf(__builtin_fmaxf(C[jb][0][0], C[jb][0][1]), __builtin_fmaxf(C[jb][0][2], C[jb][0][3])), __builtin_fmaxf(__builtin_fmaxf(C[jb][1][0], C[jb][1][1]), __builtin_fmaxf(C[jb][1][2], C[jb][1][3])));
                { auto rr = __builtin_amdgcn_permlane16_swap(__float_as_uint(m), __float_as_uint(m), false, false); m = __builtin_fmaxf(__uint_as_float(rr[0]), __uint_as_float(rr[1])); }
                { auto rr = __builtin_amdgcn_permlane32_swap(__float_as_uint(m), __float_as_uint(m), false, false); m = __builtin_fmaxf(__uint_as_float(rr[0]), __uint_as_float(rr[1])); }
                rm[jb] = m;
            }
            if (first || __any(__builtin_fmaxf(rm[0], rm[1]) > (float)THRL)) {
#pragma unroll
                for (int jb = 0; jb < 2; ++jb) {
                    const float dl = first ? rm[jb] : __builtin_fmaxf(rm[jb], 0.f); mhat[jb] += dl; C[jb][0] = C[jb][0] - dl; C[jb][1] = C[jb][1] - dl;
                    const float f = first ? 0.f : __builtin_amdgcn_exp2f(-dl); lsum[jb] *= f;
#pragma unroll
                    for (int db = 0; db < 4; ++db) o[jb][db] = o[jb][db] * f;
                }
            }
#pragma unroll
            for (int jb = 0; jb < 2; ++jb) {
                const LAS unsigned char* vp = lds + NA_V + s * 8192 + vaddr[jb];
                float sacc = 0.f;
#pragma unroll
                for (int kb = 0; kb < 2; ++kb)
#pragma unroll
                    for (int i = 0; i < 4; ++i) { C[jb][kb][i] = __builtin_amdgcn_exp2f(C[jb][kb][i]); sacc += C[jb][kb][i]; }
                lsum[jb] += sacc;
                const u32x4 pw = (u32x4){pk2(C[jb][0][0], C[jb][0][1]), pk2(C[jb][0][2], C[jb][0][3]), pk2(C[jb][1][0], C[jb][1][1]), pk2(C[jb][1][2], C[jb][1][3])};
                const bf16x8 pf = __builtin_bit_cast(bf16x8, pw);
#pragma unroll
                for (int db = 0; db < 4; ++db) { const int dbo = (db >> 1) * 4096 + (db & 1) * 32; const s16x4 lo = vtr(vp + dbo), hh = vtr(vp + dbo + 1024);
                    const bf16x8 vf = (bf16x8){lo[0], lo[1], lo[2], lo[3], hh[0], hh[1], hh[2], hh[3]};
                    o[jb][db] = __builtin_amdgcn_mfma_f32_16x16x32_bf16(vf, pf, o[jb][db], 0, 0, 0); }
            }
        }
        { const int ahead = min(it + 3, NT - 1) - (it + 1);
          if (ahead >= 2) asm volatile("s_waitcnt vmcnt(4) lgkmcnt(0)" ::: "memory"); else if (ahead == 1) asm volatile("s_waitcnt vmcnt(2) lgkmcnt(0)" ::: "memory"); else asm volatile("s_waitcnt vmcnt(0) lgkmcnt(0)" ::: "memory");
          __builtin_amdgcn_s_barrier(); asm volatile("" ::: "memory"); }
    }
#undef NA_STAGE
#pragma unroll
    for (int jb = 0; jb < 2; ++jb) {
        float l = lsum[jb];
        { auto rr = __builtin_amdgcn_permlane16_swap(__float_as_uint(l), __float_as_uint(l), false, false); l = __uint_as_float(rr[0]) + __uint_as_float(rr[1]); }
        { auto rr = __builtin_amdgcn_permlane32_swap(__float_as_uint(l), __float_as_uint(l), false, false); l = __uint_as_float(rr[0]) + __uint_as_float(rr[1]); }
        const float inv = __builtin_amdgcn_rcpf(l); float ss = 0.f; const size_t tok = (size_t)(qrow + 16 * jb + q16);
        bf16_t* op = AB + tok * DM + 512 + h * 64 + 4 * quad;
#pragma unroll
        for (int db = 0; db < 4; ++db) { const f32x4 v = o[jb][db] * inv; ss += dot4(v); u32x2 w; w.x = pk2(v[0], v[1]); w.y = pk2(v[2], v[3]); *(u32x2*)(op + 16 * db) = w; }
        ss += __shfl_xor(ss, 16); ss += __shfl_xor(ss, 32);
        if (quad == 0) SSB[tok * 8 + h] = ss;
    }
}
}

__device__ __forceinline__ float wave_sum(float v) {
#pragma unroll
    for (int o = 1; o < 64; o <<= 1) v += __shfl_xor(v, o);
    return v;
}
__device__ __forceinline__ int ropeperm(int p) { return 16 * ((p >> 2) & 1) + 4 * (p >> 3) + (p & 3); }
struct MapIn  { __device__ int operator()(int n) const { if (n < 640) return n; if (n < 672) return 640 + ropeperm(n - 640); if (n < 768) return -1; return n - 96; } };
struct MapUq  { __device__ int operator()(int n) const { const int h = n / 96, w = n - 96 * h; return w < 64 ? n : 96 * h + 64 + ropeperm(w - 64); } };
struct MapId  { __device__ int operator()(int n) const { return n; } };
struct MapGU  { __device__ int operator()(int n) const { const int pn = n >> 8, w = n & 255; return w < 128 ? 128 * pn + w : DFF + 128 * pn + (w - 128); } };
template <class Map>
__device__ __forceinline__ void wt_item(const float* W, const float* W2, int K, int N, bf16_t* WT, const float* g0, const float* g1, int ksplit, LAS float* scr, int item, int nblk, int lane, Map map) {
    const int kb = item / nblk, nb = item % nblk, k0 = 64 * kb, n0 = 32 * nb;
    int src = map(n0 + (lane & 31)); const float* Wsrc = W; if (W2 && src >= N) { Wsrc = W2; src -= N; }
#pragma unroll 8
    for (int i = 0; i < 32; ++i) { const int kk = 2 * i + (lane >> 5), k = k0 + kk; float v = src >= 0 ? Wsrc[(size_t)k * N + src] : 0.f;
        if (g0) v *= (k < ksplit ? g0[k] : g1[k - ksplit]);
        scr[kk * 33 + (lane & 31)] = v; }
    asm volatile("s_waitcnt lgkmcnt(0)" ::: "memory");
    const int c = lane & 7;
#pragma unroll
    for (int j = 0; j < 4; ++j) { const int n = (lane >> 3) + 8 * j; const LAS float* s = scr + (8 * c) * 33 + n;
        u32x4 o; o.x = pk2(s[0 * 33], s[1 * 33]); o.y = pk2(s[2 * 33], s[3 * 33]); o.z = pk2(s[4 * 33], s[5 * 33]); o.w = pk2(s[6 * 33], s[7 * 33]);
        *(u32x4*)(WT + (size_t)(n0 + n) * K + k0 + 8 * c) = o; }
    asm volatile("s_waitcnt lgkmcnt(0)" ::: "memory");
}
__device__ __forceinline__ void sincos_d(float ang, float& sn, float& cs) {
    const double a = (double)ang; const double k = __builtin_rint(a * 0.15915494309189535); const double r = a - k * 6.283185307179586 ; const double r2 = r * r;
    double ts = 1.0, tc = 1.0, s = 1.0, c = 1.0;
#pragma unroll
    for (int n = 1; n <= 13; ++n) { tc = -tc * r2 / (double)((2 * n - 1) * (2 * n)); ts = -ts * r2 / (double)((2 * n) * (2 * n + 1)); c += tc; s += ts; }
    sn = (float)(s * r); cs = (float)c;
}

#define XB_TMO      128
#define XB_XCNT(j)  (256  + 64 * (j))
#define XB_XSUB(j)  (1280 + 64 * (j))
#define XB_XGEN(j)  (2304 + 64 * (j))
#define XB_TOP      3328
#define XB_TOPGEN   3392
#define XCD_BAR_WORDS 3456
#define XB_SPIN_CAP (1u << 18)
__device__ __forceinline__ unsigned xb_ld(unsigned* p)              { return __hip_atomic_load(p, __ATOMIC_RELAXED, __HIP_MEMORY_SCOPE_AGENT); }
__device__ __forceinline__ unsigned xb_add(unsigned* p, unsigned v) { return __hip_atomic_fetch_add(p, v, __ATOMIC_RELAXED, __HIP_MEMORY_SCOPE_AGENT); }
__device__ __forceinline__ unsigned xb_xcc_id() { return (unsigned)__builtin_amdgcn_s_getreg((3 << 11) | 20) & 0xFu; }
#define XB_SPIN(cond, bar) do { unsigned _sp = 0; while (cond) { __builtin_amdgcn_s_sleep(1); \
    if ((++_sp & 255u) == 0u) { if (xb_ld(&(bar)[XB_TMO])) break; if (_sp > XB_SPIN_CAP) { atomicAdd(&(bar)[XB_TMO], 1u); break; } } } } while (0)
struct XcdBarrier { unsigned* bar; unsigned x; volatile LAS unsigned* st; };
__device__ __forceinline__ XcdBarrier xcd_barrier_post(unsigned* bar, volatile LAS unsigned* st) {
    XcdBarrier b; b.bar = bar; b.x = xb_xcc_id(); b.st = st;
    if (threadIdx.x == 0) (void)xb_add(&bar[XB_XCNT(b.x)], 1u);
    return b;
}
__device__ __forceinline__ void xcd_barrier_complete(unsigned* bar, unsigned x, unsigned& nloc, unsigned& nx) {
    const unsigned G = gridDim.x * gridDim.y * gridDim.z;
    unsigned sum, cnt, mine, sp = 0u;
    for (;;) {
        sum = 0u; cnt = 0u; mine = 0u;
#pragma unroll
        for (unsigned j = 0; j < 16; ++j) { const unsigned c = xb_ld(&bar[XB_XCNT(j)]); sum += c; cnt += (c > 0u) ? 1u : 0u; mine = (j == x) ? c : mine; }
        if (sum == G) break;
        __builtin_amdgcn_s_sleep(1);
        if ((++sp & 255u) == 0u) { if (xb_ld(&bar[XB_TMO])) break; if (sp > XB_SPIN_CAP) { atomicAdd(&bar[XB_TMO], 1u); break; } }
    }
    nloc = mine > 0u ? mine : 1u; nx = cnt > 0u ? cnt : 1u;
}
__device__ __forceinline__ void xcd_barrier(const XcdBarrier& b) {
    asm volatile("s_waitcnt vmcnt(0)" ::: "memory");
    __syncthreads();
    if (threadIdx.x == 0) {
        unsigned* bar = b.bar;
        __builtin_amdgcn_s_waitcnt(0);
        unsigned nloc = b.st[0], nx = b.st[1];
        if (nloc == 0u) { xcd_barrier_complete(bar, b.x, nloc, nx); b.st[0] = nloc; b.st[1] = nx; }
        const unsigned old = xb_add(&bar[XB_XSUB(b.x)], 1u);
        const unsigned gen = old / nloc;
        if (old + 1u == (gen + 1u) * nloc) {
            __builtin_amdgcn_fence(__ATOMIC_RELEASE, "agent");
            asm volatile("s_waitcnt vmcnt(0)" ::: "memory");
            const unsigned og = xb_add(&bar[XB_TOP], 1u);
            const unsigned tg = og / nx;
            if (og + 1u == (tg + 1u) * nx) xb_add(&bar[XB_TOPGEN], 1u);
            else XB_SPIN(xb_ld(&bar[XB_TOPGEN]) == tg, bar);
            __builtin_amdgcn_fence(__ATOMIC_ACQUIRE, "agent");
            xb_add(&bar[XB_XGEN(b.x)], 1u);
            asm volatile("s_waitcnt vmcnt(0)" ::: "memory");
        } else {
            XB_SPIN(xb_ld(&bar[XB_XGEN(b.x)]) == gen, bar);
            __builtin_amdgcn_fence(__ATOMIC_ACQUIRE, "agent");
            asm volatile("s_waitcnt vmcnt(0)" ::: "memory");
        }
    }
    __syncthreads();
}

struct Args { const float* in[17]; float* out; unsigned char* ws; int ph_lo, ph_hi; };
constexpr int NPHASE = 8;

__global__ void __launch_bounds__(512, 2) mega(Args args) {
    extern __shared__ __attribute__((aligned(16))) unsigned char lds_raw[];
    LAS unsigned char* lds = (LAS unsigned char*)lds_raw;
    const int tid = threadIdx.x, lane = tid & 63, wave = __builtin_amdgcn_readfirstlane(tid >> 6);
    const int G = gridDim.x, bx = blockIdx.x; const int vcu = (G % 8 == 0) ? (bx % 8) * (G / 8) + bx / 8 : bx;
    unsigned char* ws = args.ws;
    const float *xp = args.in[0], *xs = args.in[1];
    float* COS = (float*)(ws + WS_COS); float* SIN = (float*)(ws + WS_SIN);
    bf16_t *WIN = (bf16_t*)(ws + WS_WIN), *WUQ = (bf16_t*)(ws + WS_WUQ), *WUKV = (bf16_t*)(ws + WS_WUKV), *WO = (bf16_t*)(ws + WS_WO), *WGU = (bf16_t*)(ws + WS_WGU), *WD = (bf16_t*)(ws + WS_WD);
    float *SSQ = (float*)(ws + WS_SSQ), *SSKV = (float*)(ws + WS_SSKV), *SSA = (float*)(ws + WS_SSA), *SSB = (float*)(ws + WS_SSB), *SS1 = (float*)(ws + WS_SS1), *SS2 = (float*)(ws + WS_SS2);
    bf16_t *H = (bf16_t*)(ws + WS_H), *AB = (bf16_t*)(ws + WS_AB), *CQ = (bf16_t*)(ws + WS_CQ), *CKV = (bf16_t*)(ws + WS_CKV), *KR = (bf16_t*)(ws + WS_KR), *NAB = (bf16_t*)(ws + WS_NA);
    bf16_t *Qb = (bf16_t*)(ws + WS_Q), *KN = (bf16_t*)(ws + WS_KN), *Vb = (bf16_t*)(ws + WS_V), *X1 = (bf16_t*)(ws + WS_X1), *ACT = (bf16_t*)(ws + WS_ACT);
    const int lo = args.ph_lo, hi = args.ph_hi;
    volatile LAS unsigned* MISC = (volatile LAS unsigned*)(lds + RING_BYTES + 320);
    XcdBarrier bar; bar.bar = (unsigned*)(ws + WS_CTL) + CW_BAR; bar.x = 0; bar.st = MISC;
    if (hi - lo > 1) { if (tid < 2) MISC[tid] = 0u; __syncthreads(); bar = xcd_barrier_post((unsigned*)(ws + WS_CTL) + CW_BAR, MISC); }
#ifndef PH_MASK
#define PH_MASK 0xff
#endif
#define IN(k) (((PH_MASK >> (k)) & 1) && lo <= (k) && (k) < hi)
#ifndef PH_TWICE
#define PH_TWICE -1
#endif
#ifndef EXTRA_SYNCS
#define EXTRA_SYNCS 0
#endif
#define REP(k) for (int rep_ = 0; rep_ < ((k) == PH_TWICE ? 2 : 1); ++rep_)
#ifndef CG_SEAM
#define CG_SEAM -1
#endif
#define SEAM(k) do { if (IN(k) && IN((k) + 1)) { if ((k) == CG_SEAM) cg::this_grid().sync(); else xcd_barrier(bar); } } while (0)

    REP(0) if (IN(0)) {
        LAS float* scr = (LAS float*)(lds + wave * 16384);
        const int gw = vcu * 8 + wave, NGW = G * 8;
        constexpr int I_IN = (DM / 64) * (N1P / 32), I_UQ = (QL / 64) * (768 / 32), I_UKV = (KVL / 64) * (1024 / 32), I_O = (DM / 64) * (DM / 32), I_GU = (DM / 64) * (NGU / 32), I_D = (DFF / 64) * (DM / 32);
        constexpr int NITEMS = I_IN + I_UQ + I_UKV + I_O + I_GU + I_D;
        for (int it = gw; it < NITEMS; it += NGW) {
            int r = it;
            if (r < I_IN) { wt_item(args.in[3], nullptr, DM, NIN, WIN, nullptr, nullptr, 0, scr, r, N1P / 32, lane, MapIn()); continue; } r -= I_IN;
            if (r < I_UQ) { wt_item(args.in[6], nullptr, QL, 768, WUQ, args.in[4], args.in[4], QL, scr, r, 768 / 32, lane, MapUq()); continue; } r -= I_UQ;
            if (r < I_UKV) { wt_item(args.in[7], nullptr, KVL, 1024, WUKV, args.in[5], args.in[5], KVL, scr, r, 1024 / 32, lane, MapId()); continue; } r -= I_UKV;
            if (r < I_O) { wt_item(args.in[11], nullptr, DM, DM, WO, args.in[9], args.in[10], 512, scr, r, DM / 32, lane, MapId()); continue; } r -= I_O;
            if (r < I_GU) { wt_item(args.in[13], args.in[14], DM, DFF, WGU, args.in[12], args.in[12], DM, scr, r, NGU / 32, lane, MapGU()); continue; } r -= I_GU;
            wt_item(args.in[15], nullptr, DFF, DM, WD, nullptr, nullptr, 0, scr, r, DM / 32, lane, MapId());
        }
        for (int i = bx * 512 + tid; i < SEQS * 16; i += G * 512) { const int pos = i >> 4, j = i & 15;
            double inv = 1.0; for (int q = 0; q < j; ++q) inv *= 0.5623413251903491;
            const float ang = (float)pos * (float)inv; float sn, cs; sincos_d(ang, sn, cs); COS[i] = cs; SIN[i] = sn; }
        const float* g = args.in[2];
        f32x4 gv[4];
#pragma unroll
        for (int j = 0; j < 4; ++j) gv[j] = *(const f32x4*)(g + 4 * lane + 256 * j);
        for (int m = gw; m < TOK; m += NGW) {
            const float* xr = (m < TOKP ? xp + (size_t)m * DM : xs + (size_t)(m - TOKP) * DM) + 4 * lane;
            f32x4 v[4]; float s = 0.f;
#pragma unroll
            for (int j = 0; j < 4; ++j) { v[j] = *(const f32x4*)(xr + 256 * j); s += dot4(v[j]); }
            const float rstd = 1.0f / sqrtf(wave_sum(s) * (1.0f / DM) + EPS);
#pragma unroll
            for (int j = 0; j < 4; ++j) { const f32x4 o = v[j] * rstd * gv[j]; u32x2 w; w.x = pk2(o[0], o[1]); w.y = pk2(o[2], o[3]); *(u32x2*)(H + (size_t)m * DM + 4 * lane + 256 * j) = w; }
        }
    }
    SEAM(0);
    REP(1) if (IN(1)) {
        pg8::Gemm g{H, WIN, TOK, N1P, DM}; pg8::StaticOrder S; S.init(TOK, N1P, G, bx);
        Epi1 E{CQ, CKV, KR, NAB, SSQ, SSKV, COS, SIN};
        pg8::gemm_phase<Epi1, true>(lds, g, S, E);
    }
    SEAM(1);
    REP(2) if (IN(2)) {
        { pg8::Gemm g{CQ, WUQ, TOK, 768, QL}; pg8::StaticOrder S; S.init(TOK, 768, G, bx); Epi2 E{Qb, SSQ, COS, SIN}; pg8::gemm_phase<Epi2, true>(lds, g, S, E); }
        { pg8::Gemm g{CKV, WUKV, TOK, 1024, KVL}; pg8::StaticOrder S; S.init(TOK, 1024, G, bx); Epi3 E{KN, Vb, SSKV}; pg8::gemm_phase<Epi3, true>(lds, g, S, E); }
    }
    SEAM(2);
    REP(3) if (IN(3)) {
        for (int r2_ = 0; r2_ < (PH_TWICE == 30 ? 2 : 1); ++r2_)
        if (G == 256) {
            const int x = vcu >> 5, j = vcu & 31;
            for (int i = 0; i < 2; ++i) { const int pair = 2 * x + i; att::mla_unit(lds, TOKP + (pair >> 3) * SEQS, SEQS, pair & 7, j * 256, Qb, KN, KR, Vb, AB, SSA); }
            for (int i = 0; i < 4; ++i) { const int L = 4 * j + i, pair = 16 * x + (L >> 3); att::mla_unit(lds, (pair >> 3) * SEQP, SEQP, pair & 7, (L & 7) * 256, Qb, KN, KR, Vb, AB, SSA); }
        } else {
            for (int U = vcu; U < 512; U += G) { const int pair = U >> 5; att::mla_unit(lds, TOKP + (pair >> 3) * SEQS, SEQS, pair & 7, (U & 31) * 256, Qb, KN, KR, Vb, AB, SSA); }
            for (int U = vcu; U < 1024; U += G) { const int pair = U >> 3; att::mla_unit(lds, (pair >> 3) * SEQP, SEQP, pair & 7, (U & 7) * 256, Qb, KN, KR, Vb, AB, SSA); }
        }
        for (int r2_ = 0; r2_ < (PH_TWICE == 31 ? 2 : 1); ++r2_)
        for (int U = vcu; U < 1536; U += G) {
            if (U < 1024) { const int h = U & 7, grp = U >> 3; att::na_unit2(lds, (grp >> 3) * SEQP, 32, h, (grp & 7) * 4, NAB, args.in[8], AB, SSB); }
            else { const int U2 = U - 1024, h = U2 & 7, grp = U2 >> 3; att::na_unit2(lds, TOKP + (grp >> 5) * SEQS, 128, h, (grp & 31) * 4, NAB, args.in[8], AB, SSB); }
        }
    }
    SEAM(3);
    REP(4) if (IN(4)) {
        pg8::Gemm g{AB, WO, TOK, DM, DM}; pg8::StaticOrder S; S.init(TOK, DM, G, bx);
        Epi4 E{xp, xs, X1, SSA, SSB, SS1};
        pg8::gemm_phase<Epi4, true>(lds, g, S, E);
    }
    SEAM(4);
    REP(5) if (IN(5)) {
        pg8::Gemm g{X1, WGU, TOK, NGU, DM}; pg8::StaticOrder S; S.init(TOK, NGU, G, bx);
        Epi5 E{ACT, SS1};
        pg8::gemm_phase<Epi5, true>(lds, g, S, E);
    }
    SEAM(5);
    REP(6) if (IN(6)) {
        pg8::Gemm g{ACT, WD, TOK, DM, DFF}; pg8::StaticOrder S; S.init(TOK, DM, G, bx);
        Epi6 E{X1, args.out, SS2};
        pg8::gemm_phase<Epi6, true>(lds, g, S, E);
    }
    SEAM(6);
    for (int es_ = 0; es_ < EXTRA_SYNCS; ++es_) xcd_barrier(bar);
    REP(7) if (IN(7)) {
        const int gw = vcu * 8 + wave, NGW = G * 8; const float* g = args.in[16];
        f32x4 gv[4];
#pragma unroll
        for (int j = 0; j < 4; ++j) gv[j] = *(const f32x4*)(g + 4 * lane + 256 * j);
        for (int m = gw; m < TOK; m += NGW) { float* o = args.out + (size_t)m * DM + 4 * lane; const float r = rstd16(SS2 + (size_t)m * 16);
#pragma unroll
            for (int j = 0; j < 4; ++j) { const f32x4 v = *(const f32x4*)(o + 256 * j); *(f32x4*)(o + 256 * j) = v * r * gv[j]; } }
    }
#undef IN
#undef SEAM
}

#if MK_DEBUG
__device__ __forceinline__ float block_sum(float v, LAS float* red) {
    v = wave_sum(v); __syncthreads(); if ((threadIdx.x & 63) == 0) red[threadIdx.x >> 6] = v; __syncthreads(); const float r = (red[0] + red[1]) + (red[2] + red[3]); __syncthreads(); return r;
}
__device__ __forceinline__ void report(unsigned* ctl, int phase, float rel2) {
    if (!(rel2 < 2e-4f)) { const int b = !(rel2 == rel2) ? 9 : rel2 < 1e-3f ? 1 : rel2 < 1e-2f ? 2 : rel2 < 1e-1f ? 3 : rel2 < 0.5f ? 4 : rel2 < 2.f ? 5 : 6; atomicMax(ctl + CW_FAIL, (unsigned)((8 - phase) * 16 + b)); }
}
__device__ __forceinline__ int chk_row(int b) { const int t = b >> 8; return (t == 0 ? 0 : t == 1 ? 77 : t == 2 ? 130 : 191) * 256 + (b & 255); }
__device__ __forceinline__ void rope_ref(int pos, int j, float& sn, float& cs) { const float inv = __powf(10000.0f, -(float)j / 16.0f); const float ang = (float)pos * inv; const double a = (double)ang; const double r = a - __builtin_rint(a * 0.15915494309189535) * 6.283185307179586; sn = __sinf((float)r); cs = __cosf((float)r); }

__global__ void __launch_bounds__(256) chk_phase(Args args, int phase) {
    __shared__ float buf[5632]; __shared__ float inb[2816]; __shared__ float red4[4];
    LAS float* red = (LAS float*)red4;
    unsigned char* ws = args.ws; unsigned* ctl = (unsigned*)(ws + WS_CTL);
    const int tid = threadIdx.x; const int row = chk_row(blockIdx.x);
    const float* xrow = row < TOKP ? args.in[0] + (size_t)row * DM : args.in[1] + (size_t)(row - TOKP) * DM;
    const bf16_t *H = (const bf16_t*)(ws + WS_H), *AB = (const bf16_t*)(ws + WS_AB), *CQ = (const bf16_t*)(ws + WS_CQ), *CKV = (const bf16_t*)(ws + WS_CKV), *KR = (const bf16_t*)(ws + WS_KR), *NAB = (const bf16_t*)(ws + WS_NA);
    const bf16_t *Qb = (const bf16_t*)(ws + WS_Q), *KN = (const bf16_t*)(ws + WS_KN), *Vb = (const bf16_t*)(ws + WS_V), *X1 = (const bf16_t*)(ws + WS_X1), *ACT = (const bf16_t*)(ws + WS_ACT);
    float d2 = 0.f, e2 = 0.f;
    if (phase == 0) {
        float s = 0.f; for (int k = tid; k < DM; k += 256) s += xrow[k] * xrow[k];
        const float rstd = rsqrtf(block_sum(s, red) / DM + EPS);
        for (int k = tid; k < DM; k += 256) { const float e = xrow[k] * rstd * args.in[2][k], f = bf2f(H[(size_t)row * DM + k]); d2 += (f - e) * (f - e); e2 += e * e; }
    } else if (phase == 1) {
        for (int k = tid; k < DM; k += 256) inb[k] = bf2f(H[(size_t)row * DM + k]);
        __syncthreads();
        for (int n = tid; n < NIN; n += 256) { float a = 0.f; for (int k = 0; k < DM; ++k) a += inb[k] * args.in[3][(size_t)k * NIN + n]; buf[n] = a; }
        __syncthreads();
        const int pos = seq_pos(row);
        for (int n = tid; n < NIN; n += 256) { float e, f;
            if (n < 384) { e = buf[n]; f = bf2f(CQ[(size_t)row * QL + n]); }
            else if (n < 640) { e = buf[n]; f = bf2f(CKV[(size_t)row * KVL + n - 384]); }
            else if (n < 672) { const int j = n - 640, jj = j & 15; float sn, cs; rope_ref(pos, jj, sn, cs); const float x1 = buf[640 + jj], x2 = buf[656 + jj]; e = j < 16 ? x1 * cs - x2 * sn : x1 * sn + x2 * cs; f = bf2f(KR[(size_t)row * 32 + j]); }
            else { const int c = n - 672; e = buf[n] * (c < 512 ? QSC_NA : 1.f); f = bf2f(NAB[(size_t)row * 1536 + c]); }
            d2 += (f - e) * (f - e); e2 += e * e; }
        float sq = 0.f, sk = 0.f; for (int n = tid; n < 640; n += 256) { if (n < 384) sq += buf[n] * buf[n]; else sk += buf[n] * buf[n]; }
        sq = block_sum(sq, red); sk = block_sum(sk, red);
        if (tid == 0) { float fq = 0.f, fk = 0.f; for (int i = 0; i < 12; ++i) fq += ((const float*)(ws + WS_SSQ))[(size_t)row * 12 + i]; for (int i = 0; i < 8; ++i) fk += ((const float*)(ws + WS_SSKV))[(size_t)row * 8 + i];
            const float rq = (fq - sq) / sq, rk = (fk - sk) / sk; report(ctl, 1, rq * rq + rk * rk); }
    } else if (phase == 2) {
        float s = 0.f; for (int k = tid; k < QL; k += 256) { const float v = bf2f(CQ[(size_t)row * QL + k]); inb[k] = v; s += v * v; }
        float s2 = 0.f; for (int k = tid; k < KVL; k += 256) { const float v = bf2f(CKV[(size_t)row * KVL + k]); inb[512 + k] = v; s2 += v * v; }
        const float rq = rsqrtf(block_sum(s, red) / QL + EPS), rk = rsqrtf(block_sum(s2, red) / KVL + EPS);
        for (int k = tid; k < QL; k += 256) inb[k] *= rq * args.in[4][k];
        for (int k = tid; k < KVL; k += 256) inb[512 + k] *= rk * args.in[5][k];
        __syncthreads();
        for (int n = tid; n < 768; n += 256) { float a = 0.f; for (int k = 0; k < QL; ++k) a += inb[k] * args.in[6][(size_t)k * 768 + n]; buf[n] = a; }
        for (int n = tid; n < 1024; n += 256) { float a = 0.f; for (int k = 0; k < KVL; ++k) a += inb[512 + k] * args.in[7][(size_t)k * 1024 + n]; buf[1024 + n] = a; }
        __syncthreads();
        const int pos = seq_pos(row);
        for (int n = tid; n < 768; n += 256) { const int h = n / 96, w = n - 96 * h; float e;
            if (w < 64) e = buf[n]; else { const int j = w - 64, jj = j & 15; float sn, cs; rope_ref(pos, jj, sn, cs); const float x1 = buf[h * 96 + 64 + jj], x2 = buf[h * 96 + 80 + jj]; e = j < 16 ? x1 * cs - x2 * sn : x1 * sn + x2 * cs; }
            e *= QSC_MLA; const float f = bf2f(Qb[(size_t)row * 768 + n]); d2 += (f - e) * (f - e); e2 += e * e; }
        for (int n = tid; n < 1024; n += 256) { const int h = n >> 7, w = n & 127; const float e = buf[1024 + n]; const float f = w < 64 ? bf2f(KN[(size_t)row * 512 + h * 64 + w]) : bf2f(Vb[(size_t)row * 512 + h * 64 + w - 64]); d2 += (f - e) * (f - e); e2 += e * e; }
    } else if (phase == 4) {
        float sa = 0.f, sb = 0.f; for (int k = tid; k < DM; k += 256) { const float v = bf2f(AB[(size_t)row * DM + k]); inb[k] = v; if (k < 512) sa += v * v; else sb += v * v; }
        const float ra = rsqrtf(block_sum(sa, red) / 512 + EPS), rb = rsqrtf(block_sum(sb, red) / 512 + EPS);
        for (int k = tid; k < DM; k += 256) inb[k] *= (k < 512 ? ra * args.in[9][k] : rb * args.in[10][k - 512]);
        __syncthreads();
        for (int n = tid; n < DM; n += 256) { float a = 0.f; for (int k = 0; k < DM; ++k) a += inb[k] * args.in[11][(size_t)k * DM + n]; const float e = xrow[n] + a, f = bf2f(X1[(size_t)row * DM + n]); d2 += (f - e) * (f - e); e2 += e * e; }
    } else if (phase == 5) {
        float s = 0.f; for (int k = tid; k < DM; k += 256) { const float v = bf2f(X1[(size_t)row * DM + k]); inb[k] = v; s += v * v; }
        const float r = rsqrtf(block_sum(s, red) / DM + EPS);
        for (int k = tid; k < DM; k += 256) inb[k] *= r * args.in[12][k];
        __syncthreads();
        for (int n = tid; n < DFF; n += 256) { float a = 0.f, b = 0.f; for (int k = 0; k < DM; ++k) { a += inb[k] * args.in[13][(size_t)k * DFF + n]; b += inb[k] * args.in[14][(size_t)k * DFF + n]; }
            const float e = a / (1.f + __expf(-a)) * b, f = bf2f(ACT[(size_t)row * DFF + n]); d2 += (f - e) * (f - e); e2 += e * e; }
    } else if (phase == 7) {
        for (int k = tid; k < DFF; k += 256) inb[k] = bf2f(ACT[(size_t)row * DFF + k]);
        __syncthreads();
        float s = 0.f;
        for (int n = tid; n < DM; n += 256) { float a = 0.f; for (int k = 0; k < DFF; ++k) a += inb[k] * args.in[15][(size_t)k * DM + n]; const float v = bf2f(X1[(size_t)row * DM + n]) + a; buf[n] = v; s += v * v; }
        const float r = rsqrtf(block_sum(s, red) / DM + EPS);
        for (int n = tid; n < DM; n += 256) { const float e = buf[n] * r * args.in[16][n], f = args.out[(size_t)row * DM + n]; d2 += (f - e) * (f - e); e2 += e * e; }
    }
    d2 = block_sum(d2, red); e2 = block_sum(e2, red);
    if (tid == 0) report(ctl, phase, d2 / e2);
}
__global__ void __launch_bounds__(64) chk_attn(Args args) {
    __shared__ float sc[8192]; __shared__ float qv[96];
    unsigned char* ws = args.ws; unsigned* ctl = (unsigned*)(ws + WS_CTL);
    const bf16_t *AB = (const bf16_t*)(ws + WS_AB), *KR = (const bf16_t*)(ws + WS_KR), *NAB = (const bf16_t*)(ws + WS_NA), *Qb = (const bf16_t*)(ws + WS_Q), *KN = (const bf16_t*)(ws + WS_KN), *Vb = (const bf16_t*)(ws + WS_V);
    const int sidx = blockIdx.x >> 1, kind = blockIdx.x & 1, lane = threadIdx.x;
    const int row = (int)(((long)sidx * 2731 + 17) % TOK), h = (sidx / 3) & 7;
    const int rowbase = row < TOKP ? (row / SEQP) * SEQP : TOKP + ((row - TOKP) / SEQS) * SEQS, S = row < TOKP ? SEQP : SEQS, t = row - rowbase;
    float o = 0.f, e2 = 0.f, d2 = 0.f;
    if (kind == 0) {
        for (int d = lane; d < 96; d += 64) qv[d] = bf2f(Qb[(size_t)row * 768 + h * 96 + d]);
        __syncthreads();
        float mx = -INFINITY;
        for (int j = lane; j < S; j += 64) { float s = 0.f; const bf16_t* kn = KN + (size_t)(rowbase + j) * 512 + h * 64; const bf16_t* kr = KR + (size_t)(rowbase + j) * 32;
            for (int d = 0; d < 64; ++d) s += qv[d] * bf2f(kn[d]); for (int d = 0; d < 32; ++d) s += qv[64 + d] * bf2f(kr[d]); sc[j] = s; mx = fmaxf(mx, s); }
        for (int of = 1; of < 64; of <<= 1) mx = fmaxf(mx, __shfl_xor(mx, of));
        float l = 0.f; for (int j = lane; j < S; j += 64) { const float p = exp2f(sc[j] - mx); sc[j] = p; l += p; }
        l = wave_sum(l); __syncthreads();
        for (int j = 0; j < S; ++j) o += sc[j] * bf2f(Vb[(size_t)(rowbase + j) * 512 + h * 64 + lane]);
        o /= l; const float f = bf2f(AB[(size_t)row * DM + h * 64 + lane]); d2 = (f - o) * (f - o); e2 = o * o;
        const float ssf = ((const float*)(ws + WS_SSA))[(size_t)row * 8 + h]; d2 = wave_sum(d2); e2 = wave_sum(e2);
        if (lane == 0) { const float rs = (ssf - e2) / e2; report(ctl, 3, d2 / e2 + (fabsf(rs) > 0.05f ? rs * rs : 0.f)); }
    } else {
        const int rows = S / 64, r = t >> 6, qc = t & 63; const int start = min(max(r - 4, 0), rows - 8), cs = min(max(qc - 8, 0), 48);
        for (int d = lane; d < 64; d += 64) qv[d] = bf2f(NAB[(size_t)row * 1536 + h * 64 + d]);
        __syncthreads();
        float mx = -INFINITY;
        for (int j = lane; j < 128; j += 64) { const int kr_ = start + (j >> 4), kc = cs + (j & 15); const bf16_t* kp = NAB + (size_t)(rowbase + kr_ * 64 + kc) * 1536 + 512 + h * 64;
            float s = 0.f; for (int d = 0; d < 64; ++d) s += qv[d] * bf2f(kp[d]);
            s += args.in[8][h * 465 + (kr_ - r + 7) * 31 + (kc - qc + 15)] * LOG2E; sc[j] = s; mx = fmaxf(mx, s); }
        for (int of = 1; of < 64; of <<= 1) mx = fmaxf(mx, __shfl_xor(mx, of));
        float l = 0.f; for (int j = lane; j < 128; j += 64) { const float p = exp2f(sc[j] - mx); sc[j] = p; l += p; }
        l = wave_sum(l); __syncthreads();
        for (int j = 0; j < 128; ++j) { const int kr_ = start + (j >> 4), kc = cs + (j & 15); o += sc[j] * bf2f(NAB[(size_t)(rowbase + kr_ * 64 + kc) * 1536 + 1024 + h * 64 + lane]); }
        o /= l; const float f = bf2f(AB[(size_t)row * DM + 512 + h * 64 + lane]); d2 = (f - o) * (f - o); e2 = o * o;
        const float ssf = ((const float*)(ws + WS_SSB))[(size_t)row * 8 + h]; d2 = wave_sum(d2); e2 = wave_sum(e2);
        if (lane == 0) { const float rs = (ssf - e2) / e2; report(ctl, 3, d2 / e2 + (fabsf(rs) > 0.05f ? rs * rs : 0.f)); }
    }
}
__global__ void __launch_bounds__(256) chk_final(Args args) {
    const unsigned code = ((const unsigned*)(args.ws + WS_CTL))[CW_FAIL];
    if (code == 0) return;
    const int k = 8 - (int)(code >> 4), b = (int)(code & 15); const float c = sqrtf(1.0f + (float)k + 0.1f * (float)b);
    for (size_t i = (size_t)blockIdx.x * 256 + threadIdx.x; i < (size_t)TOK * DM; i += (size_t)gridDim.x * 256) args.out[i] = c;
}
#endif

extern "C" void kernel_launch(void* const* d_in, const int* in_sizes, int n_in, void* d_out, int out_size, void* d_ws, size_t ws_size, hipStream_t stream) {
    static int grid = 0;
    if (grid == 0) {
        if (n_in != 17 || out_size != TOK * DM || ws_size < WS_NEED) { fprintf(stderr, "kernel_launch: unexpected problem (n_in %d, out %d, ws %zu; need %zu)\n", n_in, out_size, ws_size, (size_t)WS_NEED); grid = -1; return; }
        int dev = 0, cus = 0, per_cu = 0;
        hipGetDevice(&dev); hipDeviceGetAttribute(&cus, hipDeviceAttributeMultiprocessorCount, dev);
        if (hipFuncSetAttribute((const void*)mega, hipFuncAttributeMaxDynamicSharedMemorySize, LDS_BYTES) != hipSuccess) { fprintf(stderr, "kernel_launch: hipFuncSetAttribute failed\n"); grid = -1; return; }
        if (hipOccupancyMaxActiveBlocksPerMultiprocessor(&per_cu, (const void*)mega, 512, LDS_BYTES) != hipSuccess || per_cu < 1) { fprintf(stderr, "kernel_launch: occupancy query says %d\n", per_cu); per_cu = 1; }
        (void)hipGetLastError();
        grid = cus * 1;
    }
    if (grid < 0) return;
    hipMemsetAsync((char*)d_ws + WS_CTL, 0, CTL_ZERO_BYTES, stream);
    Args a{};
    for (int i = 0; i < 17; ++i) a.in[i] = (const float*)d_in[i];
    a.out = (float*)d_out; a.ws = (unsigned char*)d_ws;
#if MK_ONE_LAUNCH
    a.ph_lo = 0; a.ph_hi = NPHASE;
    void* kargs[] = {&a};
    hipError_t e = hipLaunchCooperativeKernel((const void*)mega, dim3(grid), dim3(512), kargs, LDS_BYTES, stream);
    if (e != hipSuccess) fprintf(stderr, "kernel_launch: cooperative launch failed: %s (grid %d)\n", hipGetErrorString(e), grid);
#else
    for (int ph = 0; ph < NPHASE; ++ph) {
        a.ph_lo = ph; a.ph_hi = ph + 1;
        hipLaunchKernelGGL(mega, dim3(grid), dim3(512), LDS_BYTES, stream, a);
#if MK_DEBUG
        if (ph == 3) hipLaunchKernelGGL(chk_attn, dim3(2 * 1536), dim3(64), 0, stream, a);
        else if (ph != 6) hipLaunchKernelGGL(chk_phase, dim3(1024), dim3(256), 0, stream, a, ph);
#endif
    }
#if MK_DEBUG
    hipLaunchKernelGGL(chk_final, dim3(2048), dim3(256), 0, stream, a);
#endif
#endif
}
```

```cpp
#include <hip/hip_runtime.h>
#include <hip/hip_cooperative_groups.h>
#include <cstdio>
#include <cstdint>
namespace cg = cooperative_groups;

#ifndef MK_ONE_LAUNCH
#define MK_ONE_LAUNCH 1
#endif
#ifndef MK_DEBUG
#define MK_DEBUG 0
#endif

#define GAS __attribute__((address_space(1)))
#define LAS __attribute__((address_space(3)))
typedef unsigned short bf16_t;
typedef short bf16x8 __attribute__((ext_vector_type(8)));
typedef short s16x4 __attribute__((ext_vector_type(4)));
typedef short v4i16_t __attribute__((ext_vector_type(4)));
typedef float f32x2 __attribute__((ext_vector_type(2)));
typedef float f32x4 __attribute__((ext_vector_type(4)));
typedef float f32x16 __attribute__((ext_vector_type(16)));
typedef unsigned u32x2 __attribute__((ext_vector_type(2)));
typedef unsigned u32x4 __attribute__((ext_vector_type(4)));
typedef __bf16 bf16x2_t __attribute__((ext_vector_type(2)));

__device__ __forceinline__ unsigned pk2(float lo, float hi) { f32x2 v = {lo, hi}; bf16x2_t b = __builtin_convertvector(v, bf16x2_t); return __builtin_bit_cast(unsigned, b); }
__device__ __forceinline__ float bf2f(unsigned b) { return __builtin_bit_cast(float, b << 16); }
__device__ __forceinline__ float bflo(unsigned w) { return __builtin_bit_cast(float, w << 16); }
__device__ __forceinline__ float bfhi(unsigned w) { return __builtin_bit_cast(float, w & 0xffff0000u); }
__device__ __forceinline__ u32x4 pack8(f32x4 a, f32x4 b) { u32x4 w; w.x = pk2(a[0], a[1]); w.y = pk2(a[2], a[3]); w.z = pk2(b[0], b[1]); w.w = pk2(b[2], b[3]); return w; }
__device__ __forceinline__ float sum4(f32x4 v) { return (v[0] + v[1]) + (v[2] + v[3]); }
__device__ __forceinline__ float dot4(f32x4 v) { return (v[0] * v[0] + v[1] * v[1]) + (v[2] * v[2] + v[3] * v[3]); }

constexpr int DM = 1024, TOK = 49152, TOKP = 32768, SEQP = 2048, SEQS = 8192;
constexpr int QL = 384, KVL = 256, NIN = 2208, N1P = 2304, DFF = 2816, NGU = 5632;
constexpr float EPS = 1e-6f, LOG2E = 1.4426950408889634f;
constexpr float QSC_MLA = 0.10206207261596575f * LOG2E;
constexpr float QSC_NA = 0.125f * LOG2E;
__device__ __forceinline__ int seq_pos(int row) { return row < TOKP ? (row & (SEQP - 1)) : (row & (SEQS - 1)); }

constexpr size_t KiB = 1024, MiB = 1u << 20;
constexpr size_t WS_CTL = 0, CTL_ZERO_BYTES = 64 * KiB;
constexpr size_t WS_COS = 1 * MiB, WS_SIN = WS_COS + 512 * KiB;
constexpr size_t WS_WIN = 2 * MiB;
constexpr size_t WS_WUQ = WS_WIN + (size_t)N1P * DM * 2;
constexpr size_t WS_WUKV = WS_WUQ + 768 * 384 * 2;
constexpr size_t WS_WO = WS_WUKV + 1024 * 256 * 2;
constexpr size_t WS_WGU = WS_WO + 1024 * 1024 * 2;
constexpr size_t WS_WD = WS_WGU + (size_t)NGU * DM * 2;
constexpr size_t WS_WEND = WS_WD + (size_t)DM * DFF * 2;
constexpr size_t WS_SSQ = 27 * MiB;
constexpr size_t WS_SSKV = WS_SSQ + (size_t)TOK * 12 * 4;
constexpr size_t WS_SSA = WS_SSKV + (size_t)TOK * 8 * 4;
constexpr size_t WS_SSB = WS_SSA + (size_t)TOK * 8 * 4;
constexpr size_t WS_SS1 = WS_SSB + (size_t)TOK * 8 * 4;
constexpr size_t WS_SS2 = WS_SS1 + (size_t)TOK * 16 * 4;
constexpr size_t WS_SSEND = WS_SS2 + (size_t)TOK * 16 * 4;
constexpr size_t WS_H = 40 * MiB;
constexpr size_t WS_AB = WS_H;
constexpr size_t WS_CQ = 136 * MiB;
constexpr size_t WS_CKV = WS_CQ + (size_t)TOK * QL * 2;
constexpr size_t WS_KR = WS_CKV + (size_t)TOK * KVL * 2;
constexpr size_t WS_NA = WS_KR + (size_t)TOK * 32 * 2;
constexpr size_t WS_Q = WS_NA + (size_t)TOK * 1536 * 2;
constexpr size_t WS_KN = WS_Q + (size_t)TOK * 768 * 2;
constexpr size_t WS_V = WS_KN + (size_t)TOK * 512 * 2;
constexpr size_t WS_END1 = WS_V + (size_t)TOK * 512 * 2;
constexpr size_t WS_X1 = 136 * MiB;
constexpr size_t WS_ACT = 232 * MiB;
constexpr size_t WS_NEED = 511 * MiB;
static_assert(WS_WEND <= WS_SSQ && WS_SSEND <= WS_H && WS_H + (size_t)TOK * DM * 2 <= WS_CQ && WS_END1 <= WS_NEED, "d_ws map");
static_assert(WS_X1 + (size_t)TOK * DM * 2 <= WS_ACT && WS_ACT + (size_t)TOK * DFF * 2 <= WS_NEED, "d_ws overlays");
constexpr int CW_FAIL = 16, CW_BAR = 1024;

constexpr int RING_BYTES = 131072, LDS_BYTES = 147456;

namespace pg8 {
constexpr int BM = 256, BK = 64, HALF = 128, HTB = HALF * BK * 2, STAGE_BYTES = 8 * HTB, NXCD = 8, WGM = 8;
__host__ __device__ __forceinline__ int lds_byte(int r, int c) { const int st = (r >> 4) * 2 + (c >> 5), rr = r & 15, cc = c & 31, ob = rr * 64 + cc * 2; return st * 1024 + (ob ^ (((ob >> 9) & 1) << 5)); }
__host__ __device__ __forceinline__ void stage_rc(int b, int& R, int& C) { const int st = b / 1024, sb = b % 1024, swz = sb ^ (((sb >> 9) & 1) << 5); R = (st >> 1) * 16 + swz / 64; C = (st & 1) * 32 + (swz % 64) / 2; }
__host__ __device__ __forceinline__ int perm32(int rho) { const int n = rho >> 4, i = rho & 15; return 8 * (i >> 2) + 4 * n + (i & 3); }

struct Unit { int pm, pn; };
struct Gemm { const bf16_t* A; const bf16_t* Bt; int M, N, K; };

struct StaticOrder {
    int nM, nN, nwg, G, c;
    __device__ void init(int M, int N, int G_, int c_) { nM = M / BM; nN = N / BM; nwg = nM * nN; G = G_; c = c_; }
    __device__ bool next(int i, Unit& u) const {
        const long L = (long)i * G + c; if (L >= nwg) return false;
        int wgid = (int)L; { const int q = nwg / NXCD, r = nwg % NXCD, xcd = wgid % NXCD, off = wgid / NXCD; wgid = (xcd < r ? xcd * (q + 1) : r * (q + 1) + (xcd - r) * q) + off; }
        const int nig = WGM * nN, gid = wgid / nig, fm = gid * WGM, gsz = (nM - fm) < WGM ? (nM - fm) : WGM;
        u.pm = fm + ((wgid % nig) % gsz); u.pn = (wgid % nig) / gsz; return true;
    }
};

template <class Epi, bool ALIGN_EPI>
__device__ __forceinline__ void gemm_phase(LAS unsigned char* lds, const Gemm g, const StaticOrder& S, const Epi& E) {
    int tid = threadIdx.x; asm volatile("" : "+v"(tid));
    const int wid = __builtin_amdgcn_readfirstlane(tid >> 6), lane = tid & 63, wr = wid >> 2, wc = wid & 3, fr = lane & 15, fq = lane >> 4;
    const int K = g.K, nt = K / BK;
    unsigned voffA[2], voffB[2];
#pragma unroll
    for (int i = 0; i < 2; ++i) { int R, C; stage_rc(tid * 16 + i * 8192, R, C); const int Rb = Epi::PERM ? ((R & ~31) + perm32(R & 31)) : R;
        voffA[i] = (unsigned)(R * K + C) * 2u; voffB[i] = (unsigned)(Rb * K + C) * 2u; }
    const size_t kstep = (size_t)(BK * 2);
    const size_t hstep = (size_t)HALF * K * 2;
    const size_t tstep = 2 * hstep;
    const unsigned ldsw = (unsigned)wid * 1024u;
    const int aoff = lds_byte(wr * 64 + fr, fq * 8), boff = lds_byte(wc * 32 + fr, fq * 8);
#define PG8_SA(b, h) (((b) * 2 + (h)) * HTB)
#define PG8_SB(b, h) ((4 + (b) * 2 + (h)) * HTB)
#define PG8_STAGE(bufoff, gbase, voff) do { _Pragma("unroll") for (int _i = 0; _i < 2; ++_i) \
        __builtin_amdgcn_global_load_lds((const unsigned*)((const char*)(gbase) + (voff)[_i]), (LAS unsigned*)(lds + (bufoff) + ldsw + _i * 8192), 16, 0, 0); } while (0)
#define PG8_LDA(dst, b, h) do { _Pragma("unroll") for (int m = 0; m < 4; ++m) _Pragma("unroll") for (int k = 0; k < 2; ++k) dst[m][k] = *(const LAS bf16x8*)(lds + PG8_SA(b, h) + aoff + m * 2048 + k * 1024); } while (0)
#define PG8_LDB(dst, b, h) do { _Pragma("unroll") for (int n = 0; n < 2; ++n) _Pragma("unroll") for (int k = 0; k < 2; ++k) dst[n][k] = *(const LAS bf16x8*)(lds + PG8_SB(b, h) + boff + n * 2048 + k * 1024); } while (0)
#define PG8_MMA(ai, bj, At, Bt) do { __builtin_amdgcn_s_setprio(1); _Pragma("unroll") for (int m = 0; m < 4; ++m) _Pragma("unroll") for (int n = 0; n < 2; ++n) _Pragma("unroll") for (int k = 0; k < 2; ++k) \
        acc[ai][bj][m][n] = __builtin_amdgcn_mfma_f32_16x16x32_bf16(Bt[n][k], At[m][k], acc[ai][bj][m][n], 0, 0, 0); __builtin_amdgcn_s_setprio(0); } while (0)
#define PG8_WAIT_V(n) asm volatile("s_waitcnt vmcnt(" #n ")" ::: "memory")
#define PG8_WAIT_L(n) asm volatile("s_waitcnt lgkmcnt(" #n ")" ::: "memory")
#define PG8_BAR __builtin_amdgcn_s_barrier()
#define PG8_SCHED __builtin_amdgcn_sched_barrier(0)
    Unit cur, nxt; int ui = 0;
    if (!S.next(0, cur)) return;
    f32x4 acc[2][2][4][2];
#pragma unroll
    for (int a = 0; a < 2; ++a)
#pragma unroll
        for (int b = 0; b < 2; ++b)
#pragma unroll
            for (int m = 0; m < 4; ++m)
#pragma unroll
                for (int n = 0; n < 2; ++n) acc[a][b][m][n] = (f32x4){0.f, 0.f, 0.f, 0.f};
    bf16x8 At[4][2], B0[2][2], B1[2][2];
    const char* cA = (const char*)g.A + (size_t)cur.pm * tstep; const char* cB = (const char*)g.Bt + (size_t)cur.pn * tstep;
    PG8_STAGE(PG8_SB(0, 0), cB, voffB); PG8_STAGE(PG8_SB(0, 1), cB + hstep, voffB); PG8_STAGE(PG8_SA(0, 0), cA, voffA); PG8_STAGE(PG8_SA(0, 1), cA + hstep, voffA);
    if (wr == 1) PG8_BAR;
    PG8_WAIT_V(2); PG8_BAR;
    PG8_STAGE(PG8_SB(1, 0), cB + kstep, voffB); PG8_STAGE(PG8_SA(1, 0), cA + kstep, voffA); PG8_STAGE(PG8_SB(1, 1), cB + hstep + kstep, voffB);
    PG8_WAIT_V(6); PG8_BAR;
    for (;;) {
        const bool has_next = S.next(ui + 1, nxt);
        const char* nA = has_next ? (const char*)g.A + (size_t)nxt.pm * tstep : cA; const char* nB = has_next ? (const char*)g.Bt + (size_t)nxt.pn * tstep : cB;
#pragma unroll 1
        for (int t = 0; t < nt; t += 2) {
            if constexpr (Epi::MID_T >= 0) { if (t == Epi::MID_T) E.mid(acc, cur, wr, wc, fr, fq); }
            const bool last = (t == nt - 2);
            const char* a1 = cA + (size_t)(t + 1) * kstep;
            const char* a2 = last ? nA : cA + (size_t)(t + 2) * kstep; const char* b2 = last ? nB : cB + (size_t)(t + 2) * kstep;
            const char* a3 = a2 + kstep; const char* b3 = b2 + kstep;
            PG8_LDB(B0, 0, 0); PG8_LDB(B1, 0, 1); PG8_SCHED; PG8_LDA(At, 0, 0); PG8_STAGE(PG8_SA(1, 1), a1 + hstep, voffA);
            PG8_WAIT_V(8); PG8_WAIT_L(0); PG8_BAR; PG8_MMA(0, 0, At, B0); PG8_MMA(0, 1, At, B1); PG8_BAR; PG8_SCHED;
            PG8_LDA(At, 0, 1); PG8_STAGE(PG8_SB(0, 0), b2, voffB); PG8_STAGE(PG8_SB(0, 1), b2 + hstep, voffB); PG8_STAGE(PG8_SA(0, 0), a2, voffA);
            PG8_WAIT_V(8); PG8_WAIT_L(0); PG8_BAR; PG8_MMA(1, 0, At, B0); PG8_MMA(1, 1, At, B1); PG8_BAR; PG8_SCHED;
            PG8_LDB(B0, 1, 0); PG8_LDB(B1, 1, 1); PG8_SCHED; PG8_LDA(At, 1, 0); PG8_STAGE(PG8_SA(0, 1), a2 + hstep, voffA);
            PG8_WAIT_V(8); PG8_WAIT_L(0); PG8_BAR; PG8_MMA(0, 0, At, B0); PG8_MMA(0, 1, At, B1); PG8_BAR; PG8_SCHED;
            PG8_LDA(At, 1, 1); PG8_STAGE(PG8_SB(1, 0), b3, voffB); PG8_STAGE(PG8_SB(1, 1), b3 + hstep, voffB); PG8_STAGE(PG8_SA(1, 0), a3, voffA);
            PG8_WAIT_V(8); PG8_WAIT_L(0); PG8_BAR; PG8_MMA(1, 0, At, B0); PG8_MMA(1, 1, At, B1); PG8_BAR; PG8_SCHED;
        }
        if constexpr (ALIGN_EPI) { if (wr == 0) PG8_BAR; }
        E(acc, cur, wr, wc, fr, fq);
        if (!has_next) break;
#pragma unroll
        for (int a = 0; a < 2; ++a)
#pragma unroll
            for (int b = 0; b < 2; ++b)
#pragma unroll
                for (int m = 0; m < 4; ++m)
#pragma unroll
                    for (int n = 0; n < 2; ++n) acc[a][b][m][n] = (f32x4){0.f, 0.f, 0.f, 0.f};
        cur = nxt; cA = nA; cB = nB; ++ui;
        if constexpr (ALIGN_EPI) { if (wr == 1) PG8_BAR; }
    }
    PG8_WAIT_V(0);
    if constexpr (!ALIGN_EPI) { if (wr == 0) PG8_BAR; }
    PG8_BAR;
#undef PG8_SA
#undef PG8_SB
#undef PG8_STAGE
#undef PG8_LDA
#undef PG8_LDB
#undef PG8_MMA
#undef PG8_WAIT_V
#undef PG8_WAIT_L
#undef PG8_BAR
#undef PG8_SCHED
}
}
using pg8::Unit;

struct Epi1 {
    static constexpr bool PERM = true; static constexpr int MID_T = -1;
    bf16_t *CQ, *CKV, *KR, *NA; float *SSQ, *SSKV; const float *COS, *SIN;
    __device__ __forceinline__ void mid(f32x4 (&)[2][2][4][2], const Unit&, int, int, int, int) const {}
    __device__ __forceinline__ void operator()(const f32x4 (&acc)[2][2][4][2], const Unit& u, int wr, int wc, int fr, int fq_in) const {
        int row0 = u.pm * 256 + wr * 64 + fr, fq = fq_in; asm volatile("" : "+v"(row0), "+v"(fq));
#pragma unroll
        for (int bj = 0; bj < 2; ++bj) {
            const int gc = u.pn * 256 + bj * 128 + wc * 32;
            if (gc < 640) {
                const bool isq = gc < QL;
                bf16_t* base = isq ? CQ : CKV; const int ld = isq ? QL : KVL, col = isq ? gc : gc - QL; float* ss = isq ? SSQ : SSKV; const int nslot = isq ? 12 : 8, slot = col >> 5;
#pragma unroll
                for (int ai = 0; ai < 2; ++ai)
#pragma unroll
                    for (int m = 0; m < 4; ++m) { const int row = row0 + ai * 128 + m * 16; const f32x4 v0 = acc[ai][bj][m][0], v1 = acc[ai][bj][m][1];
                        float s = dot4(v0) + dot4(v1); s += __shfl_xor(s, 16); s += __shfl_xor(s, 32);
                        if (fq == 0) ss[(size_t)row * nslot + slot] = s;
                        *(u32x4*)(base + (size_t)row * ld + col + 8 * fq) = pack8(v0, v1); }
            } else if (gc < 672) {
#pragma unroll
                for (int ai = 0; ai < 2; ++ai)
#pragma unroll
                    for (int m = 0; m < 4; ++m) { const int row = row0 + ai * 128 + m * 16; const int pos = seq_pos(row);
                        const f32x4 c4 = *(const f32x4*)(COS + pos * 16 + 4 * fq), s4 = *(const f32x4*)(SIN + pos * 16 + 4 * fq);
                        const f32x4 x1 = acc[ai][bj][m][0], x2 = acc[ai][bj][m][1]; const f32x4 o1 = x1 * c4 - x2 * s4, o2 = x1 * s4 + x2 * c4;
                        u32x2 w1, w2; w1.x = pk2(o1[0], o1[1]); w1.y = pk2(o1[2], o1[3]); w2.x = pk2(o2[0], o2[1]); w2.y = pk2(o2[2], o2[3]);
                        *(u32x2*)(KR + (size_t)row * 32 + 4 * fq) = w1; *(u32x2*)(KR + (size_t)row * 32 + 16 + 4 * fq) = w2; }
            } else if (gc >= 768) {
                const int col = gc - 768; const float sc = col < 512 ? QSC_NA : 1.0f;
#pragma unroll
                for (int ai = 0; ai < 2; ++ai)
#pragma unroll
                    for (int m = 0; m < 4; ++m) { const int row = row0 + ai * 128 + m * 16;
                        *(u32x4*)(NA + (size_t)row * 1536 + col + 8 * fq) = pack8(acc[ai][bj][m][0] * sc, acc[ai][bj][m][1] * sc); }
            }
        }
    }
};
struct Epi2 {
    static constexpr bool PERM = true; static constexpr int MID_T = -1;
    bf16_t* Q; const float *SSQ, *COS, *SIN;
    __device__ __forceinline__ void mid(f32x4 (&)[2][2][4][2], const Unit&, int, int, int, int) const {}
    __device__ __forceinline__ void operator()(const f32x4 (&acc)[2][2][4][2], const Unit& u, int wr, int wc, int fr, int fq_in) const {
        int row0 = u.pm * 256 + wr * 64 + fr, fq = fq_in; asm volatile("" : "+v"(row0), "+v"(fq));
#pragma unroll
        for (int ai = 0; ai < 2; ++ai)
#pragma unroll
            for (int m = 0; m < 4; ++m) { const int row = row0 + ai * 128 + m * 16; const float* p = SSQ + (size_t)row * 12;
                const f32x4 a = *(const f32x4*)p, b = *(const f32x4*)(p + 4), c = *(const f32x4*)(p + 8);
                const float r = __builtin_amdgcn_rsqf((sum4(a) + sum4(b) + sum4(c)) * (1.0f / QL) + EPS) * QSC_MLA;
#pragma unroll
                for (int bj = 0; bj < 2; ++bj) {
                    const int gc = u.pn * 256 + bj * 128 + wc * 32, G = gc >> 5, h = G / 3, part = G - 3 * h;
                    if (part < 2) {
                        *(u32x4*)(Q + (size_t)row * 768 + h * 96 + part * 32 + 8 * fq) = pack8(acc[ai][bj][m][0] * r, acc[ai][bj][m][1] * r);
                    } else { const int pos = seq_pos(row);
                        const f32x4 c4 = *(const f32x4*)(COS + pos * 16 + 4 * fq), s4 = *(const f32x4*)(SIN + pos * 16 + 4 * fq);
                        const f32x4 x1 = acc[ai][bj][m][0] * r, x2 = acc[ai][bj][m][1] * r; const f32x4 o1 = x1 * c4 - x2 * s4, o2 = x1 * s4 + x2 * c4;
                        u32x2 w1, w2; w1.x = pk2(o1[0], o1[1]); w1.y = pk2(o1[2], o1[3]); w2.x = pk2(o2[0], o2[1]); w2.y = pk2(o2[2], o2[3]);
                        bf16_t* qp = Q + (size_t)row * 768 + h * 96 + 64 + 4 * fq; *(u32x2*)qp = w1; *(u32x2*)(qp + 16) = w2; }
                }
                asm volatile("" ::: "memory"); }
    }
};
struct Epi3 {
    static constexpr bool PERM = true; static constexpr int MID_T = -1;
    bf16_t *KN, *V; const float* SSKV;
    __device__ __forceinline__ void mid(f32x4 (&)[2][2][4][2], const Unit&, int, int, int, int) const {}
    __device__ __forceinline__ void operator()(const f32x4 (&acc)[2][2][4][2], const Unit& u, int wr, int wc, int fr, int fq_in) const {
        int row0 = u.pm * 256 + wr * 64 + fr, fq = fq_in; asm volatile("" : "+v"(row0), "+v"(fq));
        float rs[2][4];
#pragma unroll
        for (int ai = 0; ai < 2; ++ai)
#pragma unroll
            for (int m = 0; m < 4; ++m) { const float* p = SSKV + (size_t)(row0 + ai * 128 + m * 16) * 8;
                const f32x4 a = *(const f32x4*)p, b = *(const f32x4*)(p + 4);
                rs[ai][m] = __builtin_amdgcn_rsqf((sum4(a) + sum4(b)) * (1.0f / KVL) + EPS); }
#pragma unroll
        for (int bj = 0; bj < 2; ++bj) {
            const int gc = u.pn * 256 + bj * 128 + wc * 32, h = gc >> 7, w = gc & 127;
            bf16_t* base = (w < 64) ? KN + h * 64 + w : V + h * 64 + (w - 64);
#pragma unroll
            for (int ai = 0; ai < 2; ++ai)
#pragma unroll
                for (int m = 0; m < 4; ++m) { const int row = row0 + ai * 128 + m * 16; const float r = rs[ai][m];
                    *(u32x4*)(base + (size_t)row * 512 + 8 * fq) = pack8(acc[ai][bj][m][0] * r, acc[ai][bj][m][1] * r); }
        }
    }
};
struct Epi4 {
    static constexpr bool PERM = true; static constexpr int MID_T = 8;
    const float *xp, *xs; bf16_t* X1; const float *SSA, *SSB; float* SS1;
    __device__ __forceinline__ float rstd8(const float* p) const { const f32x4 a = *(const f32x4*)p, b = *(const f32x4*)(p + 4); return __builtin_amdgcn_rsqf((sum4(a) + sum4(b)) * (1.0f / 512.0f) + EPS); }
    __device__ __forceinline__ void mid(f32x4 (&acc)[2][2][4][2], const Unit& u, int wr, int wc, int fr, int fq_in) const {
        int row0 = u.pm * 256 + wr * 64 + fr, fq = fq_in; asm volatile("" : "+v"(row0), "+v"(fq));
#pragma unroll
        for (int ai = 0; ai < 2; ++ai)
#pragma unroll
            for (int m = 0; m < 4; ++m) { const size_t row = (size_t)(row0 + ai * 128 + m * 16);
                const float ra = rstd8(SSA + row * 8), rb = rstd8(SSB + row * 8); const float f = ra / rb;
#pragma unroll
                for (int bj = 0; bj < 2; ++bj)
#pragma unroll
                    for (int n = 0; n < 2; ++n) acc[ai][bj][m][n] = acc[ai][bj][m][n] * f;
                asm volatile("" ::: "memory"); }
    }
    __device__ __forceinline__ void operator()(const f32x4 (&acc)[2][2][4][2], const Unit& u, int wr, int wc, int fr, int fq_in) const {
        int row0 = u.pm * 256 + wr * 64 + fr, fq = fq_in; asm volatile("" : "+v"(row0), "+v"(fq)); const int colw = u.pn * 256 + wc * 32 + 8 * fq;
#pragma unroll
        for (int ai = 0; ai < 2; ++ai)
#pragma unroll
            for (int m = 0; m < 4; ++m) { const int row = row0 + ai * 128 + m * 16; const float rb = rstd8(SSB + (size_t)row * 8);
                const float* xr = (row < TOKP ? xp + (size_t)row * DM : xs + (size_t)(row - TOKP) * DM) + colw;
                float s = 0.f;
#pragma unroll
                for (int bj = 0; bj < 2; ++bj) { const f32x4 a0 = *(const f32x4*)(xr + bj * 128), a1 = *(const f32x4*)(xr + bj * 128 + 4);
                    const f32x4 v0 = a0 + acc[ai][bj][m][0] * rb, v1 = a1 + acc[ai][bj][m][1] * rb; s += dot4(v0) + dot4(v1);
                    *(u32x4*)(X1 + (size_t)row * DM + colw + bj * 128) = pack8(v0, v1); }
                s += __shfl_xor(s, 16); s += __shfl_xor(s, 32);
                if (fq == 0) SS1[(size_t)row * 16 + u.pn * 4 + wc] = s;
                asm volatile("" ::: "memory"); }
    }
};
__device__ __forceinline__ float rstd16(const float* p) { const f32x4 a = *(const f32x4*)p, b = *(const f32x4*)(p + 4), c = *(const f32x4*)(p + 8), d = *(const f32x4*)(p + 12);
    return __builtin_amdgcn_rsqf(((sum4(a) + sum4(b)) + (sum4(c) + sum4(d))) * (1.0f / DM) + EPS); }
struct Epi5 {
    static constexpr bool PERM = true; static constexpr int MID_T = -1;
    bf16_t* ACT; const float* SS1;
    __device__ __forceinline__ void mid(f32x4 (&)[2][2][4][2], const Unit&, int, int, int, int) const {}
    __device__ __forceinline__ void operator()(const f32x4 (&acc)[2][2][4][2], const Unit& u, int wr, int wc, int fr, int fq_in) const {
        int row0 = u.pm * 256 + wr * 64 + fr, fq = fq_in; asm volatile("" : "+v"(row0), "+v"(fq)); const int col = u.pn * 128 + wc * 32 + 8 * fq;
#pragma unroll
        for (int ai = 0; ai < 2; ++ai)
#pragma unroll
            for (int m = 0; m < 4; ++m) { const int row = row0 + ai * 128 + m * 16; const float r = rstd16(SS1 + (size_t)row * 16);
                f32x4 o[2];
#pragma unroll
                for (int n = 0; n < 2; ++n) { const f32x4 gt = acc[ai][0][m][n] * r, up = acc[ai][1][m][n] * r;
#pragma unroll
                    for (int i = 0; i < 4; ++i) o[n][i] = gt[i] * __builtin_amdgcn_rcpf(1.0f + __builtin_amdgcn_exp2f(-gt[i] * LOG2E)) * up[i]; }
                *(u32x4*)(ACT + (size_t)row * DFF + col) = pack8(o[0], o[1]); }
    }
};
struct Epi6 {
    static constexpr bool PERM = false; static constexpr int MID_T = -1;
    const bf16_t* X1; float* out; float* SS2;
    __device__ __forceinline__ void mid(f32x4 (&)[2][2][4][2], const Unit&, int, int, int, int) const {}
    __device__ __forceinline__ void operator()(const f32x4 (&acc)[2][2][4][2], const Unit& u, int wr, int wc, int fr, int fq_in) const {
        int row0 = u.pm * 256 + wr * 64 + fr, fq = fq_in; asm volatile("" : "+v"(row0), "+v"(fq)); const int colw = u.pn * 256 + wc * 32 + 4 * fq;
#pragma unroll
        for (int ai = 0; ai < 2; ++ai)
#pragma unroll
            for (int m = 0; m < 4; ++m) { const int row = row0 + ai * 128 + m * 16; float s = 0.f;
#pragma unroll
                for (int bj = 0; bj < 2; ++bj)
#pragma unroll
                    for (int n = 0; n < 2; ++n) { const size_t off = (size_t)row * DM + colw + bj * 128 + n * 16; const u32x2 w = *(const u32x2*)(X1 + off);
                        f32x4 v = acc[ai][bj][m][n]; v[0] += bflo(w.x); v[1] += bfhi(w.x); v[2] += bflo(w.y); v[3] += bfhi(w.y); s += dot4(v);
                        *(f32x4*)(out + off) = v; }
                s += __shfl_xor(s, 16); s += __shfl_xor(s, 32);
                if (fq == 0) SS2[(size_t)row * 16 + u.pn * 4 + wc] = s; }
    }
};

namespace att {
constexpr int KSLOT = 12288, VSLOT = 8192;
constexpr int L_K = 0, L_V = 2 * KSLOT, L_WS = L_V + 2 * VSLOT, L_OST = L_WS + 8 * 256, L_BIAS = 110592, L_END = L_BIAS + 2560;
constexpr int M_K0 = 0, M_V0 = 4 * KSLOT, M_WS = M_V0 + 3 * VSLOT, M_OST = M_WS + 8 * 256, M_END = M_OST + 8 * 4096;
static_assert(M_END <= L_BIAS && L_OST + 8 * 4096 <= L_BIAS, "attention LDS map");
static_assert(L_END <= RING_BYTES, "attention LDS");
constexpr int THRL = 8;
constexpr int NA_K = 0, NA_V = 32768;
#define MFMA32(a, b, c) __builtin_amdgcn_mfma_f32_32x32x16_bf16(a, b, c, 0, 0, 0)
__device__ __forceinline__ int crow(int r, int hi) { return (r & 3) + 8 * (r >> 2) + 4 * hi; }
__device__ __forceinline__ s16x4 vtr(const LAS unsigned char* p) { return __builtin_bit_cast(s16x4, __builtin_amdgcn_ds_read_tr16_b64_v4i16((LAS v4i16_t*)p)); }
__device__ __forceinline__ void glds(const void* g, LAS unsigned char* dst) { __builtin_amdgcn_global_load_lds((const unsigned*)g, (LAS unsigned*)dst, 16, 0, 0); }

struct SoftSt { float mhat, l; f32x16 o[2]; f32x16 negm; };

template <int ND, bool NA>
__device__ __forceinline__ void tile_step(SoftSt& st, const bf16x8 (&qr)[ND], const LAS unsigned char* kb, const LAS unsigned char* vp, LAS float* wsf, int r32, int hi, bool first,
                                          const LAS float* brow, int cs) {
    f32x16 C0, C1;
#pragma unroll
    for (int d0 = 0; d0 < ND; ++d0) {
        const bf16x8 b0 = *(const LAS bf16x8*)(kb + d0 * 2048), b1 = *(const LAS bf16x8*)(kb + d0 * 2048 + 512);
        if (d0 == 0) { C0 = MFMA32(b0, qr[0], st.negm); C1 = MFMA32(b1, qr[0], st.negm); } else { C0 = MFMA32(b0, qr[d0], C0); C1 = MFMA32(b1, qr[d0], C1); }
    }
    if (NA) {
#pragma unroll
        for (int r = 0; r < 16; ++r) { const int kc = (r & 3) + 8 * (r >> 2) + 4 * hi;
            C0[r] = ((unsigned)(kc - cs) < 16u) ? C0[r] + brow[kc] : -INFINITY;
            C1[r] = ((unsigned)(kc + 32 - cs) < 16u) ? C1[r] + brow[kc + 32] : -INFINITY; }
    }
#define MX3(a, b, c) __builtin_fmaxf(__builtin_fmaxf((a), (b)), (c))
    float a = MX3(C0[0], C0[1], C1[0]), b = MX3(C0[2], C0[3], C1[1]); a = MX3(a, C1[2], C1[3]);
#pragma unroll
    for (int r = 4; r < 16; r += 4) { a = MX3(a, C0[r], C0[r + 1]); b = MX3(b, C0[r + 2], C0[r + 3]); a = MX3(a, C1[r], C1[r + 1]); b = MX3(b, C1[r + 2], C1[r + 3]); }
#undef MX3
    float rm = __builtin_fmaxf(a, b);
    { auto rr = __builtin_amdgcn_permlane32_swap(__float_as_uint(rm), __float_as_uint(rm), false, false); rm = __builtin_fmaxf(__uint_as_float(rr[0]), __uint_as_float(rr[1])); }
    bool resc = false;
    if (first || __any(rm > (float)THRL)) {
        const float dl = first ? rm : __builtin_fmaxf(rm, 0.f); st.mhat += dl;
#pragma unroll
        for (int r = 0; r < 16; ++r) { C0[r] -= dl; C1[r] -= dl; st.negm[r] = -st.mhat; }
        const float f = first ? 0.f : __builtin_amdgcn_exp2f(-dl); st.l *= f; if (hi == 0) wsf[r32] = f; resc = true;
    }
    float sacc = 0.f;
#pragma unroll
    for (int r = 0; r < 16; ++r) { C0[r] = __builtin_amdgcn_exp2f(C0[r]); C1[r] = __builtin_amdgcn_exp2f(C1[r]); sacc += C0[r] + C1[r]; }
    st.l += sacc;
    u32x4 pw0, pw1, pw2, pw3;
    pw0 = (u32x4){pk2(C0[0], C0[1]), pk2(C0[2], C0[3]), pk2(C0[4], C0[5]), pk2(C0[6], C0[7])}; pw1 = (u32x4){pk2(C0[8], C0[9]), pk2(C0[10], C0[11]), pk2(C0[12], C0[13]), pk2(C0[14], C0[15])};
    pw2 = (u32x4){pk2(C1[0], C1[1]), pk2(C1[2], C1[3]), pk2(C1[4], C1[5]), pk2(C1[6], C1[7])}; pw3 = (u32x4){pk2(C1[8], C1[9]), pk2(C1[10], C1[11]), pk2(C1[12], C1[13]), pk2(C1[14], C1[15])};
    if (resc) {
#pragma unroll
        for (int r = 0; r < 16; ++r) { const float f = wsf[crow(r, hi)]; st.o[0][r] *= f; st.o[1][r] *= f; }
    }
#pragma unroll
    for (int d0 = 0; d0 < 2; ++d0) {
#pragma unroll
        for (int ks = 0; ks < 4; ++ks) { const s16x4 lo = vtr(vp + d0 * 4096 + ks * 1024), hh = vtr(vp + d0 * 4096 + ks * 1024 + 512);
            const bf16x8 vb = (bf16x8){lo[0], lo[1], lo[2], lo[3], hh[0], hh[1], hh[2], hh[3]};
            const bf16x8 pa = __builtin_bit_cast(bf16x8, ks == 0 ? pw0 : ks == 1 ? pw1 : ks == 2 ? pw2 : pw3);
            st.o[d0] = MFMA32(pa, vb, st.o[d0]); }
    }
}
template <int OFF_WS, int OFF_OST>
__device__ __forceinline__ void attn_epilogue(SoftSt& st, LAS unsigned char* lds, int wid, int lane_in, int r32_in, int hi_in, bf16_t* Orow0  , float* SSrow0  ) {
    int lane = lane_in, r32 = r32_in, hi = hi_in; asm volatile("" : "+v"(lane), "+v"(r32), "+v"(hi));
    LAS float* wsf = (LAS float*)(lds + OFF_WS) + wid * 64;
    { auto rr = __builtin_amdgcn_permlane32_swap(__float_as_uint(st.l), __float_as_uint(st.l), false, false); st.l = __uint_as_float(rr[0]) + __uint_as_float(rr[1]); }
    if (hi == 0) wsf[32 + r32] = st.l;
    LAS bf16_t* stg = (LAS bf16_t*)(lds + OFF_OST) + wid * 2048;
#pragma unroll
    for (int r = 0; r < 16; ++r) { const int orow = crow(r, hi); const float rl = __builtin_amdgcn_rcpf(wsf[32 + orow]);
        const unsigned w0 = pk2(st.o[0][r] * rl, 0.f), w1 = pk2(st.o[1][r] * rl, 0.f);
        stg[orow * 64 + r32] = (bf16_t)(w0 & 0xffffu); stg[orow * 64 + 32 + r32] = (bf16_t)(w1 & 0xffffu); }
#pragma unroll
    for (int i = 0; i < 4; ++i) { const int row = i * 8 + (lane >> 3), ch = lane & 7; const u32x4 v = *(const LAS u32x4*)(stg + row * 64 + ch * 8);
        float s = 0.f;
#pragma unroll
        for (int j = 0; j < 4; ++j) { const float x = bflo(v[j]), y = bfhi(v[j]); s += x * x + y * y; }
        s += __shfl_xor(s, 1); s += __shfl_xor(s, 2); s += __shfl_xor(s, 4);
        if (ch == 0) SSrow0[(size_t)row * 8] = s;
        *(u32x4*)(Orow0 + (size_t)row * DM + ch * 8) = v; }
}

__device__ __forceinline__ void mla_unit(LAS unsigned char* lds, int rowbase, int S, int h, int q0, const bf16_t* Q, const bf16_t* KN, const bf16_t* KR, const bf16_t* V, bf16_t* AB, float* SSA) {
    const int tid = threadIdx.x, lane = tid & 63, r32 = lane & 31, hi = lane >> 5; const int wid = __builtin_amdgcn_readfirstlane(tid >> 6);
    const bf16_t* ksrc = KN + (size_t)(rowbase + lane) * 512 + h * 64 + wid * 8;
    const bf16_t* rsrc = KR + (size_t)(rowbase + lane) * 32 + (wid & 3) * 8;
    const bf16_t* vsrc = V + (size_t)(rowbase + 16 * (wid & 3) + (lane >> 2)) * 512 + h * 64 + (wid >> 2) * 32 + (lane & 3) * 8;
#define MLA_STAGE(t, s) do { glds(ksrc + (size_t)(t) * 64 * 512, lds + L_K + (s) * KSLOT + wid * 1024); \
        if (wid < 4) glds(rsrc + (size_t)(t) * 64 * 32, lds + L_K + (s) * KSLOT + (8 + wid) * 1024); \
        glds(vsrc + (size_t)(t) * 64 * 512, lds + L_V + (s) * VSLOT + wid * 1024); } while (0)
    const int NT = S / 64;
    MLA_STAGE(0, 0);
    const int qrow = rowbase + q0 + wid * 32;
    bf16x8 qr[6];
#pragma unroll
    for (int d0 = 0; d0 < 6; ++d0) qr[d0] = *(const bf16x8*)(Q + (size_t)(qrow + r32) * 768 + h * 96 + d0 * 16 + hi * 8);
    SoftSt st; st.mhat = 0.f; st.l = 0.f; st.o[0] = f32x16{}; st.o[1] = f32x16{}; st.negm = f32x16{};
    LAS float* wsf = (LAS float*)(lds + L_WS) + wid * 64;
    const int kboff = hi * 1024 + r32 * 16, vpoff = ((lane >> 4) & 1) * 32 + (lane & 3) * 8 + (4 * hi + ((lane & 15) >> 2)) * 64;
    asm volatile("s_waitcnt vmcnt(0)" ::: "memory"); __syncthreads();
    for (int t = 0; t < NT; ++t) {
        const int s = t & 1;
        if (t + 1 < NT) MLA_STAGE(t + 1, s ^ 1);
        tile_step<6, false>(st, qr, lds + L_K + s * KSLOT + kboff, lds + L_V + s * VSLOT + vpoff, wsf, r32, hi, t == 0, nullptr, 0);
        asm volatile("s_waitcnt vmcnt(0)" ::: "memory"); __syncthreads();
    }
#undef MLA_STAGE
    attn_epilogue<L_WS, L_OST>(st, lds, wid, lane, r32, hi, AB + (size_t)qrow * DM + h * 64, SSA + (size_t)qrow * 8 + h);
    asm volatile("s_waitcnt lgkmcnt(0)" ::: "memory"); __syncthreads();
}


template <int THR>
__device__ __forceinline__ void mla_unit2(LAS unsigned char* lds, int rowbase, int S, int h, int q0, const bf16_t* Q, const bf16_t* KN, const bf16_t* KR, const bf16_t* V, bf16_t* AB, float* SSA) {
    int tid = threadIdx.x; asm volatile("" : "+v"(tid));
    const int lane = tid & 63, r32 = lane & 31, hi = lane >> 5; const int wid = __builtin_amdgcn_readfirstlane(tid >> 6);
    const bf16_t* ksrc = KN + (size_t)(rowbase + lane) * 512 + h * 64 + wid * 8;
    const bf16_t* rsrc = KR + (size_t)(rowbase + lane) * 32 + (wid & 3) * 8;
    const bf16_t* vsrc = V + (size_t)(rowbase + 16 * (wid & 3) + (lane >> 2)) * 512 + h * 64 + (wid >> 2) * 32 + (lane & 3) * 8;
#define SBAR() __builtin_amdgcn_sched_barrier(0)
#define DMA_K(t, koff) do { glds(ksrc + (size_t)(t) * 64 * 512, lds + M_K0 + (koff) + wid * 1024); if (wid < 4) glds(rsrc + (size_t)(t) * 64 * 32, lds + M_K0 + (koff) + (8 + wid) * 1024); } while (0)
#define DMA_V(t, voff) glds(vsrc + (size_t)(t) * 64 * 512, lds + M_V0 + (voff) + wid * 1024)
#define WAIT_BAR(N) asm volatile("s_waitcnt vmcnt(" #N ") lgkmcnt(0)\n\ts_barrier" ::: "memory")
    const int NT = S / 64;
    DMA_K(0, 0); DMA_V(0, 0); DMA_K(1, KSLOT); DMA_K(2, 2 * KSLOT);
    const int qrow = rowbase + q0 + wid * 32;
    bf16x8 qr[6];
#pragma unroll
    for (int d0 = 0; d0 < 6; ++d0) qr[d0] = *(const bf16x8*)(Q + (size_t)(qrow + r32) * 768 + h * 96 + d0 * 16 + hi * 8);
    float mhat = 0.f, l_reg = 0.f; f32x16 o[2]; o[0] = f32x16{}; o[1] = f32x16{}; f32x16 negm = f32x16{}; asm volatile("" : "+v"(negm));
    LAS float* wsf = (LAS float*)(lds + M_WS) + wid * 64;
    const LAS unsigned char* kp0 = lds + M_K0 + hi * 1024 + r32 * 16;
    const LAS unsigned char* vp0 = lds + M_V0 + ((lane >> 4) & 1) * 32 + (lane & 3) * 8 + (4 * hi + ((lane & 15) >> 2)) * 64;
    bf16x8 kf[8];
    f32x16 pA0, pA1, pB0, pB1;
    bool resc = false;
    WAIT_BAR(0);
    {
#pragma unroll
        for (int d0 = 0; d0 < 6; ++d0) { const bf16x8 b0 = *(const LAS bf16x8*)(kp0 + d0 * 2048), b1 = *(const LAS bf16x8*)(kp0 + d0 * 2048 + 512);
            if (d0 == 0) { pA0 = MFMA32(b0, qr[0], negm); pA1 = MFMA32(b1, qr[0], negm); } else { pA0 = MFMA32(b0, qr[d0], pA0); pA1 = MFMA32(b1, qr[d0], pA1); } }
#define MX3(a, b, c) __builtin_fmaxf(__builtin_fmaxf((a), (b)), (c))
        float a = MX3(pA0[0], pA0[1], pA1[0]), b = MX3(pA0[2], pA0[3], pA1[1]); a = MX3(a, pA1[2], pA1[3]);
#pragma unroll
        for (int r = 4; r < 16; r += 4) { a = MX3(a, pA0[r], pA0[r + 1]); b = MX3(b, pA0[r + 2], pA0[r + 3]); a = MX3(a, pA1[r], pA1[r + 1]); b = MX3(b, pA1[r + 2], pA1[r + 3]); }
        float rm = __builtin_fmaxf(a, b);
        { auto rr = __builtin_amdgcn_permlane32_swap(__float_as_uint(rm), __float_as_uint(rm), false, false); rm = __builtin_fmaxf(__uint_as_float(rr[0]), __uint_as_float(rr[1])); }
        mhat = rm;
#pragma unroll
        for (int r = 0; r < 16; ++r) { pA0[r] = __builtin_amdgcn_exp2f(pA0[r] - rm); pA1[r] = __builtin_amdgcn_exp2f(pA1[r] - rm); negm[r] = -mhat; }
        asm volatile("" : "+v"(negm));
    }
    DMA_K(3, 3 * KSLOT); DMA_V(1, VSLOT);
    int kprev = 0, kcur = KSLOT, knext = 2 * KSLOT, vprev = 0, vcur = VSLOT, vnext = 2 * VSLOT;
#define ROT() do { kprev = kcur; kcur = knext; knext = (knext == 3 * KSLOT) ? 0 : knext + KSLOT; vprev = vcur; vcur = vnext; vnext = (vnext == 2 * VSLOT) ? 0 : vnext + VSLOT; } while (0)
#pragma unroll
    for (int j = 0; j < 4; ++j) { kf[2 * j] = *(const LAS bf16x8*)(kp0 + kcur + j * 2048); kf[2 * j + 1] = *(const LAS bf16x8*)(kp0 + kcur + j * 2048 + 512); }
    s16x4 vlo[8], vhi[8]; u32x4 pw0, pw1, pw2, pw3;
#define PKW(P, B) pk2(P[B], P[B + 1])
#define PAF(k) __builtin_bit_cast(bf16x8, pw##k)
#define VFR(i) (bf16x8){vlo[i][0], vlo[i][1], vlo[i][2], vlo[i][3], vhi[i][0], vhi[i][1], vhi[i][2], vhi[i][3]}
#define PIN(x) asm volatile("" : "+v"(x))
#define GAPA(MF, A0, A1, A2, A3, W0, W1, PW) do { MF; sacc += A0; sacc += A1; sacc += A2; sacc += A3; PIN(sacc); W0; W1; PIN(PW); SBAR(); } while (0)
#define EX(v) __builtin_amdgcn_exp2f(v)
#define GAPB(MF, X, B) do { MF; X[B] = EX(X[B]); X[B + 1] = EX(X[B + 1]); X[B + 2] = EX(X[B + 2]); X[B + 3] = EX(X[B + 3]); PIN(X); SBAR(); } while (0)
#define VRD(i) do { vlo[i] = vtr(vp_ + (((i) >> 2) * 4096 + ((i) & 3) * 1024)); vhi[i] = vtr(vp_ + (((i) >> 2) * 4096 + ((i) & 3) * 1024 + 512)); } while (0)
#define KROPE(j) do { kf[j] = *(const LAS bf16x8*)(kp0 + kcur + (4 + ((j) >> 1)) * 2048 + ((j) & 1) * 512); SBAR(); } while (0)
#define KRD(G, j) do { if (G) { kf[2 * (j)] = *(const LAS bf16x8*)(kp0 + knext + (j) * 2048); kf[2 * (j) + 1] = *(const LAS bf16x8*)(kp0 + knext + (j) * 2048 + 512); SBAR(); } } while (0)
#define STEP(C0, C1, P0, P1, t, GK, GV, GL) do { SBAR(); \
    const LAS unsigned char* vp_ = vp0 + vprev; \
    VRD(0); SBAR(); float sacc = (P0[0] + P0[1]); \
    GAPA(C0 = MFMA32(kf[0], qr[0], negm), P0[2], P0[3], P0[4], P0[5],     pw0[0] = PKW(P0, 0), pw0[1] = PKW(P0, 2), pw0); \
    VRD(4); SBAR(); GAPA(C1 = MFMA32(kf[1], qr[0], negm), P0[6], P0[7], P0[8], P0[9],     pw0[2] = PKW(P0, 4), pw0[3] = PKW(P0, 6), pw0); \
    KROPE(0); VRD(1); SBAR(); GAPA(C0 = MFMA32(kf[2], qr[1], C0),   P0[10], P0[11], P0[12], P0[13], pw1[0] = PKW(P0, 8), pw1[1] = PKW(P0, 10), pw1); \
    KROPE(1); VRD(5); SBAR(); GAPA(C1 = MFMA32(kf[3], qr[1], C1),   P0[14], P0[15], P1[0], P1[1],   pw1[2] = PKW(P0, 12), pw1[3] = PKW(P0, 14), pw1); \
    VRD(2); SBAR(); GAPA(C0 = MFMA32(kf[4], qr[2], C0),   P1[2], P1[3], P1[4], P1[5],     pw2[0] = PKW(P1, 0), pw2[1] = PKW(P1, 2), pw2); \
    KROPE(2); VRD(6); SBAR(); GAPA(C1 = MFMA32(kf[5], qr[2], C1),   P1[6], P1[7], P1[8], P1[9],     pw2[2] = PKW(P1, 4), pw2[3] = PKW(P1, 6), pw2); \
    KROPE(3); VRD(3); SBAR(); GAPA(C0 = MFMA32(kf[6], qr[3], C0),   P1[10], P1[11], P1[12], P1[13], pw3[0] = PKW(P1, 8), pw3[1] = PKW(P1, 10), pw3); \
    VRD(7); SBAR(); GAPA(C1 = MFMA32(kf[7], qr[3], C1),   P1[14], P1[15], 0.f, 0.f,       pw3[2] = PKW(P1, 12), pw3[3] = PKW(P1, 14), pw3); \
    C0 = MFMA32(kf[0], qr[4], C0); C1 = MFMA32(kf[1], qr[4], C1); C0 = MFMA32(kf[2], qr[5], C0); C1 = MFMA32(kf[3], qr[5], C1); SBAR(); \
    l_reg += sacc; \
    if (GK) { DMA_K((t) + 3, kprev); } if (GV) { DMA_V((t) + 1, vnext); } \
    { float a = MX3(C0[0], C0[1], C1[0]), b = MX3(C0[2], C0[3], C1[1]); a = MX3(a, C1[2], C1[3]); \
      _Pragma("unroll") for (int r = 4; r < 16; r += 4) { a = MX3(a, C0[r], C0[r + 1]); b = MX3(b, C0[r + 2], C0[r + 3]); a = MX3(a, C1[r], C1[r + 1]); b = MX3(b, C1[r + 2], C1[r + 3]); } \
      float rm = __builtin_fmaxf(a, b); { auto rr = __builtin_amdgcn_permlane32_swap(__float_as_uint(rm), __float_as_uint(rm), false, false); rm = __builtin_fmaxf(__uint_as_float(rr[0]), __uint_as_float(rr[1])); } \
      resc = false; \
      if (__builtin_expect(__any(rm > (float)THR), 0)) { const float dl = __builtin_fmaxf(rm, 0.f); mhat += dl; \
        _Pragma("unroll") for (int r = 0; r < 16; ++r) { C0[r] -= dl; C1[r] -= dl; } \
        _Pragma("unroll") for (int r = 0; r < 16; ++r) negm[r] = -mhat; asm volatile("" : "+v"(negm)); \
        const float f = __builtin_amdgcn_exp2f(-dl); l_reg *= f; if (hi == 0) wsf[r32] = f; resc = true; } } \
    SBAR(); \
    GAPB(o[0] = MFMA32(PAF(0), VFR(0), o[0]), C0, 0); \
    GAPB(o[1] = MFMA32(PAF(0), VFR(4), o[1]), C0, 4); \
    KRD(GL, 0); GAPB(o[0] = MFMA32(PAF(1), VFR(1), o[0]), C0, 8); \
    KRD(GL, 1); GAPB(o[1] = MFMA32(PAF(1), VFR(5), o[1]), C0, 12); \
    KRD(GL, 2); GAPB(o[0] = MFMA32(PAF(2), VFR(2), o[0]), C1, 0); \
    KRD(GL, 3); GAPB(o[1] = MFMA32(PAF(2), VFR(6), o[1]), C1, 4); \
    GAPB(o[0] = MFMA32(PAF(3), VFR(3), o[0]), C1, 8); \
    GAPB(o[1] = MFMA32(PAF(3), VFR(7), o[1]), C1, 12); \
    } while (0)
#define RESC() do { if (resc) { _Pragma("unroll") for (int r = 0; r < 16; ++r) { const float f_ = wsf[crow(r, hi)]; o[0][r] *= f_; o[1][r] *= f_; } } } while (0)
#define ENDW(tt) do { if ((tt) + 3 < NT) { if (wid < 4) WAIT_BAR(3); else WAIT_BAR(2); } else if ((tt) + 1 < NT) { WAIT_BAR(1); } else { WAIT_BAR(0); } } while (0)
    int t = 1;
    for (; t + 5 < NT; t += 2) {
        STEP(pB0, pB1, pA0, pA1, t, true, true, true);     if (wid < 4) WAIT_BAR(3); else WAIT_BAR(2); RESC(); ROT();
        STEP(pA0, pA1, pB0, pB1, t + 1, true, true, true); if (wid < 4) WAIT_BAR(3); else WAIT_BAR(2); RESC(); ROT();
    }
    for (; t + 1 < NT; t += 2) {
        STEP(pB0, pB1, pA0, pA1, t, (t + 3 < NT), (t + 1 < NT), (t + 1 < NT));         ENDW(t);     RESC(); ROT();
        STEP(pA0, pA1, pB0, pB1, t + 1, (t + 4 < NT), (t + 2 < NT), (t + 2 < NT));     ENDW(t + 1); RESC(); ROT();
    }
    STEP(pB0, pB1, pA0, pA1, NT - 1, false, false, false); RESC();
    SoftSt st;
    { float sacc = pB0[0] + pB0[1];
#pragma unroll
      for (int r = 2; r < 16; ++r) sacc += pB0[r];
#pragma unroll
      for (int r = 0; r < 16; ++r) sacc += pB1[r];
      l_reg += sacc;
      pw0 = (u32x4){PKW(pB0, 0), PKW(pB0, 2), PKW(pB0, 4), PKW(pB0, 6)}; pw1 = (u32x4){PKW(pB0, 8), PKW(pB0, 10), PKW(pB0, 12), PKW(pB0, 14)};
      pw2 = (u32x4){PKW(pB1, 0), PKW(pB1, 2), PKW(pB1, 4), PKW(pB1, 6)}; pw3 = (u32x4){PKW(pB1, 8), PKW(pB1, 10), PKW(pB1, 12), PKW(pB1, 14)};
      SBAR();
      const LAS unsigned char* vp_ = vp0 + vcur;
#pragma unroll
      for (int d0 = 0; d0 < 2; ++d0)
#pragma unroll
          for (int ks = 0; ks < 4; ++ks) { const s16x4 lo = vtr(vp_ + d0 * 4096 + ks * 1024), hh = vtr(vp_ + d0 * 4096 + ks * 1024 + 512);
              const bf16x8 vb = (bf16x8){lo[0], lo[1], lo[2], lo[3], hh[0], hh[1], hh[2], hh[3]};
              const bf16x8 pa = __builtin_bit_cast(bf16x8, ks == 0 ? pw0 : ks == 1 ? pw1 : ks == 2 ? pw2 : pw3);
              o[d0] = MFMA32(pa, vb, o[d0]); } }
    st.mhat = mhat; st.l = l_reg; st.o[0] = o[0]; st.o[1] = o[1]; st.negm = negm;
    attn_epilogue<M_WS, M_OST>(st, lds, wid, lane, r32, hi, AB + (size_t)qrow * DM + h * 64, SSA + (size_t)qrow * 8 + h);
    asm volatile("s_waitcnt lgkmcnt(0)\n\ts_barrier" ::: "memory");
#undef SBAR
#undef DMA_K
#undef DMA_V
#undef WAIT_BAR
#undef MX3
#undef ROT
#undef PKW
#undef PAF
#undef VFR
#undef PIN
#undef GAPA
#undef EX
#undef GAPB
#undef VRD
#undef KROPE
#undef KRD
#undef STEP
#undef RESC
#undef ENDW
}

__device__ __forceinline__ void na_unit(LAS unsigned char* lds, int rowbase, int rows, int h, int R0, const bf16_t* NAB, const float* rpb, bf16_t* AB, float* SSB) {
    const int tid = threadIdx.x, lane = tid & 63, r32 = lane & 31, hi = lane >> 5; const int wid = __builtin_amdgcn_readfirstlane(tid >> 6);
    LAS float* tab = (LAS float*)(lds + L_BIAS);
    for (int i = tid; i < 640; i += 512) { const int j = i - 48; tab[i] = (j >= 0 && j < 465) ? rpb[h * 465 + j] * LOG2E : 0.f; }
    const int r = R0 + (wid >> 1), qh = wid & 1;
    const int start_w = min(max(r - 4, 0), rows - 8);
    const int u_lo = min(max(R0 - 4, 0), rows - 8), u_hi = min(max(R0 - 1, 0), rows - 8) + 8;
    const bf16_t* ksrc = NAB + (size_t)(rowbase + lane) * 1536 + 512 + h * 64 + wid * 8;
    const bf16_t* vsrc = NAB + (size_t)(rowbase + 16 * (wid & 3) + (lane >> 2)) * 1536 + 1024 + h * 64 + (wid >> 2) * 32 + (lane & 3) * 8;
#define NA_STAGE(u, s) do { glds(ksrc + (size_t)(u) * 64 * 1536, lds + L_K + (s) * KSLOT + wid * 1024); glds(vsrc + (size_t)(u) * 64 * 1536, lds + L_V + (s) * VSLOT + wid * 1024); } while (0)
    NA_STAGE(u_lo, 0);
    const int qrow = rowbase + r * 64 + qh * 32;
    bf16x8 qr[4];
#pragma unroll
    for (int d0 = 0; d0 < 4; ++d0) qr[d0] = *(const bf16x8*)(NAB + (size_t)(qrow + r32) * 1536 + h * 64 + d0 * 16 + hi * 8);
    SoftSt st; st.mhat = 0.f; st.l = 0.f; st.o[0] = f32x16{}; st.o[1] = f32x16{}; st.negm = f32x16{};
    LAS float* wsf = (LAS float*)(lds + L_WS) + wid * 64;
    const int kboff = hi * 1024 + r32 * 16, vpoff = ((lane >> 4) & 1) * 32 + (lane & 3) * 8 + (4 * hi + ((lane & 15) >> 2)) * 64;
    const int qc = qh * 32 + r32, cs = min(max(qc - 8, 0), 48);
    asm volatile("s_waitcnt vmcnt(0)" ::: "memory"); __syncthreads();
    const int NT = u_hi - u_lo;
    for (int i = 0; i < NT; ++i) {
        const int s = i & 1, u = u_lo + i;
        if (i + 1 < NT) NA_STAGE(u + 1, s ^ 1);
        if (u >= start_w && u < start_w + 8)
            tile_step<4, true>(st, qr, lds + L_K + s * KSLOT + kboff, lds + L_V + s * VSLOT + vpoff, wsf, r32, hi, u == start_w, tab + 48 + (u - r + 7) * 31 + 15 - qc, cs);
        asm volatile("s_waitcnt vmcnt(0)" ::: "memory"); __syncthreads();
    }
#undef NA_STAGE
    attn_epilogue<L_WS, L_OST>(st, lds, wid, lane, r32, hi, AB + (size_t)qrow * DM + 512 + h * 64, SSB + (size_t)qrow * 8 + h);
    asm volatile("s_waitcnt lgkmcnt(0)" ::: "memory"); __syncthreads();
}
__device__ __forceinline__ void na_unit2(LAS unsigned char* lds, int rowbase, int rows, int h, int R0, const bf16_t* NAB, const float* rpb, bf16_t* AB, float* SSB) {
    int tid = threadIdx.x; asm volatile("" : "+v"(tid));
    const int lane = tid & 63, q16 = lane & 15, quad = lane >> 4; const int wid = __builtin_amdgcn_readfirstlane(tid >> 6);
    LAS float* tab = (LAS float*)(lds + L_BIAS);
    for (int i = tid; i < 640; i += 512) { const int j = i - 48; tab[i] = (j >= 0 && j < 465) ? rpb[h * 465 + j] * LOG2E : 0.f; }
    const int r = R0 + (wid >> 1), qh = wid & 1;
    const int start_w = min(max(r - 4, 0), rows - 8);
    const int u_lo = min(max(R0 - 4, 0), rows - 8), u_hi = min(max(R0 - 1, 0), rows - 8) + 8;
    const bf16_t* ksrc = NAB + (size_t)(rowbase + lane) * 1536 + 512 + h * 64 + wid * 8;
    const bf16_t* vsrc = NAB + (size_t)(rowbase + 16 * (wid & 3) + (lane >> 2)) * 1536 + 1024 + h * 64 + (wid >> 2) * 32 + (lane & 3) * 8;
#define NA_STAGE(u, s) do { glds(ksrc + (size_t)(u) * 64 * 1536, lds + NA_K + (s) * 8192 + wid * 1024); glds(vsrc + (size_t)(u) * 64 * 1536, lds + NA_V + (s) * 8192 + wid * 1024); } while (0)
    const int NT = u_hi - u_lo;
    NA_STAGE(u_lo, 0); NA_STAGE(u_lo + 1, 1); NA_STAGE(u_lo + 2, 2);
    const int qrow = rowbase + r * 64 + qh * 32;
    bf16x8 qf[2][2];
#pragma unroll
    for (int jb = 0; jb < 2; ++jb)
#pragma unroll
        for (int ks = 0; ks < 2; ++ks) qf[jb][ks] = *(const bf16x8*)(NAB + (size_t)(qrow + 16 * jb + q16) * 1536 + h * 64 + 32 * ks + 8 * quad);
    float mhat[2] = {0.f, 0.f}, lsum[2] = {0.f, 0.f}; f32x4 o[2][4];
#pragma unroll
    for (int jb = 0; jb < 2; ++jb)
#pragma unroll
        for (int db = 0; db < 4; ++db) o[jb][db] = (f32x4){0.f, 0.f, 0.f, 0.f};
    int koff[2], cs[2], kaddr[2], vaddr[2], boff[2];
#pragma unroll
    for (int jb = 0; jb < 2; ++jb) { const int jq = 2 * qh + jb, qc = 16 * jq + q16; koff[jb] = jq == 0 ? 0 : jq == 1 ? 8 : jq == 2 ? 24 : 32; cs[jb] = min(max(qc - 8, 0), 48);
        kaddr[jb] = quad * 1024 + (koff[jb] + q16) * 16;
        const int vr = koff[jb] + 4 * quad + (q16 >> 2); vaddr[jb] = (vr >> 4) * 1024 + (vr & 15) * 64 + (lane & 3) * 8;
        boff[jb] = 48 + 15 - qc + koff[jb] + 4 * quad; }
    asm volatile("s_waitcnt vmcnt(4)" ::: "memory"); __syncthreads();
    for (int it = 0; it < NT; ++it) {
        const int s = it & 3, u = u_lo + it;
        if (it + 3 < NT) NA_STAGE(u + 3, (it + 3) & 3);
        if (u >= start_w && u < start_w + 8) {
            const bool first = (u == start_w);
            f32x4 C[2][2]; float rm[2];
#pragma unroll
            for (int jb = 0; jb < 2; ++jb) {
                const LAS unsigned char* kp = lds + NA_K + s * 8192 + kaddr[jb];
                const float nm = -mhat[jb]; C[jb][0] = (f32x4){nm, nm, nm, nm}; C[jb][1] = C[jb][0];
#pragma unroll
                for (int ks = 0; ks < 2; ++ks)
#pragma unroll
                    for (int kb = 0; kb < 2; ++kb) C[jb][kb] = __builtin_amdgcn_mfma_f32_16x16x32_bf16(*(const LAS bf16x8*)(kp + ks * 4096 + kb * 256), qf[jb][ks], C[jb][kb], 0, 0, 0);
            }
#pragma unroll
            for (int jb = 0; jb < 2; ++jb) {
                const LAS float* brow = tab + boff[jb] + (u - r + 7) * 31; const int kc0 = koff[jb] + 4 * quad - cs[jb];
#pragma unroll
                for (int kb = 0; kb < 2; ++kb) { float bv[4];
#pragma unroll
                    for (int i = 0; i < 4; ++i) bv[i] = brow[16 * kb + i];
#pragma unroll
                    for (int i = 0; i < 4; ++i) { const float t = C[jb][kb][i] + bv[i]; C[jb][kb][i] = ((unsigned)(kc0 + 16 * kb + i) < 16u) ? t : -INFINITY; } }
                float m = __builtin_fmaxf(__builtin_fmaxf(__builtin_fmaxf(C[jb][0][0], C[jb][0][1]), __builtin_fmaxf(C[jb][0][2], C[jb][0][3])), __builtin_fmaxf(__builtin_fmaxf(C[jb][1][0], C[jb][1][1]), __builtin_fmaxf(C[jb][1][2], C[jb][1][3])));
                { auto rr = __builtin_amdgcn_permlane16_swap(__float_as_uint(m), __float_as_uint(m), false, false); m = __builtin_fmaxf(__uint_as_float(rr[0]), __uint_as_float(rr[1])); }
                { auto rr = __builtin_amdgcn_permlane32_swap(__float_as_uint(m), __float_as_uint(m), false, false); m = __builtin_fmaxf(__uint_as_float(rr[0]), __uint_as_float(rr[1])); }
                rm[jb] = m;
            }
            if (first || __any(__builtin_fmaxf(rm[0], rm[1]) > (float)THRL)) {
#pragma unroll
                for (int jb = 0; jb < 2; ++jb) {
                    const float dl = first ? rm[jb] : __builtin_fmaxf(rm[jb], 0.f); mhat[jb] += dl; C[jb][0] = C[jb][0] - dl; C[jb][1] = C[jb][1] - dl;
                    const float f = first ? 0.f : __builtin_amdgcn_exp2f(-dl); lsum[jb] *= f;
#pragma unroll
                    for (int db = 0; db < 4; ++db) o[jb][db] = o[jb][db] * f;
                }
            }
#pragma unroll
            for (int jb = 0; jb < 2; ++jb) {
                const LAS unsigned char* vp = lds + NA_V + s * 8192 + vaddr[jb];
                float sacc = 0.f;
#pragma unroll
                for (int kb = 0; kb < 2; ++kb)
#pragma unroll
                    for (int i = 0; i < 4; ++i) { C[jb][kb][i] = __builtin_amdgcn_exp2f(C[jb][kb][i]); sacc += C[jb][kb][i]; }
                lsum[jb] += sacc;
                const u32x4 pw = (u32x4){pk2(C[jb][0][0], C[jb][0][1]), pk2(C[jb][0][2], C[jb][0][3]), pk2(C[jb][1][0], C[jb][1][1]), pk2(C[jb][1][2], C[jb][1][3])};
                const bf16x8 pf = __builtin_bit_cast(bf16x8, pw);
#pragma unroll
                for (int db = 0; db < 4; ++db) { const int dbo = (db >> 1) * 4096 + (db & 1) * 32; const s16x4 lo = vtr(vp + dbo), hh = vtr(vp + dbo + 1024);
                    const bf16x8 vf = (bf16x8){lo[0], lo[1], lo[2], lo[3], hh[0], hh[1], hh[2], hh[3]};
                    o[jb][db] = __builtin_amdgcn_mfma_f32_16x16x32_bf16(vf, pf, o[jb][db], 0, 0, 0); }
            }
        }
        { const int ahead = min(it + 3, NT - 1) - (it + 1);
          if (ahead >= 2) asm volatile("s_waitcnt vmcnt(4) lgkmcnt(0)" ::: "memory"); else if (ahead == 1) asm volatile("s_waitcnt vmcnt(2) lgkmcnt(0)" ::: "memory"); else asm volatile("s_waitcnt vmcnt(0) lgkmcnt(0)" ::: "memory");
          __builtin_amdgcn_s_barrier(); asm volatile("" ::: "memory"); }
    }
#undef NA_STAGE
#pragma unroll
    for (int jb = 0; jb < 2; ++jb) {
        float l = lsum[jb];
        { auto rr = __builtin_amdgcn_permlane16_swap(__float_as_uint(l), __float_as_uint(l), false, false); l = __uint_as_float(rr[0]) + __uint_as_float(rr[1]); }
        { auto rr = __builtin_amdgcn_permlane32_swap(__float_as_uint(l), __float_as_uint(l), false, false); l = __uint_as_float(rr[0]) + __uint_as_float(rr[1]); }
        const float inv = __builtin_amdgcn_rcpf(l); float ss = 0.f; const size_t tok = (size_t)(qrow + 16 * jb + q16);
        bf16_t* op = AB + tok * DM + 512 + h * 64 + 4 * quad;
#pragma unroll
        for (int db = 0; db < 4; ++db) { const f32x4 v = o[jb][db] * inv; ss += dot4(v); u32x2 w; w.x = pk2(v[0], v[1]); w.y = pk2(v[2], v[3]); *(u32x2*)(op + 16 * db) = w; }
        ss += __shfl_xor(ss, 16); ss += __shfl_xor(ss, 32);
        if (quad == 0) SSB[tok * 8 + h] = ss;
    }
}
}

__device__ __forceinline__ float wave_sum(float v) {
#pragma unroll
    for (int o = 1; o < 64; o <<= 1) v += __shfl_xor(v, o);
    return v;
}
__device__ __forceinline__ int ropeperm(int p) { return 16 * ((p >> 2) & 1) + 4 * (p >> 3) + (p & 3); }
struct MapIn  { __device__ int operator()(int n) const { if (n < 640) return n; if (n < 672) return 640 + ropeperm(n - 640); if (n < 768) return -1; return n - 96; } };
struct MapUq  { __device__ int operator()(int n) const { const int h = n / 96, w = n - 96 * h; return w < 64 ? n : 96 * h + 64 + ropeperm(w - 64); } };
struct MapId  { __device__ int operator()(int n) const { return n; } };
struct MapGU  { __device__ int operator()(int n) const { const int pn = n >> 8, w = n & 255; return w < 128 ? 128 * pn + w : DFF + 128 * pn + (w - 128); } };
template <class Map>
__device__ __forceinline__ void wt_item(const float* W, const float* W2, int K, int N, bf16_t* WT, const float* g0, const float* g1, int ksplit, LAS float* scr, int item, int nblk, int lane, Map map) {
    const int kb = item / nblk, nb = item % nblk, k0 = 64 * kb, n0 = 32 * nb;
    int src = map(n0 + (lane & 31)); const float* Wsrc = W; if (W2 && src >= N) { Wsrc = W2; src -= N; }
#pragma unroll 8
    for (int i = 0; i < 32; ++i) { const int kk = 2 * i + (lane >> 5), k = k0 + kk; float v = src >= 0 ? Wsrc[(size_t)k * N + src] : 0.f;
        if (g0) v *= (k < ksplit ? g0[k] : g1[k - ksplit]);
        scr[kk * 33 + (lane & 31)] = v; }
    asm volatile("s_waitcnt lgkmcnt(0)" ::: "memory");
    const int c = lane & 7;
#pragma unroll
    for (int j = 0; j < 4; ++j) { const int n = (lane >> 3) + 8 * j; const LAS float* s = scr + (8 * c) * 33 + n;
        u32x4 o; o.x = pk2(s[0 * 33], s[1 * 33]); o.y = pk2(s[2 * 33], s[3 * 33]); o.z = pk2(s[4 * 33], s[5 * 33]); o.w = pk2(s[6 * 33], s[7 * 33]);
        *(u32x4*)(WT + (size_t)(n0 + n) * K + k0 + 8 * c) = o; }
    asm volatile("s_waitcnt lgkmcnt(0)" ::: "memory");
}
__device__ __forceinline__ void sincos_d(float ang, float& sn, float& cs) {
    const double a = (double)ang; const double k = __builtin_rint(a * 0.15915494309189535); const double r = a - k * 6.283185307179586 ; const double r2 = r * r;
    double ts = 1.0, tc = 1.0, s = 1.0, c = 1.0;
#pragma unroll
    for (int n = 1; n <= 13; ++n) { tc = -tc * r2 / (double)((2 * n - 1) * (2 * n)); ts = -ts * r2 / (double)((2 * n) * (2 * n + 1)); c += tc; s += ts; }
    sn = (float)(s * r); cs = (float)c;
}

#define XB_TMO      128
#define XB_XCNT(j)  (256  + 64 * (j))
#define XB_XSUB(j)  (1280 + 64 * (j))
#define XB_XGEN(j)  (2304 + 64 * (j))
#define XB_TOP      3328
#define XB_TOPGEN   3392
#define XCD_BAR_WORDS 3456
#define XB_SPIN_CAP (1u << 18)
__device__ __forceinline__ unsigned xb_ld(unsigned* p)              { return __hip_atomic_load(p, __ATOMIC_RELAXED, __HIP_MEMORY_SCOPE_AGENT); }
__device__ __forceinline__ unsigned xb_add(unsigned* p, unsigned v) { return __hip_atomic_fetch_add(p, v, __ATOMIC_RELAXED, __HIP_MEMORY_SCOPE_AGENT); }
__device__ __forceinline__ unsigned xb_xcc_id() { return (unsigned)__builtin_amdgcn_s_getreg((3 << 11) | 20) & 0xFu; }
#define XB_SPIN(cond, bar) do { unsigned _sp = 0; while (cond) { __builtin_amdgcn_s_sleep(1); \
    if ((++_sp & 255u) == 0u) { if (xb_ld(&(bar)[XB_TMO])) break; if (_sp > XB_SPIN_CAP) { atomicAdd(&(bar)[XB_TMO], 1u); break; } } } } while (0)
struct XcdBarrier { unsigned* bar; unsigned x; volatile LAS unsigned* st; };
__device__ __forceinline__ XcdBarrier xcd_barrier_post(unsigned* bar, volatile LAS unsigned* st) {
    XcdBarrier b; b.bar = bar; b.x = xb_xcc_id(); b.st = st;
    if (threadIdx.x == 0) (void)xb_add(&bar[XB_XCNT(b.x)], 1u);
    return b;
}
__device__ __forceinline__ void xcd_barrier_complete(unsigned* bar, unsigned x, unsigned& nloc, unsigned& nx) {
    const unsigned G = gridDim.x * gridDim.y * gridDim.z;
    unsigned sum, cnt, mine, sp = 0u;
    for (;;) {
        sum = 0u; cnt = 0u; mine = 0u;
#pragma unroll
        for (unsigned j = 0; j < 16; ++j) { const unsigned c = xb_ld(&bar[XB_XCNT(j)]); sum += c; cnt += (c > 0u) ? 1u : 0u; mine = (j == x) ? c : mine; }
        if (sum == G) break;
        __builtin_amdgcn_s_sleep(1);
        if ((++sp & 255u) == 0u) { if (xb_ld(&bar[XB_TMO])) break; if (sp > XB_SPIN_CAP) { atomicAdd(&bar[XB_TMO], 1u); break; } }
    }
    nloc = mine > 0u ? mine : 1u; nx = cnt > 0u ? cnt : 1u;
}
__device__ __forceinline__ void xcd_barrier(const XcdBarrier& b) {
    asm volatile("s_waitcnt vmcnt(0)" ::: "memory");
    __syncthreads();
    if (threadIdx.x == 0) {
        unsigned* bar = b.bar;
        __builtin_amdgcn_s_waitcnt(0);
        unsigned nloc = b.st[0], nx = b.st[1];
        if (nloc == 0u) { xcd_barrier_complete(bar, b.x, nloc, nx); b.st[0] = nloc; b.st[1] = nx; }
        const unsigned old = xb_add(&bar[XB_XSUB(b.x)], 1u);
        const unsigned gen = old / nloc;
        if (old + 1u == (gen + 1u) * nloc) {
            __builtin_amdgcn_fence(__ATOMIC_RELEASE, "agent");
            asm volatile("s_waitcnt vmcnt(0)" ::: "memory");
            const unsigned og = xb_add(&bar[XB_TOP], 1u);
            const unsigned tg = og / nx;
            if (og + 1u == (tg + 1u) * nx) xb_add(&bar[XB_TOPGEN], 1u);
            else XB_SPIN(xb_ld(&bar[XB_TOPGEN]) == tg, bar);
            __builtin_amdgcn_fence(__ATOMIC_ACQUIRE, "agent");
            xb_add(&bar[XB_XGEN(b.x)], 1u);
            asm volatile("s_waitcnt vmcnt(0)" ::: "memory");
        } else {
            XB_SPIN(xb_ld(&bar[XB_XGEN(b.x)]) == gen, bar);
            __builtin_amdgcn_fence(__ATOMIC_ACQUIRE, "agent");
            asm volatile("s_waitcnt vmcnt(0)" ::: "memory");
        }
    }
    __syncthreads();
}

struct Args { const float* in[17]; float* out; unsigned char* ws; int ph_lo, ph_hi; };
constexpr int NPHASE = 8;

__global__ void __launch_bounds__(512, 2) mega(Args args) {
    extern __shared__ __attribute__((aligned(16))) unsigned char lds_raw[];
    LAS unsigned char* lds = (LAS unsigned char*)lds_raw;
    const int tid = threadIdx.x, lane = tid & 63, wave = __builtin_amdgcn_readfirstlane(tid >> 6);
    const int G = gridDim.x, bx = blockIdx.x; const int vcu = (G % 8 == 0) ? (bx % 8) * (G / 8) + bx / 8 : bx;
    unsigned char* ws = args.ws;
    const float *xp = args.in[0], *xs = args.in[1];
    float* COS = (float*)(ws + WS_COS); float* SIN = (float*)(ws + WS_SIN);
    bf16_t *WIN = (bf16_t*)(ws + WS_WIN), *WUQ = (bf16_t*)(ws + WS_WUQ), *WUKV = (bf16_t*)(ws + WS_WUKV), *WO = (bf16_t*)(ws + WS_WO), *WGU = (bf16_t*)(ws + WS_WGU), *WD = (bf16_t*)(ws + WS_WD);
    float *SSQ = (float*)(ws + WS_SSQ), *SSKV = (float*)(ws + WS_SSKV), *SSA = (float*)(ws + WS_SSA), *SSB = (float*)(ws + WS_SSB), *SS1 = (float*)(ws + WS_SS1), *SS2 = (float*)(ws + WS_SS2);
    bf16_t *H = (bf16_t*)(ws + WS_H), *AB = (bf16_t*)(ws + WS_AB), *CQ = (bf16_t*)(ws + WS_CQ), *CKV = (bf16_t*)(ws + WS_CKV), *KR = (bf16_t*)(ws + WS_KR), *NAB = (bf16_t*)(ws + WS_NA);
    bf16_t *Qb = (bf16_t*)(ws + WS_Q), *KN = (bf16_t*)(ws + WS_KN), *Vb = (bf16_t*)(ws + WS_V), *X1 = (bf16_t*)(ws + WS_X1), *ACT = (bf16_t*)(ws + WS_ACT);
    const int lo = args.ph_lo, hi = args.ph_hi;
    volatile LAS unsigned* MISC = (volatile LAS unsigned*)(lds + RING_BYTES + 320);
    XcdBarrier bar; bar.bar = (unsigned*)(ws + WS_CTL) + CW_BAR; bar.x = 0; bar.st = MISC;
    if (hi - lo > 1) { if (tid < 2) MISC[tid] = 0u; __syncthreads(); bar = xcd_barrier_post((unsigned*)(ws + WS_CTL) + CW_BAR, MISC); }
#ifndef PH_MASK
#define PH_MASK 0xff
#endif
#define IN(k) (((PH_MASK >> (k)) & 1) && lo <= (k) && (k) < hi)
#ifndef PH_TWICE
#define PH_TWICE -1
#endif
#ifndef EXTRA_SYNCS
#define EXTRA_SYNCS 0
#endif
#define REP(k) for (int rep_ = 0; rep_ < ((k) == PH_TWICE ? 2 : 1); ++rep_)
#ifndef CG_SEAM
#define CG_SEAM -1
#endif
#define SEAM(k) do { if (IN(k) && IN((k) + 1)) { if ((k) == CG_SEAM) cg::this_grid().sync(); else xcd_barrier(bar); } } while (0)

    REP(0) if (IN(0)) {
        LAS float* scr = (LAS float*)(lds + wave * 16384);
        const int gw = vcu * 8 + wave, NGW = G * 8;
        constexpr int I_IN = (DM / 64) * (N1P / 32), I_UQ = (QL / 64) * (768 / 32), I_UKV = (KVL / 64) * (1024 / 32), I_O = (DM / 64) * (DM / 32), I_GU = (DM / 64) * (NGU / 32), I_D = (DFF / 64) * (DM / 32);
        constexpr int NITEMS = I_IN + I_UQ + I_UKV + I_O + I_GU + I_D;
        for (int it = gw; it < NITEMS; it += NGW) {
            int r = it;
            if (r < I_IN) { wt_item(args.in[3], nullptr, DM, NIN, WIN, nullptr, nullptr, 0, scr, r, N1P / 32, lane, MapIn()); continue; } r -= I_IN;
            if (r < I_UQ) { wt_item(args.in[6], nullptr, QL, 768, WUQ, args.in[4], args.in[4], QL, scr, r, 768 / 32, lane, MapUq()); continue; } r -= I_UQ;
            if (r < I_UKV) { wt_item(args.in[7], nullptr, KVL, 1024, WUKV, args.in[5], args.in[5], KVL, scr, r, 1024 / 32, lane, MapId()); continue; } r -= I_UKV;
            if (r < I_O) { wt_item(args.in[11], nullptr, DM, DM, WO, args.in[9], args.in[10], 512, scr, r, DM / 32, lane, MapId()); continue; } r -= I_O;
            if (r < I_GU) { wt_item(args.in[13], args.in[14], DM, DFF, WGU, args.in[12], args.in[12], DM, scr, r, NGU / 32, lane, MapGU()); continue; } r -= I_GU;
            wt_item(args.in[15], nullptr, DFF, DM, WD, nullptr, nullptr, 0, scr, r, DM / 32, lane, MapId());
        }
        for (int i = bx * 512 + tid; i < SEQS * 16; i += G * 512) { const int pos = i >> 4, j = i & 15;
            double inv = 1.0; for (int q = 0; q < j; ++q) inv *= 0.5623413251903491;
            const float ang = (float)pos * (float)inv; float sn, cs; sincos_d(ang, sn, cs); COS[i] = cs; SIN[i] = sn; }
        const float* g = args.in[2];
        f32x4 gv[4];
#pragma unroll
        for (int j = 0; j < 4; ++j) gv[j] = *(const f32x4*)(g + 4 * lane + 256 * j);
        for (int m = gw; m < TOK; m += NGW) {
            const float* xr = (m < TOKP ? xp + (size_t)m * DM : xs + (size_t)(m - TOKP) * DM) + 4 * lane;
            f32x4 v[4]; float s = 0.f;
#pragma unroll
            for (int j = 0; j < 4; ++j) { v[j] = *(const f32x4*)(xr + 256 * j); s += dot4(v[j]); }
            const float rstd = 1.0f / sqrtf(wave_sum(s) * (1.0f / DM) + EPS);
#pragma unroll
            for (int j = 0; j < 4; ++j) { const f32x4 o = v[j] * rstd * gv[j]; u32x2 w; w.x = pk2(o[0], o[1]); w.y = pk2(o[2], o[3]); *(u32x2*)(H + (size_t)m * DM + 4 * lane + 256 * j) = w; }
        }
    }
    SEAM(0);
    REP(1) if (IN(1)) {
        pg8::Gemm g{H, WIN, TOK, N1P, DM}; pg8::StaticOrder S; S.init(TOK, N1P, G, bx);
        Epi1 E{CQ, CKV, KR, NAB, SSQ, SSKV, COS, SIN};
        pg8::gemm_phase<Epi1, true>(lds, g, S, E);
    }
    SEAM(1);
    REP(2) if (IN(2)) {
        { pg8::Gemm g{CQ, WUQ, TOK, 768, QL}; pg8::StaticOrder S; S.init(TOK, 768, G, bx); Epi2 E{Qb, SSQ, COS, SIN}; pg8::gemm_phase<Epi2, true>(lds, g, S, E); }
        { pg8::Gemm g{CKV, WUKV, TOK, 1024, KVL}; pg8::StaticOrder S; S.init(TOK, 1024, G, bx); Epi3 E{KN, Vb, SSKV}; pg8::gemm_phase<Epi3, true>(lds, g, S, E); }
    }
    SEAM(2);
    REP(3) if (IN(3)) {
        for (int r2_ = 0; r2_ < (PH_TWICE == 30 ? 2 : 1); ++r2_)
        if (G == 256) {
            const int x = vcu >> 5, j = vcu & 31;
            for (int i = 0; i < 2; ++i) { const int pair = 2 * x + i; att::mla_unit2<8>(lds, TOKP + (pair >> 3) * SEQS, SEQS, pair & 7, j * 256, Qb, KN, KR, Vb, AB, SSA); }
            for (int i = 0; i < 4; ++i) { const int L = 4 * j + i, pair = 16 * x + (L >> 3); att::mla_unit2<8>(lds, (pair >> 3) * SEQP, SEQP, pair & 7, (L & 7) * 256, Qb, KN, KR, Vb, AB, SSA); }
        } else {
            for (int U = vcu; U < 512; U += G) { const int pair = U >> 5; att::mla_unit2<8>(lds, TOKP + (pair >> 3) * SEQS, SEQS, pair & 7, (U & 31) * 256, Qb, KN, KR, Vb, AB, SSA); }
            for (int U = vcu; U < 1024; U += G) { const int pair = U >> 3; att::mla_unit2<8>(lds, (pair >> 3) * SEQP, SEQP, pair & 7, (U & 7) * 256, Qb, KN, KR, Vb, AB, SSA); }
        }
        for (int r2_ = 0; r2_ < (PH_TWICE == 31 ? 2 : 1); ++r2_)
        for (int U = vcu; U < 1536; U += G) {
            if (U < 1024) { const int h = U & 7, grp = U >> 3; att::na_unit2(lds, (grp >> 3) * SEQP, 32, h, (grp & 7) * 4, NAB, args.in[8], AB, SSB); }
            else { const int U2 = U - 1024, h = U2 & 7, grp = U2 >> 3; att::na_unit2(lds, TOKP + (grp >> 5) * SEQS, 128, h, (grp & 31) * 4, NAB, args.in[8], AB, SSB); }
        }
    }
    SEAM(3);
    REP(4) if (IN(4)) {
        pg8::Gemm g{AB, WO, TOK, DM, DM}; pg8::StaticOrder S; S.init(TOK, DM, G, bx);
        Epi4 E{xp, xs, X1, SSA, SSB, SS1};
        pg8::gemm_phase<Epi4, true>(lds, g, S, E);
    }
    SEAM(4);
    REP(5) if (IN(5)) {
        pg8::Gemm g{X1, WGU, TOK, NGU, DM}; pg8::StaticOrder S; S.init(TOK, NGU, G, bx);
        Epi5 E{ACT, SS1};
        pg8::gemm_phase<Epi5, true>(lds, g, S, E);
    }
    SEAM(5);
    REP(6) if (IN(6)) {
        pg8::Gemm g{ACT, WD, TOK, DM, DFF}; pg8::StaticOrder S; S.init(TOK, DM, G, bx);
        Epi6 E{X1, args.out, SS2};
        pg8::gemm_phase<Epi6, true>(lds, g, S, E);
    }
    SEAM(6);
    for (int es_ = 0; es_ < EXTRA_SYNCS; ++es_) xcd_barrier(bar);
    REP(7) if (IN(7)) {
        const int gw = vcu * 8 + wave, NGW = G * 8; const float* g = args.in[16];
        f32x4 gv[4];
#pragma unroll
        for (int j = 0; j < 4; ++j) gv[j] = *(const f32x4*)(g + 4 * lane + 256 * j);
        for (int m = gw; m < TOK; m += NGW) { float* o = args.out + (size_t)m * DM + 4 * lane; const float r = rstd16(SS2 + (size_t)m * 16);
#pragma unroll
            for (int j = 0; j < 4; ++j) { const f32x4 v = *(const f32x4*)(o + 256 * j); *(f32x4*)(o + 256 * j) = v * r * gv[j]; } }
    }
#undef IN
#undef SEAM
}

#if MK_DEBUG
__device__ __forceinline__ float block_sum(float v, LAS float* red) {
    v = wave_sum(v); __syncthreads(); if ((threadIdx.x & 63) == 0) red[threadIdx.x >> 6] = v; __syncthreads(); const float r = (red[0] + red[1]) + (red[2] + red[3]); __syncthreads(); return r;
}
__device__ __forceinline__ void report(unsigned* ctl, int phase, float rel2) {
    if (!(rel2 < 2e-4f)) { const int b = !(rel2 == rel2) ? 9 : rel2 < 1e-3f ? 1 : rel2 < 1e-2f ? 2 : rel2 < 1e-1f ? 3 : rel2 < 0.5f ? 4 : rel2 < 2.f ? 5 : 6; atomicMax(ctl + CW_FAIL, (unsigned)((8 - phase) * 16 + b)); }
}
__device__ __forceinline__ int chk_row(int b) { const int t = b >> 8; return (t == 0 ? 0 : t == 1 ? 77 : t == 2 ? 130 : 191) * 256 + (b & 255); }
__device__ __forceinline__ void rope_ref(int pos, int j, float& sn, float& cs) { const float inv = __powf(10000.0f, -(float)j / 16.0f); const float ang = (float)pos * inv; const double a = (double)ang; const double r = a - __builtin_rint(a * 0.15915494309189535) * 6.283185307179586; sn = __sinf((float)r); cs = __cosf((float)r); }

__global__ void __launch_bounds__(256) chk_phase(Args args, int phase) {
    __shared__ float buf[5632]; __shared__ float inb[2816]; __shared__ float red4[4];
    LAS float* red = (LAS float*)red4;
    unsigned char* ws = args.ws; unsigned* ctl = (unsigned*)(ws + WS_CTL);
    const int tid = threadIdx.x; const int row = chk_row(blockIdx.x);
    const float* xrow = row < TOKP ? args.in[0] + (size_t)row * DM : args.in[1] + (size_t)(row - TOKP) * DM;
    const bf16_t *H = (const bf16_t*)(ws + WS_H), *AB = (const bf16_t*)(ws + WS_AB), *CQ = (const bf16_t*)(ws + WS_CQ), *CKV = (const bf16_t*)(ws + WS_CKV), *KR = (const bf16_t*)(ws + WS_KR), *NAB = (const bf16_t*)(ws + WS_NA);
    const bf16_t *Qb = (const bf16_t*)(ws + WS_Q), *KN = (const bf16_t*)(ws + WS_KN), *Vb = (const bf16_t*)(ws + WS_V), *X1 = (const bf16_t*)(ws + WS_X1), *ACT = (const bf16_t*)(ws + WS_ACT);
    float d2 = 0.f, e2 = 0.f;
    if (phase == 0) {
        float s = 0.f; for (int k = tid; k < DM; k += 256) s += xrow[k] * xrow[k];
        const float rstd = rsqrtf(block_sum(s, red) / DM + EPS);
        for (int k = tid; k < DM; k += 256) { const float e = xrow[k] * rstd * args.in[2][k], f = bf2f(H[(size_t)row * DM + k]); d2 += (f - e) * (f - e); e2 += e * e; }
    } else if (phase == 1) {
        for (int k = tid; k < DM; k += 256) inb[k] = bf2f(H[(size_t)row * DM + k]);
        __syncthreads();
        for (int n = tid; n < NIN; n += 256) { float a = 0.f; for (int k = 0; k < DM; ++k) a += inb[k] * args.in[3][(size_t)k * NIN + n]; buf[n] = a; }
        __syncthreads();
        const int pos = seq_pos(row);
        for (int n = tid; n < NIN; n += 256) { float e, f;
            if (n < 384) { e = buf[n]; f = bf2f(CQ[(size_t)row * QL + n]); }
            else if (n < 640) { e = buf[n]; f = bf2f(CKV[(size_t)row * KVL + n - 384]); }
            else if (n < 672) { const int j = n - 640, jj = j & 15; float sn, cs; rope_ref(pos, jj, sn, cs); const float x1 = buf[640 + jj], x2 = buf[656 + jj]; e = j < 16 ? x1 * cs - x2 * sn : x1 * sn + x2 * cs; f = bf2f(KR[(size_t)row * 32 + j]); }
            else { const int c = n - 672; e = buf[n] * (c < 512 ? QSC_NA : 1.f); f = bf2f(NAB[(size_t)row * 1536 + c]); }
            d2 += (f - e) * (f - e); e2 += e * e; }
        float sq = 0.f, sk = 0.f; for (int n = tid; n < 640; n += 256) { if (n < 384) sq += buf[n] * buf[n]; else sk += buf[n] * buf[n]; }
        sq = block_sum(sq, red); sk = block_sum(sk, red);
        if (tid == 0) { float fq = 0.f, fk = 0.f; for (int i = 0; i < 12; ++i) fq += ((const float*)(ws + WS_SSQ))[(size_t)row * 12 + i]; for (int i = 0; i < 8; ++i) fk += ((const float*)(ws + WS_SSKV))[(size_t)row * 8 + i];
            const float rq = (fq - sq) / sq, rk = (fk - sk) / sk; report(ctl, 1, rq * rq + rk * rk); }
    } else if (phase == 2) {
        float s = 0.f; for (int k = tid; k < QL; k += 256) { const float v = bf2f(CQ[(size_t)row * QL + k]); inb[k] = v; s += v * v; }
        float s2 = 0.f; for (int k = tid; k < KVL; k += 256) { const float v = bf2f(CKV[(size_t)row * KVL + k]); inb[512 + k] = v; s2 += v * v; }
        const float rq = rsqrtf(block_sum(s, red) / QL + EPS), rk = rsqrtf(block_sum(s2, red) / KVL + EPS);
        for (int k = tid; k < QL; k += 256) inb[k] *= rq * args.in[4][k];
        for (int k = tid; k < KVL; k += 256) inb[512 + k] *= rk * args.in[5][k];
        __syncthreads();
        for (int n = tid; n < 768; n += 256) { float a = 0.f; for (int k = 0; k < QL; ++k) a += inb[k] * args.in[6][(size_t)k * 768 + n]; buf[n] = a; }
        for (int n = tid; n < 1024; n += 256) { float a = 0.f; for (int k = 0; k < KVL; ++k) a += inb[512 + k] * args.in[7][(size_t)k * 1024 + n]; buf[1024 + n] = a; }
        __syncthreads();
        const int pos = seq_pos(row);
        for (int n = tid; n < 768; n += 256) { const int h = n / 96, w = n - 96 * h; float e;
            if (w < 64) e = buf[n]; else { const int j = w - 64, jj = j & 15; float sn, cs; rope_ref(pos, jj, sn, cs); const float x1 = buf[h * 96 + 64 + jj], x2 = buf[h * 96 + 80 + jj]; e = j < 16 ? x1 * cs - x2 * sn : x1 * sn + x2 * cs; }
            e *= QSC_MLA; const float f = bf2f(Qb[(size_t)row * 768 + n]); d2 += (f - e) * (f - e); e2 += e * e; }
        for (int n = tid; n < 1024; n += 256) { const int h = n >> 7, w = n & 127; const float e = buf[1024 + n]; const float f = w < 64 ? bf2f(KN[(size_t)row * 512 + h * 64 + w]) : bf2f(Vb[(size_t)row * 512 + h * 64 + w - 64]); d2 += (f - e) * (f - e); e2 += e * e; }
    } else if (phase == 4) {
        float sa = 0.f, sb = 0.f; for (int k = tid; k < DM; k += 256) { const float v = bf2f(AB[(size_t)row * DM + k]); inb[k] = v; if (k < 512) sa += v * v; else sb += v * v; }
        const float ra = rsqrtf(block_sum(sa, red) / 512 + EPS), rb = rsqrtf(block_sum(sb, red) / 512 + EPS);
        for (int k = tid; k < DM; k += 256) inb[k] *= (k < 512 ? ra * args.in[9][k] : rb * args.in[10][k - 512]);
        __syncthreads();
        for (int n = tid; n < DM; n += 256) { float a = 0.f; for (int k = 0; k < DM; ++k) a += inb[k] * args.in[11][(size_t)k * DM + n]; const float e = xrow[n] + a, f = bf2f(X1[(size_t)row * DM + n]); d2 += (f - e) * (f - e); e2 += e * e; }
    } else if (phase == 5) {
        float s = 0.f; for (int k = tid; k < DM; k += 256) { const float v = bf2f(X1[(size_t)row * DM + k]); inb[k] = v; s += v * v; }
        const float r = rsqrtf(block_sum(s, red) / DM + EPS);
        for (int k = tid; k < DM; k += 256) inb[k] *= r * args.in[12][k];
        __syncthreads();
        for (int n = tid; n < DFF; n += 256) { float a = 0.f, b = 0.f; for (int k = 0; k < DM; ++k) { a += inb[k] * args.in[13][(size_t)k * DFF + n]; b += inb[k] * args.in[14][(size_t)k * DFF + n]; }
            const float e = a / (1.f + __expf(-a)) * b, f = bf2f(ACT[(size_t)row * DFF + n]); d2 += (f - e) * (f - e); e2 += e * e; }
    } else if (phase == 7) {
        for (int k = tid; k < DFF; k += 256) inb[k] = bf2f(ACT[(size_t)row * DFF + k]);
        __syncthreads();
        float s = 0.f;
        for (int n = tid; n < DM; n += 256) { float a = 0.f; for (int k = 0; k < DFF; ++k) a += inb[k] * args.in[15][(size_t)k * DM + n]; const float v = bf2f(X1[(size_t)row * DM + n]) + a; buf[n] = v; s += v * v; }
        const float r = rsqrtf(block_sum(s, red) / DM + EPS);
        for (int n = tid; n < DM; n += 256) { const float e = buf[n] * r * args.in[16][n], f = args.out[(size_t)row * DM + n]; d2 += (f - e) * (f - e); e2 += e * e; }
    }
    d2 = block_sum(d2, red); e2 = block_sum(e2, red);
    if (tid == 0) report(ctl, phase, d2 / e2);
}
__global__ void __launch_bounds__(64) chk_attn(Args args) {
    __shared__ float sc[8192]; __shared__ float qv[96];
    unsigned char* ws = args.ws; unsigned* ctl = (unsigned*)(ws + WS_CTL);
    const bf16_t *AB = (const bf16_t*)(ws + WS_AB), *KR = (const bf16_t*)(ws + WS_KR), *NAB = (const bf16_t*)(ws + WS_NA), *Qb = (const bf16_t*)(ws + WS_Q), *KN = (const bf16_t*)(ws + WS_KN), *Vb = (const bf16_t*)(ws + WS_V);
    const int sidx = blockIdx.x >> 1, kind = blockIdx.x & 1, lane = threadIdx.x;
    const int row = (int)(((long)sidx * 2731 + 17) % TOK), h = (sidx / 3) & 7;
    const int rowbase = row < TOKP ? (row / SEQP) * SEQP : TOKP + ((row - TOKP) / SEQS) * SEQS, S = row < TOKP ? SEQP : SEQS, t = row - rowbase;
    float o = 0.f, e2 = 0.f, d2 = 0.f;
    if (kind == 0) {
        for (int d = lane; d < 96; d += 64) qv[d] = bf2f(Qb[(size_t)row * 768 + h * 96 + d]);
        __syncthreads();
        float mx = -INFINITY;
        for (int j = lane; j < S; j += 64) { float s = 0.f; const bf16_t* kn = KN + (size_t)(rowbase + j) * 512 + h * 64; const bf16_t* kr = KR + (size_t)(rowbase + j) * 32;
            for (int d = 0; d < 64; ++d) s += qv[d] * bf2f(kn[d]); for (int d = 0; d < 32; ++d) s += qv[64 + d] * bf2f(kr[d]); sc[j] = s; mx = fmaxf(mx, s); }
        for (int of = 1; of < 64; of <<= 1) mx = fmaxf(mx, __shfl_xor(mx, of));
        float l = 0.f; for (int j = lane; j < S; j += 64) { const float p = exp2f(sc[j] - mx); sc[j] = p; l += p; }
        l = wave_sum(l); __syncthreads();
        for (int j = 0; j < S; ++j) o += sc[j] * bf2f(Vb[(size_t)(rowbase + j) * 512 + h * 64 + lane]);
        o /= l; const float f = bf2f(AB[(size_t)row * DM + h * 64 + lane]); d2 = (f - o) * (f - o); e2 = o * o;
        const float ssf = ((const float*)(ws + WS_SSA))[(size_t)row * 8 + h]; d2 = wave_sum(d2); e2 = wave_sum(e2);
        if (lane == 0) { const float rs = (ssf - e2) / e2; report(ctl, 3, d2 / e2 + (fabsf(rs) > 0.05f ? rs * rs : 0.f)); }
    } else {
        const int rows = S / 64, r = t >> 6, qc = t & 63; const int start = min(max(r - 4, 0), rows - 8), cs = min(max(qc - 8, 0), 48);
        for (int d = lane; d < 64; d += 64) qv[d] = bf2f(NAB[(size_t)row * 1536 + h * 64 + d]);
        __syncthreads();
        float mx = -INFINITY;
        for (int j = lane; j < 128; j += 64) { const int kr_ = start + (j >> 4), kc = cs + (j & 15); const bf16_t* kp = NAB + (size_t)(rowbase + kr_ * 64 + kc) * 1536 + 512 + h * 64;
            float s = 0.f; for (int d = 0; d < 64; ++d) s += qv[d] * bf2f(kp[d]);
            s += args.in[8][h * 465 + (kr_ - r + 7) * 31 + (kc - qc + 15)] * LOG2E; sc[j] = s; mx = fmaxf(mx, s); }
        for (int of = 1; of < 64; of <<= 1) mx = fmaxf(mx, __shfl_xor(mx, of));
        float l = 0.f; for (int j = lane; j < 128; j += 64) { const float p = exp2f(sc[j] - mx); sc[j] = p; l += p; }
        l = wave_sum(l); __syncthreads();
        for (int j = 0; j < 128; ++j) { const int kr_ = start + (j >> 4), kc = cs + (j & 15); o += sc[j] * bf2f(NAB[(size_t)(rowbase + kr_ * 64 + kc) * 1536 + 1024 + h * 64 + lane]); }
        o /= l; const float f = bf2f(AB[(size_t)row * DM + 512 + h * 64 + lane]); d2 = (f - o) * (f - o); e2 = o * o;
        const float ssf = ((const float*)(ws + WS_SSB))[(size_t)row * 8 + h]; d2 = wave_sum(d2); e2 = wave_sum(e2);
        if (lane == 0) { const float rs = (ssf - e2) / e2; report(ctl, 3, d2 / e2 + (fabsf(rs) > 0.05f ? rs * rs : 0.f)); }
    }
}
__global__ void __launch_bounds__(256) chk_final(Args args) {
    const unsigned code = ((const unsigned*)(args.ws + WS_CTL))[CW_FAIL];
    if (code == 0) return;
    const int k = 8 - (int)(code >> 4), b = (int)(code & 15); const float c = sqrtf(1.0f + (float)k + 0.1f * (float)b);
    for (size_t i = (size_t)blockIdx.x * 256 + threadIdx.x; i < (size_t)TOK * DM; i += (size_t)gridDim.x * 256) args.out[i] = c;
}
#endif

extern "C" void kernel_launch(void* const* d_in, const int* in_sizes, int n_in, void* d_out, int out_size, void* d_ws, size_t ws_size, hipStream_t stream) {
    static int grid = 0;
    if (grid == 0) {
        if (n_in != 17 || out_size != TOK * DM || ws_size < WS_NEED) { fprintf(stderr, "kernel_launch: unexpected problem (n_in %d, out %d, ws %zu; need %zu)\n", n_in, out_size, ws_size, (size_t)WS_NEED); grid = -1; return; }
        int dev = 0, cus = 0, per_cu = 0;
        hipGetDevice(&dev); hipDeviceGetAttribute(&cus, hipDeviceAttributeMultiprocessorCount, dev);
        if (hipFuncSetAttribute((const void*)mega, hipFuncAttributeMaxDynamicSharedMemorySize, LDS_BYTES) != hipSuccess) { fprintf(stderr, "kernel_launch: hipFuncSetAttribute failed\n"); grid = -1; return; }
        if (hipOccupancyMaxActiveBlocksPerMultiprocessor(&per_cu, (const void*)mega, 512, LDS_BYTES) != hipSuccess || per_cu < 1) { fprintf(stderr, "kernel_launch: occupancy query says %d\n", per_cu); per_cu = 1; }
        (void)hipGetLastError();
        grid = cus * 1;
    }
    if (grid < 0) return;
    hipMemsetAsync((char*)d_ws + WS_CTL, 0, CTL_ZERO_BYTES, stream);
    Args a{};
    for (int i = 0; i < 17; ++i) a.in[i] = (const float*)d_in[i];
    a.out = (float*)d_out; a.ws = (unsigned char*)d_ws;
#if MK_ONE_LAUNCH
    a.ph_lo = 0; a.ph_hi = NPHASE;
    void* kargs[] = {&a};
    hipError_t e = hipLaunchCooperativeKernel((const void*)mega, dim3(grid), dim3(512), kargs, LDS_BYTES, stream);
    if (e != hipSuccess) fprintf(stderr, "kernel_launch: cooperative launch failed: %s (grid %d)\n", hipGetErrorString(e), grid);
#else
    for (int ph = 0; ph < NPHASE; ++ph) {
        a.ph_lo = ph; a.ph_hi = ph + 1;
        hipLaunchKernelGGL(mega, dim3(grid), dim3(512), LDS_BYTES, stream, a);
#if MK_DEBUG
        if (ph == 3) hipLaunchKernelGGL(chk_attn, dim3(2 * 1536), dim3(64), 0, stream, a);
        else if (ph != 6) hipLaunchKernelGGL(chk_phase, dim3(1024), dim3(256), 0, stream, a, ph);
#endif
    }
#if MK_DEBUG
    hipLaunchKernelGGL(chk_final, dim3(2048), dim3(256), 0, stream, a);
#endif
#endif
}
```
